# Optimizing an MI355X kernel written in HIP

```python
import jax, jax.numpy as jnp
from jax import lax
import numpy as np

D_MODEL = 1024
BATCH = 32
SEQ = 256
DEPTH = 2
DEC_BATCH = 4
DEC_SEQ = 1024
PAST_LEN = 256

GRID_W = 64
CHUNK = 16
N_EVEN = (DEPTH + 1) // 2
N_ODD = DEPTH // 2
EPS = 1e-6
H_A = 4
DK_A = 128
DV_A = 128
H_B = 4
DK_B = 64
DV_B = 128
GLA_RANK = 16
GLA_GATE_NORM = 16.0
H_C = 8
DK_C = 128
DV_C = 128
ROPE_BASE = 10000.0

W_A = H_A * DV_A
W_B = H_B * DV_B
W_EVEN = W_A + W_B
W_ODD = H_C * DV_C
EVEN_SPLITS = [H_A * DK_A, W_A, H_A * DK_A, H_A * DK_A, W_A, H_B * DK_B, H_B * DK_B, W_B, W_B, GLA_RANK, GLA_RANK]
EVEN_SPLIT_IDX = np.cumsum(EVEN_SPLITS)[:-1].tolist()
D_IN_EVEN = int(sum(EVEN_SPLITS))
ODD_SPLIT_IDX = [H_C * DK_C, 2 * H_C * DK_C, 2 * H_C * DK_C + W_ODD]
D_IN_ODD = 2 * H_C * DK_C + 2 * W_ODD

kernel_name = "hybrid_hgrn2_gla_retention_diffusion_step"


def rms_norm(x, w):
    xf = x.astype(jnp.float32)
    y = xf * lax.rsqrt(jnp.mean(xf * xf, axis=-1, keepdims=True) + EPS)
    return (y * w.astype(jnp.float32)).astype(x.dtype)


def group_rms_norm(o, w):
    b, t, h, v = o.shape
    of = o.astype(jnp.float32)
    y = of * lax.rsqrt(jnp.mean(of * of, axis=-1, keepdims=True) + EPS)
    return y.reshape(b, t, h * v) * w.astype(jnp.float32)


def grid_angles(T):
    rows = T // GRID_W
    t_row = jnp.repeat(jnp.arange(rows), GRID_W).astype(jnp.float32)
    t_col = jnp.tile(jnp.arange(GRID_W), rows).astype(jnp.float32)
    half = DK_C // 2
    inv = ROPE_BASE ** (-jnp.arange(0, half, 2, dtype=jnp.float32) / half)
    ang_r = t_row[:, None] * inv
    ang_c = t_col[:, None] * inv
    ang = jnp.concatenate([ang_r, ang_r, ang_c, ang_c], axis=-1)
    return jnp.cos(ang), jnp.sin(ang)


def apply_grid_rope(x, cos, sin):
    half = DK_C // 2
    qd = half // 2
    def rot(a):
        return jnp.concatenate([-a[..., qd:], a[..., :qd]], axis=-1)
    xr = jnp.concatenate([rot(x[..., :half]), rot(x[..., half:])], axis=-1)
    return x * cos[None, :, None, :] + xr * sin[None, :, None, :]


def chunk_gated_linear(q, k, v, log_g, s0):
    f32 = jnp.float32
    q, k, v, log_g, s0 = (a.astype(f32) for a in (q, k, v, log_g, s0))
    b_, t, h, kd = q.shape
    n = t // CHUNK
    rs = lambda a: a.reshape(b_, n, CHUNK, h, a.shape[-1])
    qc, kc, vc, gc = rs(q), rs(k), rs(v), rs(log_g)
    bcum = jnp.cumsum(gc, axis=2)
    b_last = bcum[:, :, -1]
    causal = jnp.tril(jnp.ones((CHUNK, CHUNK), dtype=bool))
    diff = bcum[:, :, :, None] - bcum[:, :, None, :]
    decay = jnp.exp(jnp.where(causal[None, None, :, :, None, None], diff, -jnp.inf))
    if log_g.shape[-1] == 1:
        scores = jnp.einsum('bnthk,bnshk->bntsh', qc, kc) * decay[..., 0]
    else:
        scores = jnp.einsum('bnthk,bnshk,bntshk->bntsh', qc, kc, decay)
    o_intra = jnp.einsum('bntsh,bnshv->bnthv', scores, vc)
    q_dec = qc * jnp.exp(bcum)
    k_dec = kc * jnp.exp(b_last[:, :, None] - bcum)
    chunk_kv = jnp.einsum('bnshk,bnshv->bnhkv', k_dec, vc)
    g_chunk = jnp.exp(b_last)

    def step(S, inp):
        g_n, kv_n = inp
        return g_n[..., None] * S + kv_n, S

    s_final, s_prev = lax.scan(step, s0, (jnp.moveaxis(g_chunk, 1, 0), jnp.moveaxis(chunk_kv, 1, 0)))
    s_prev = jnp.moveaxis(s_prev, 0, 1)
    o_inter = jnp.einsum('bnthk,bnhkv->bnthv', q_dec, s_prev)
    o = (o_intra + o_inter).reshape(b_, t, h, v.shape[-1])
    return o, s_final


def bidir_scan(q, k_pair, v, lg_pair, s0):
    flip = lambda a: a[:, ::-1]
    o_f, s_f = chunk_gated_linear(q, k_pair[0], v, lg_pair[0], s0[:, 0])
    o_b, s_b = chunk_gated_linear(flip(q), flip(k_pair[1]), flip(v), flip(lg_pair[1]), s0[:, 1])
    return o_f + flip(o_b), jnp.stack([s_f, s_b], axis=1)


def even_mixer(h, s0_a, s0_b, lb, w_in, gk_w, gk_b, gn_w, w_out):
    b_, t, _ = h.shape
    p = h @ w_in
    aq, ai, af_f, af_b, ag, bq, bk, bv, bg, bl_f, bl_b = jnp.split(p, EVEN_SPLIT_IDX, axis=-1)
    hd = lambda a, nh: a.reshape(b_, t, nh, -1)
    lbf = lb.astype(jnp.float32)
    def log_forget(a):
        return jnp.logaddexp(jnp.log(lbf), jnp.log1p(-lbf) + jax.nn.log_sigmoid(a.astype(jnp.float32)))
    lf_f = hd(log_forget(af_f), H_A)
    lf_b = hd(log_forget(af_b), H_A)
    o_a, st_a = bidir_scan(hd(jax.nn.silu(aq), H_A), (-jnp.expm1(lf_f), -jnp.expm1(lf_b)),
                           hd(ai, H_A), (lf_f, lf_b), s0_a)
    def gla_log_gate(low, d):
        return jax.nn.log_sigmoid((low @ gk_w[d] + gk_b[d]).astype(jnp.float32)) / GLA_GATE_NORM
    kb = hd(bk, H_B)
    o_b, st_b = bidir_scan(hd(bq, H_B) * (DK_B ** -0.5), (kb, kb), hd(bv, H_B),
                           (hd(gla_log_gate(bl_f, 0), H_B), hd(gla_log_gate(bl_b, 1), H_B)), s0_b)
    o = jnp.concatenate([o_a, o_b], axis=2)
    o = group_rms_norm(o, gn_w).astype(h.dtype) * jax.nn.silu(jnp.concatenate([ag, bg], axis=-1))
    return o @ w_out, st_a, st_b


def odd_mixer(h, s0, decay_logit, w_in, gn_w, w_out, rope):
    b_, t, _ = h.shape
    p = h @ w_in
    q, k, v, g = jnp.split(p, ODD_SPLIT_IDX, axis=-1)
    q = q.reshape(b_, t, H_C, DK_C)
    k = k.reshape(b_, t, H_C, DK_C) * (DK_C ** -0.5)
    if rope is not None:
        q = apply_grid_rope(q, rope[0], rope[1])
        k = apply_grid_rope(k, rope[0], rope[1])
    lg = jax.nn.log_sigmoid(decay_logit.astype(jnp.float32))
    lg_f = jnp.broadcast_to(lg[0][:, None], (b_, t, H_C, 1))
    lg_b = jnp.broadcast_to(lg[1][:, None], (b_, t, H_C, 1))
    o, st = bidir_scan(q, (k, k), v.reshape(b_, t, H_C, DV_C), (lg_f, lg_b), s0)
    o = group_rms_norm(o, gn_w).astype(h.dtype) * jax.nn.silu(g)
    return o @ w_out, st


def setup_inputs(seed: int = 0) -> dict:
    key = jax.random.key(seed)
    ks = jax.random.split(key, 24)
    f32 = jnp.float32
    nrm = lambda k, shape, s: jax.random.normal(k, shape, f32) * s
    ret_init = jnp.asarray(np.log(2.0 ** (5.0 + np.arange(H_C)) - 1.0), dtype=f32)
    return {
        "x_prompt": nrm(ks[0], (BATCH, SEQ, D_MODEL), 1.0),
        "x_sample": nrm(ks[1], (DEC_BATCH, DEC_SEQ, D_MODEL), 1.0),
        "state_hgrn": nrm(ks[2], (DEC_BATCH, N_EVEN, 2, H_A, DK_A, DV_A), 0.5),
        "state_gla": nrm(ks[3], (DEC_BATCH, N_EVEN, 2, H_B, DK_B, DV_B), 0.5),
        "state_ret": nrm(ks[4], (DEC_BATCH, N_ODD, 2, H_C, DK_C, DV_C), 1.0),
        "c": nrm(ks[5], (DEC_BATCH, D_MODEL), 1.0),
        "c_ctx": nrm(ks[6], (D_MODEL,), 1.0),
        "norm_w": 1.0 + nrm(ks[7], (DEPTH, D_MODEL), 0.02),
        "ada_w": nrm(ks[8], (DEPTH, D_MODEL, 3 * D_MODEL), 0.5 * D_MODEL ** -0.5),
        "ada_b": nrm(ks[9], (DEPTH, 3 * D_MODEL), 0.02),
        "w_in_even": nrm(ks[10], (N_EVEN, D_MODEL, D_IN_EVEN), D_MODEL ** -0.5),
        "hgrn_lb": nrm(ks[11], (N_EVEN + 1, H_A * DK_A), 0.5),
        "gla_gk_w": nrm(ks[12], (N_EVEN, 2, GLA_RANK, H_B * DK_B), GLA_RANK ** -0.5),
        "gla_gk_b": nrm(ks[13], (N_EVEN, 2, H_B * DK_B), 0.02),
        "gn_even": 1.0 + nrm(ks[14], (N_EVEN, W_EVEN), 0.02),
        "w_out_even": nrm(ks[15], (N_EVEN, W_EVEN, D_MODEL), W_EVEN ** -0.5),
        "w_in_odd": nrm(ks[16], (N_ODD, D_MODEL, D_IN_ODD), D_MODEL ** -0.5),
        "ret_decay": ret_init[None, None, :] + nrm(ks[17], (N_ODD, 2, H_C), 0.1),
        "gn_odd": 1.0 + nrm(ks[18], (N_ODD, W_ODD), 0.02),
        "w_out_odd": nrm(ks[19], (N_ODD, W_ODD, D_MODEL), W_ODD ** -0.5),
        "final_norm_w": 1.0 + nrm(ks[20], (D_MODEL,), 0.02),
    }


def reference(x_prompt, x_sample, state_hgrn, state_gla, state_ret, c, c_ctx, norm_w, ada_w, ada_b,
              w_in_even, hgrn_lb, gla_gk_w, gla_gk_b, gn_even, w_out_even, w_in_odd, ret_decay, gn_odd,
              w_out_odd, final_norm_w):
    f32 = jnp.float32
    b_ctx = x_prompt.shape[0]
    lbs = jnp.cumsum(jax.nn.softmax(hgrn_lb.astype(f32), axis=0), axis=0)
    cond_ctx = jax.nn.silu(c_ctx)[None, None, :]
    cond_lat = jax.nn.silu(c)[:, None, :]
    rope = grid_angles(x_sample.shape[1])
    x_c, x_l = x_prompt, x_sample
    new_hgrn, new_gla, new_ret = [], [], []
    for l in range(DEPTH):
        i = l // 2
        sh_c, sc_c, g_c = jnp.split(cond_ctx @ ada_w[l] + ada_b[l], 3, axis=-1)
        sh_l, sc_l, g_l = jnp.split(cond_lat @ ada_w[l] + ada_b[l], 3, axis=-1)
        h_c = rms_norm(x_c, norm_w[l]) * (1.0 + sc_c) + sh_c
        h_l = rms_norm(x_l, norm_w[l]) * (1.0 + sc_l) + sh_l
        if l % 2 == 0:
            z_a = jnp.zeros((b_ctx, 2, H_A, DK_A, DV_A), f32)
            z_b = jnp.zeros((b_ctx, 2, H_B, DK_B, DV_B), f32)
            out_c, st_a, st_b = even_mixer(h_c, z_a, z_b, lbs[i], w_in_even[i], gla_gk_w[i], gla_gk_b[i],
                                           gn_even[i], w_out_even[i])
            out_l, _, _ = even_mixer(h_l, state_hgrn[:, i], state_gla[:, i], lbs[i], w_in_even[i],
                                     gla_gk_w[i], gla_gk_b[i], gn_even[i], w_out_even[i])
            new_hgrn.append(st_a)
            new_gla.append(st_b)
        else:
            z_c = jnp.zeros((b_ctx, 2, H_C, DK_C, DV_C), f32)
            out_c, st_c = odd_mixer(h_c, z_c, ret_decay[i], w_in_odd[i], gn_odd[i], w_out_odd[i], None)
            out_l, _ = odd_mixer(h_l, state_ret[:, i], ret_decay[i], w_in_odd[i], gn_odd[i], w_out_odd[i], rope)
            new_ret.append(st_c)
        x_c = x_c + g_c * out_c
        x_l = x_l + g_l * out_l
    y_prompt = rms_norm(x_c, final_norm_w)
    y_sample = rms_norm(x_l, final_norm_w)
    new_state_hgrn = jnp.stack(new_hgrn, axis=1)
    new_state_gla = jnp.stack(new_gla, axis=1)
    new_state_ret = jnp.stack(new_ret, axis=1)
    return (y_prompt, y_sample, new_state_hgrn, new_state_gla, new_state_ret)
```

```cpp
#include <hip/hip_runtime.h>
#include <hip/hip_cooperative_groups.h>
#include <cstdio>
namespace cg = cooperative_groups;

#define DI __device__ __forceinline__
#define LAS __attribute__((address_space(3)))
typedef unsigned short bf16_t;
typedef short bf16x8 __attribute__((ext_vector_type(8)));
typedef short s16x4 __attribute__((ext_vector_type(4)));
typedef float f32x4 __attribute__((ext_vector_type(4)));
typedef unsigned u32x4 __attribute__((ext_vector_type(4)));
typedef unsigned u32x2 __attribute__((ext_vector_type(2)));
typedef _Float16 f16x8 __attribute__((ext_vector_type(8)));

constexpr int TCTX = 8192, TALL = 12288;
constexpr size_t OFF_BTIN0 = 0, OFF_BTOUT0 = 8454144, OFF_BTIN1 = 10551296, OFF_BTOUT1 = 18939904, OFF_MODP = 21037056,
                 OFF_MOD = 22020096, OFF_ROPE = 22142976, OFF_A = 22159360, OFF_P = 47325184, OFF_GG = OFF_P + 75497472,
                 OFF_LG = 147988480, OFF_OF = 198320128, OFF_OB = 223485952, OFF_D0 = OFF_LG + 25165824, OFF_BAR = 248651776, WS_NEED = 248651776 + 16384;
constexpr size_t OUT_HGRN = 12582912, OUT_GLA = 16777216, OUT_RET = 18874368;

struct Params {
  const float *x_prompt, *x_sample, *state_hgrn, *state_gla, *state_ret, *c, *c_ctx, *norm_w, *ada_w, *ada_b, *w_in_even, *hgrn_lb,
      *gla_gk_w, *gla_gk_b, *gn_even, *w_out_even, *w_in_odd, *ret_decay, *gn_odd, *w_out_odd, *final_norm_w;
  float* out;
  unsigned char* ws;
};

typedef float f32x2 __attribute__((ext_vector_type(2)));
typedef __bf16 bf16v2 __attribute__((ext_vector_type(2)));
DI unsigned cvt_pk_bf16(float lo, float hi) { const f32x2 v = {lo, hi}; const bf16v2 b = __builtin_convertvector(v, bf16v2); return __builtin_bit_cast(unsigned, b); }
DI int opaque_i(int x) { asm volatile("" : "+v"(x)); return x; }
DI float bf_lo(unsigned u) { return __uint_as_float(u << 16); }
DI float bf_hi(unsigned u) { return __uint_as_float(u & 0xffff0000u); }
DI float silu_f(float x) { return x * __builtin_amdgcn_rcpf(1.0f + __expf(-x)); }
DI float logsigmoid_f(float x) { return fminf(x, 0.f) - __logf(1.0f + __expf(-fabsf(x))); }
DI void unpack8(const u32x4& u, float* f) {
  f[0] = bf_lo(u.x); f[1] = bf_hi(u.x); f[2] = bf_lo(u.y); f[3] = bf_hi(u.y); f[4] = bf_lo(u.z); f[5] = bf_hi(u.z); f[6] = bf_lo(u.w); f[7] = bf_hi(u.w);
}
DI u32x4 pack8(const float* f) { u32x4 w; w.x = cvt_pk_bf16(f[0], f[1]); w.y = cvt_pk_bf16(f[2], f[3]); w.z = cvt_pk_bf16(f[4], f[5]); w.w = cvt_pk_bf16(f[6], f[7]); return w; }
DI float wave_sum(float v) {
#pragma unroll
  for (int o = 32; o >= 1; o >>= 1) v += __shfl_xor(v, o);
  return v;
}

#define XB_TMO      128
#define XB_XCNT(j)  (256  + 64 * (j))
#define XB_XSUB(j)  (1280 + 64 * (j))
#define XB_XGEN(j)  (2304 + 64 * (j))
#define XB_TOP      3328
#define XB_TOPGEN   3392
#define XCD_BAR_WORDS 3456
#define XB_SPIN_CAP (1u << 18)
DI unsigned xb_ld(unsigned* p) { return __hip_atomic_load(p, __ATOMIC_RELAXED, __HIP_MEMORY_SCOPE_AGENT); }
DI unsigned xb_add(unsigned* p, unsigned v) { return __hip_atomic_fetch_add(p, v, __ATOMIC_RELAXED, __HIP_MEMORY_SCOPE_AGENT); }
DI unsigned xb_xcc_id() { return (unsigned)__builtin_amdgcn_s_getreg((3 << 11) | 20) & 0xFu; }
#define XB_SPIN(cond, bar) do { unsigned _sp = 0; while (cond) { __builtin_amdgcn_s_sleep(1); \
    if ((++_sp & 255u) == 0u) { if (xb_ld(&(bar)[XB_TMO])) break; if (_sp > XB_SPIN_CAP) { atomicAdd(&(bar)[XB_TMO], 1u); break; } } } } while (0)
struct XcdBarrier { unsigned* bar; unsigned x; volatile LAS unsigned* st; };
DI XcdBarrier xcd_barrier_post(unsigned* bar, volatile LAS unsigned* st) {
  XcdBarrier b; b.bar = bar; b.x = xb_xcc_id(); b.st = st;
  if (threadIdx.x == 0) (void)xb_add(&bar[XB_XCNT(b.x)], 1u);
  return b;
}
DI void xcd_barrier_complete(unsigned* bar, unsigned x, unsigned& nloc, unsigned& nx) {
  const unsigned G = gridDim.x * gridDim.y * gridDim.z;
  unsigned sum, cnt, mine, sp = 0u;
  for (;;) {
    sum = 0u; cnt = 0u; mine = 0u;
#pragma unroll
    for (unsigned j = 0; j < 16; ++j) { const unsigned c = xb_ld(&bar[XB_XCNT(j)]); sum += c; cnt += (c > 0u) ? 1u : 0u; mine = (j == x) ? c : mine; }
    if (sum == G) break;
    __builtin_amdgcn_s_sleep(1);
    if ((++sp & 255u) == 0u) { if (xb_ld(&bar[XB_TMO])) break; if (sp > XB_SPIN_CAP) { atomicAdd(&bar[XB_TMO], 1u); break; } }
  }
  nloc = mine > 0u ? mine : 1u; nx = cnt > 0u ? cnt : 1u;
}
DI void xcd_barrier(const XcdBarrier& b) {
  asm volatile("s_waitcnt vmcnt(0)" ::: "memory");
  __syncthreads();
  if (threadIdx.x == 0) {
    unsigned* bar = b.bar;
    __builtin_amdgcn_s_waitcnt(0);
    unsigned nloc = b.st[0], nx = b.st[1];
    if (nloc == 0u) { xcd_barrier_complete(bar, b.x, nloc, nx); b.st[0] = nloc; b.st[1] = nx; }
    const unsigned old = xb_add(&bar[XB_XSUB(b.x)], 1u);
    const unsigned gen = old / nloc;
    if (old + 1u == (gen + 1u) * nloc) {
      __builtin_amdgcn_fence(__ATOMIC_RELEASE, "agent");
      asm volatile("s_waitcnt vmcnt(0)" ::: "memory");
      const unsigned og = xb_add(&bar[XB_TOP], 1u);
      const unsigned tg = og / nx;
      if (og + 1u == (tg + 1u) * nx) xb_add(&bar[XB_TOPGEN], 1u);
      else XB_SPIN(xb_ld(&bar[XB_TOPGEN]) == tg, bar);
      __builtin_amdgcn_fence(__ATOMIC_ACQUIRE, "agent");
      xb_add(&bar[XB_XGEN(b.x)], 1u);
      asm volatile("s_waitcnt vmcnt(0)" ::: "memory");
    } else {
      XB_SPIN(xb_ld(&bar[XB_XGEN(b.x)]) == gen, bar);
      __builtin_amdgcn_fence(__ATOMIC_ACQUIRE, "agent");
      asm volatile("s_waitcnt vmcnt(0)" ::: "memory");
    }
  }
  __syncthreads();
}

namespace pg8 {
constexpr int BM = 256, BK = 64, HALF = 128, HTB = HALF * BK * 2, STAGE_BYTES = 8 * HTB, NXCD = 8, WGM = 8;
DI int lds_byte(int r, int c) { const int st = (r >> 4) * 2 + (c >> 5), rr = r & 15, cc = c & 31, ob = rr * 64 + cc * 2; return st * 1024 + (ob ^ (((ob >> 9) & 1) << 5)); }
DI void stage_rc(int b, int& R, int& C) { const int st = b / 1024, sb = b % 1024, swz = sb ^ (((sb >> 9) & 1) << 5); R = (st >> 1) * 16 + swz / 64; C = (st & 1) * 32 + (swz % 64) / 2; }
DI int perm32(int rho) { const int n = rho >> 4, i = rho & 15; return 8 * (i >> 2) + 4 * n + (i & 3); }
struct Unit { int pm, pn; };
struct Gemm { const bf16_t* A; const bf16_t* Bt; int M, N, K; };
struct StaticOrder {
  int nM, nN, nwg, G, c;
  DI void init(int M, int N, int G_, int c_) { nM = M / BM; nN = N / BM; nwg = nM * nN; G = G_; c = c_; }
  DI bool next(int i, Unit& u) const {
    const long L = (long)i * G + c; if (L >= nwg) return false;
    int wgid = (int)L; { const int q = nwg / NXCD, r = nwg % NXCD, xcd = wgid % NXCD, off = wgid / NXCD; wgid = (xcd < r ? xcd * (q + 1) : r * (q + 1) + (xcd - r) * q) + off; }
    const int nig = WGM * nN, gid = wgid / nig, fm = gid * WGM, gsz = (nM - fm) < WGM ? (nM - fm) : WGM;
    u.pm = fm + ((wgid % nig) % gsz); u.pn = (wgid % nig) / gsz; return true;
  }
};

template <class Epi>
DI void gemm_phase(LAS unsigned char* lds, const Gemm g, const StaticOrder& S, const Epi& E) {
  const int tid = opaque_i((int)threadIdx.x), wid = __builtin_amdgcn_readfirstlane(tid >> 6), lane = tid & 63, wr = wid >> 2, wc = wid & 3, fr = lane & 15, fq = lane >> 4;
  const int K = g.K, nt = K / BK;
  unsigned voffA[2], voffB[2];
#pragma unroll
  for (int i = 0; i < 2; ++i) { int R, C; stage_rc(tid * 16 + i * 8192, R, C); const int Rb = Epi::PERM ? ((R & ~31) + perm32(R & 31)) : R;
    voffA[i] = (unsigned)(R * K + C) * 2u; voffB[i] = (unsigned)(Rb * K + C) * 2u; }
  const size_t kstep = (size_t)(BK * 2);
  const size_t hstep = (size_t)HALF * K * 2;
  const size_t tstep = 2 * hstep;
  const unsigned ldsw = (unsigned)wid * 1024u;
  const int aoff = lds_byte(wr * 64 + fr, fq * 8), boff = lds_byte(wc * 32 + fr, fq * 8);
#define PG8_SA(b, h) (((b) * 2 + (h)) * HTB)
#define PG8_SB(b, h) ((4 + (b) * 2 + (h)) * HTB)
#define PG8_STAGE(bufoff, gbase, voff) do { _Pragma("unroll") for (int _i = 0; _i < 2; ++_i) \
        __builtin_amdgcn_global_load_lds((const unsigned*)((const char*)(gbase) + (voff)[_i]), (LAS unsigned*)(lds + (bufoff) + ldsw + _i * 8192), 16, 0, 0); } while (0)
#define PG8_LDA(dst, b, h) do { _Pragma("unroll") for (int m = 0; m < 4; ++m) _Pragma("unroll") for (int k = 0; k < 2; ++k) dst[m][k] = *(const LAS bf16x8*)(lds + PG8_SA(b, h) + aoff + m * 2048 + k * 1024); } while (0)
#define PG8_LDB(dst, b, h) do { _Pragma("unroll") for (int n = 0; n < 2; ++n) _Pragma("unroll") for (int k = 0; k < 2; ++k) dst[n][k] = *(const LAS bf16x8*)(lds + PG8_SB(b, h) + boff + n * 2048 + k * 1024); } while (0)
#define PG8_MMA(ai, bj, At, Bt) do { __builtin_amdgcn_s_setprio(1); _Pragma("unroll") for (int m = 0; m < 4; ++m) _Pragma("unroll") for (int n = 0; n < 2; ++n) _Pragma("unroll") for (int k = 0; k < 2; ++k) \
        acc[ai][bj][m][n] = __builtin_amdgcn_mfma_f32_16x16x32_bf16(Bt[n][k], At[m][k], acc[ai][bj][m][n], 0, 0, 0); __builtin_amdgcn_s_setprio(0); } while (0)
#define PG8_WAIT_V(n) asm volatile("s_waitcnt vmcnt(" #n ")" ::: "memory")
#define PG8_WAIT_L(n) asm volatile("s_waitcnt lgkmcnt(" #n ")" ::: "memory")
#define PG8_BAR __builtin_amdgcn_s_barrier()
#define PG8_SCHED __builtin_amdgcn_sched_barrier(0)
  Unit cur, nxt; int ui = 0;
  if (!S.next(0, cur)) return;
  f32x4 acc[2][2][4][2];
#pragma unroll
  for (int a = 0; a < 2; ++a)
#pragma unroll
    for (int b = 0; b < 2; ++b)
#pragma unroll
      for (int m = 0; m < 4; ++m)
#pragma unroll
        for (int n = 0; n < 2; ++n) acc[a][b][m][n] = (f32x4){0.f, 0.f, 0.f, 0.f};
  bf16x8 At[4][2], B0[2][2], B1[2][2];
  const char* cA = (const char*)g.A + (size_t)cur.pm * tstep; const char* cB = (const char*)g.Bt + (size_t)cur.pn * tstep;
  PG8_STAGE(PG8_SB(0, 0), cB, voffB); PG8_STAGE(PG8_SA(0, 0), cA, voffA); PG8_STAGE(PG8_SB(0, 1), cB + hstep, voffB); PG8_STAGE(PG8_SA(0, 1), cA + hstep, voffA);
  if (wr == 1) PG8_BAR;
  PG8_WAIT_V(4); PG8_BAR;
  PG8_STAGE(PG8_SB(1, 0), cB + kstep, voffB); PG8_STAGE(PG8_SA(1, 0), cA + kstep, voffA); PG8_STAGE(PG8_SB(1, 1), cB + hstep + kstep, voffB);
  PG8_WAIT_V(6); PG8_BAR;
  for (;;) {
    const bool has_next = S.next(ui + 1, nxt);
    const char* nA = has_next ? (const char*)g.A + (size_t)nxt.pm * tstep : cA; const char* nB = has_next ? (const char*)g.Bt + (size_t)nxt.pn * tstep : cB;
    for (int t = 0; t < nt; t += 2) {
      const bool last = (t == nt - 2);
      const char* a1 = cA + (size_t)(t + 1) * kstep;
      const char* a2 = last ? nA : cA + (size_t)(t + 2) * kstep; const char* b2 = last ? nB : cB + (size_t)(t + 2) * kstep;
      const char* a3 = a2 + kstep; const char* b3 = b2 + kstep;
      PG8_LDB(B0, 0, 0); PG8_SCHED; PG8_LDA(At, 0, 0); PG8_STAGE(PG8_SA(1, 1), a1 + hstep, voffA);
      PG8_WAIT_L(8); PG8_BAR; PG8_WAIT_L(0); PG8_MMA(0, 0, At, B0); PG8_BAR; PG8_SCHED;
      PG8_LDB(B1, 0, 1); PG8_STAGE(PG8_SB(0, 0), b2, voffB);
      PG8_BAR; PG8_WAIT_L(0); PG8_MMA(0, 1, At, B1); PG8_BAR;
      PG8_LDA(At, 0, 1); PG8_STAGE(PG8_SA(0, 0), a2, voffA);
      PG8_BAR; PG8_WAIT_L(0); PG8_MMA(1, 0, At, B0); PG8_BAR; PG8_SCHED;
      PG8_STAGE(PG8_SB(0, 1), b2 + hstep, voffB);
      PG8_WAIT_V(6); PG8_BAR; PG8_MMA(1, 1, At, B1); PG8_BAR;
      PG8_LDB(B0, 1, 0); PG8_SCHED; PG8_LDA(At, 1, 0); PG8_STAGE(PG8_SA(0, 1), a2 + hstep, voffA);
      PG8_WAIT_L(8); PG8_BAR; PG8_WAIT_L(0); PG8_MMA(0, 0, At, B0); PG8_BAR; PG8_SCHED;
      PG8_LDB(B1, 1, 1); PG8_STAGE(PG8_SB(1, 0), b3, voffB);
      PG8_BAR; PG8_WAIT_L(0); PG8_MMA(0, 1, At, B1); PG8_BAR;
      PG8_LDA(At, 1, 1); PG8_STAGE(PG8_SA(1, 0), a3, voffA);
      PG8_BAR; PG8_WAIT_L(0); PG8_MMA(1, 0, At, B0); PG8_BAR; PG8_SCHED;
      PG8_STAGE(PG8_SB(1, 1), b3 + hstep, voffB);
      PG8_WAIT_V(6); PG8_BAR; PG8_MMA(1, 1, At, B1); PG8_BAR;
    }
    E(acc, cur, wr, wc, fr, fq);
    if (!has_next) break;
#pragma unroll
    for (int a = 0; a < 2; ++a)
#pragma unroll
      for (int b = 0; b < 2; ++b)
#pragma unroll
        for (int m = 0; m < 4; ++m)
#pragma unroll
          for (int n = 0; n < 2; ++n) acc[a][b][m][n] = (f32x4){0.f, 0.f, 0.f, 0.f};
    cur = nxt; cA = nA; cB = nB; ++ui;
  }
  PG8_WAIT_V(0);
  if (wr == 0) PG8_BAR;
  PG8_BAR;
#undef PG8_SA
#undef PG8_SB
#undef PG8_STAGE
#undef PG8_LDA
#undef PG8_LDB
#undef PG8_MMA
#undef PG8_WAIT_V
#undef PG8_WAIT_L
#undef PG8_BAR
#undef PG8_SCHED
}
}

struct EpiIn0 {
  static constexpr bool PERM = true;
  bf16_t* P0; _Float16* LG; const float* hlb;
  DI void operator()(const f32x4 (&acc)[2][2][4][2], const pg8::Unit& u, int wr, int wc, int fr, int fq) const {
    const int row0 = u.pm * 256 + wr * 64 + fr, pn = u.pn;
    if (pn >= 4 && pn < 8) {
#pragma unroll
      for (int bj = 0; bj < 2; ++bj) {
        const int c0 = pn * 256 + bj * 128 + wc * 32 + 8 * fq, ch = (c0 - 1024) & 511;
        float lb[8];
#pragma unroll
        for (int e = 0; e < 8; ++e) lb[e] = __builtin_amdgcn_rcpf(1.0f + __expf(hlb[512 + ch + e] - hlb[ch + e]));
#pragma unroll
        for (int ai = 0; ai < 2; ++ai)
#pragma unroll
          for (int m = 0; m < 4; ++m) {
            _Float16* dst = LG + (size_t)(row0 + ai * 128 + m * 16) * 1024 + (c0 - 1024);
            f16x8 hv;
#pragma unroll
            for (int n = 0; n < 2; ++n) {
#pragma unroll
              for (int j = 0; j < 4; ++j) { const float a = acc[ai][bj][m][n][j]; const float sg = __builtin_amdgcn_rcpf(1.0f + __expf(-a)); const float l = lb[4 * n + j]; hv[4 * n + j] = (_Float16)((1.0f - l) * (1.0f - sg)); }
            }
            *(f16x8*)dst = hv;
          }
      }
    } else {
      const bool act = (pn < 2);
      const float scl = (pn == 10) ? 0.125f : 1.0f;
#pragma unroll
      for (int bj = 0; bj < 2; ++bj) {
        const int c0 = pn * 256 + bj * 128 + wc * 32 + 8 * fq, pc = c0 < 1024 ? c0 : c0 - 1024;
#pragma unroll
        for (int ai = 0; ai < 2; ++ai)
#pragma unroll
          for (int m = 0; m < 4; ++m) {
            float v[8];
#pragma unroll
            for (int j = 0; j < 4; ++j) { v[j] = acc[ai][bj][m][0][j]; v[4 + j] = acc[ai][bj][m][1][j]; }
#pragma unroll
            for (int j = 0; j < 8; ++j) v[j] = act ? silu_f(v[j]) : v[j] * scl;
            *(u32x4*)(P0 + (size_t)(row0 + ai * 128 + m * 16) * 3072 + pc) = pack8(v);
          }
      }
    }
  }
};
struct EpiIn1 {
  static constexpr bool PERM = true;
  bf16_t* P1; const float* ropeT;
  DI void operator()(const f32x4 (&acc)[2][2][4][2], const pg8::Unit& u, int wr, int wc, int fr, int fq) const {
    const int row0 = u.pm * 256 + wr * 64 + fr, pn = u.pn;
    const bool act = false, rope = (pn < 8) && (u.pm >= 32);
    const float scl = (pn >= 4 && pn < 8) ? 0.08838834764831845f : 1.0f;
    const int i0 = 16 * (wc & 1) + 4 * fq, hf = wc >> 1;
#pragma unroll
    for (int bj = 0; bj < 2; ++bj) {
      const int c0 = pn * 256 + bj * 128 + wc * 32 + 8 * fq;
#pragma unroll
      for (int ai = 0; ai < 2; ++ai)
#pragma unroll
        for (int m = 0; m < 4; ++m) {
          const int row = row0 + ai * 128 + m * 16;
          float v[8];
#pragma unroll
          for (int j = 0; j < 4; ++j) { v[j] = acc[ai][bj][m][0][j]; v[4 + j] = acc[ai][bj][m][1][j]; }
          if (rope) {
            const int t = row & 1023, pos = hf ? (t & 63) : (t >> 6);
            const f32x4 cs = *(const f32x4*)(ropeT + pos * 32 + i0), sn = *(const f32x4*)(ropeT + 2048 + pos * 32 + i0);
#pragma unroll
            for (int q = 0; q < 4; ++q) { const float a = v[2 * q], b = v[2 * q + 1]; v[2 * q] = a * cs[q] - b * sn[q]; v[2 * q + 1] = b * cs[q] + a * sn[q]; }
          }
#pragma unroll
          for (int j = 0; j < 8; ++j) v[j] = act ? silu_f(v[j]) : v[j] * scl;
          *(u32x4*)(P1 + (size_t)row * 4096 + c0) = pack8(v);
        }
    }
  }
};
struct EpiOut {
  static constexpr bool PERM = true;
  const float* gate;
  bf16_t* delta;
  DI void operator()(const f32x4 (&acc)[2][2][4][2], const pg8::Unit& u, int wr, int wc, int fr, int fq) const {
    const int pm = u.pm, row0 = pm * 256 + wr * 64 + fr, col0 = u.pn * 256 + wc * 32 + 8 * fq;
    const int cond = pm < 32 ? 0 : 1 + ((pm - 32) >> 2);
    const float* gp = gate + cond * 3072 + 2048 + col0;
    f32x4 gv[2][2];
#pragma unroll
    for (int bj = 0; bj < 2; ++bj)
#pragma unroll
      for (int n = 0; n < 2; ++n) gv[bj][n] = *(const f32x4*)(gp + bj * 128 + n * 4);
#pragma unroll
    for (int ai = 0; ai < 2; ++ai)
#pragma unroll
      for (int m = 0; m < 4; ++m) {
        bf16_t* dst = delta + (size_t)(row0 + ai * 128 + m * 16) * 1024 + col0;
#pragma unroll
        for (int bj = 0; bj < 2; ++bj) {
          const f32x4 a = gv[bj][0] * acc[ai][bj][m][0], b = gv[bj][1] * acc[ai][bj][m][1];
          u32x4 w; w.x = cvt_pk_bf16(a[0], a[1]); w.y = cvt_pk_bf16(a[2], a[3]); w.z = cvt_pk_bf16(b[0], b[1]); w.w = cvt_pk_bf16(b[2], b[3]);
          *(u32x4*)(dst + bj * 128) = w;
        }
      }
  }
};

template <bool PERMQK>
DI void tr_tile2(const float* __restrict__ W, const int N, bf16_t* __restrict__ Bt, const int nTn, const int t0, const int ntiles, float* tile) {
  const int tid = opaque_i((int)threadIdx.x);
  const int r = tid >> 4, c4 = (tid & 15) * 4;
  f32x4 v[2][2];
#pragma unroll
  for (int h = 0; h < 2; ++h) {
    const int t = min(t0 + h, ntiles - 1), k0 = (t / nTn) * 64, n0 = (t % nTn) * 64;
#pragma unroll
    for (int rr = 0; rr < 2; ++rr) {
      v[h][rr] = (f32x4){0.f, 0.f, 0.f, 0.f};
      if (n0 + c4 < N) v[h][rr] = *(const f32x4*)(W + (size_t)(k0 + r + 32 * rr) * N + n0 + c4);
    }
  }
#pragma unroll
  for (int h = 0; h < 2; ++h)
#pragma unroll
    for (int rr = 0; rr < 2; ++rr) { float* d = tile + h * 4160 + (r + 32 * rr) * 65 + c4; d[0] = v[h][rr][0]; d[1] = v[h][rr][1]; d[2] = v[h][rr][2]; d[3] = v[h][rr][3]; }
  __syncthreads();
  const int n = tid >> 3, k8 = (tid & 7) * 8;
#pragma unroll
  for (int h = 0; h < 2; ++h) {
    const int t = t0 + h;
    if (t < ntiles) {
      const int k0 = (t / nTn) * 64, n0 = (t % nTn) * 64;
      if (n0 + n < N) {
        float o[8];
#pragma unroll
        for (int j = 0; j < 8; ++j) o[j] = tile[h * 4160 + (k8 + j) * 65 + n];
        int nr = n0 + n;
        if (PERMQK && nr < 2048) { const int d = nr & 127; nr = (nr & ~127) + 64 * (d >> 6) + 2 * (d & 31) + ((d >> 5) & 1); }
        *(u32x4*)(Bt + (size_t)nr * 1024 + k0 + k8) = pack8(o);
      }
    }
  }
  __syncthreads();
}
DI void phase0b_transposes(const Params& p, unsigned char* shm) {
  const int nb = gridDim.x, bid = blockIdx.x;
  float* tile = (float*)shm;
  for (int t = 2 * bid; t < 1040; t += 2 * nb) tr_tile2<false>(p.w_in_even, 4128, (bf16_t*)(p.ws + OFF_BTIN0), 65, t, 1040, tile);
}
DI void prep_layer1(const Params& p, unsigned char* shm, const int slot, const int nsl) {
  float* tile = (float*)shm;
  for (int t = 2 * slot; t < 1024; t += 2 * nsl) tr_tile2<true>(p.w_in_odd, 4096, (bf16_t*)(p.ws + OFF_BTIN1), 64, t, 1024, tile);
  for (int t = 2 * (nsl - 1 - slot); t < 256; t += 2 * nsl) tr_tile2<false>(p.w_out_odd, 1024, (bf16_t*)(p.ws + OFF_BTOUT1), 16, t, 256, tile);
  for (int t = 2 * (nsl - 1 - slot); t < 256; t += 2 * nsl) tr_tile2<false>(p.w_out_even, 1024, (bf16_t*)(p.ws + OFF_BTOUT0), 16, t, 256, tile);
}
DI void mod_partials(const Params& p, const int l, const int gw, const int nw) {
  const int lane = opaque_i((int)threadIdx.x) & 63;
  float* modp = (float*)(p.ws + OFF_MODP);
  for (int it = gw; it < 384; it += nw) {
    const int ks = it & 7, cgp = it >> 3;
    float a0 = 0.f, a1 = 0.f, a2 = 0.f, a3 = 0.f, a4 = 0.f;
    const float* wp = p.ada_w + (size_t)l * 1024 * 3072 + (size_t)(ks * 128) * 3072 + cgp * 64 + lane;
#pragma unroll 1
    for (int hh = 0; hh < 2; ++hh) {
      const int k = ks * 128 + hh * 64 + lane;
      const float s0 = silu_f(p.c_ctx[k]), s1 = silu_f(p.c[k]), s2 = silu_f(p.c[1024 + k]), s3 = silu_f(p.c[2048 + k]), s4 = silu_f(p.c[3072 + k]);
#pragma unroll 16
      for (int kk = 0; kk < 64; ++kk) {
        const float w = wp[(size_t)(hh * 64 + kk) * 3072];
        a0 += __shfl(s0, kk) * w; a1 += __shfl(s1, kk) * w; a2 += __shfl(s2, kk) * w; a3 += __shfl(s3, kk) * w; a4 += __shfl(s4, kk) * w;
      }
    }
    float* mo = modp + ((size_t)(ks * 2 + l) * 5) * 3072 + cgp * 64 + lane;
    mo[0] = a0; mo[3072] = a1; mo[6144] = a2; mo[9216] = a3; mo[12288] = a4;
  }
}
DI void phase0(const Params& p, unsigned char* shm) {
  const int tid = opaque_i((int)threadIdx.x), nb = gridDim.x, bid = blockIdx.x;
  mod_partials(p, 0, bid * 8 + (tid >> 6), nb * 8);
  float* rope = (float*)(p.ws + OFF_ROPE);
  for (int i = bid * 512 + tid; i < 2048; i += nb * 512) {
    const int pos = i >> 5, fi = i & 31;
    const float inv = exp2f(-(float)(2 * fi) * (13.287712379549449f / 64.0f));
    const float ang = (float)pos * inv;
    const double kq = rint((double)ang * 0.15915494309189535);
    const float rr = (float)((double)ang - kq * 6.283185307179586);
    rope[i] = __cosf(rr);
    rope[2048 + i] = __sinf(rr);
  }
}

DI void phase_norm_mod(const Params& p, int l, bool with_delta) {
  const int tid = opaque_i((int)threadIdx.x), nb = gridDim.x, bid = blockIdx.x, wid = tid >> 6, lane = tid & 63, gw = bid * 8 + wid, nw = nb * 8;
  const float* modp = (const float*)(p.ws + OFF_MODP);
  bf16_t* A = (bf16_t*)(p.ws + OFF_A);
  {
    float* mod = (float*)(p.ws + OFF_MOD);
    for (int i = l * 15360 + bid * 512 + tid; i < (l + 1) * 15360; i += nb * 512) {
      float s = p.ada_b[(i / 15360) * 3072 + (i % 3072)];
#pragma unroll
      for (int ks = 0; ks < 8; ++ks) s += modp[ks * 30720 + i];
      mod[i] = s;
    }
  }
  const int rpw = (TALL + nw - 1) / nw;
  int cur = -1;
  f32x4 sc[4], sh[4], nwv[4];
#pragma unroll
  for (int i = 0; i < 4; ++i) { nwv[i] = *(const f32x4*)(p.norm_w + l * 1024 + lane * 4 + 256 * i); sc[i] = (f32x4){0.f, 0.f, 0.f, 0.f}; sh[i] = sc[i]; }
  const int rend = min(TALL, (gw + 1) * rpw);
  for (int rb = gw * rpw; rb < rend; rb += 6) {
    f32x4 x[6][4];
#pragma unroll
    for (int j = 0; j < 6; ++j) {
      const int r = min(rb + j, rend - 1);
      const float* src = r < TCTX ? p.x_prompt + (size_t)r * 1024 : p.x_sample + (size_t)(r - TCTX) * 1024;
#pragma unroll
      for (int i = 0; i < 4; ++i) x[j][i] = *(const f32x4*)(src + lane * 4 + 256 * i);
      if (with_delta) {
        const bf16_t* dp = (const bf16_t*)(p.ws + OFF_D0) + (size_t)r * 1024 + lane * 4;
#pragma unroll
        for (int i = 0; i < 4; ++i) { const u32x2 dv = *(const u32x2*)(dp + 256 * i); x[j][i] += (f32x4){bf_lo(dv.x), bf_hi(dv.x), bf_lo(dv.y), bf_hi(dv.y)}; }
      }
    }
#pragma unroll
    for (int j = 0; j < 6; ++j) {
      const int r = rb + j;
      if (r < rend) {
        const int cond = r < TCTX ? 0 : 1 + ((r - TCTX) >> 10);
        if (cond != cur) {
          cur = cond;
#pragma unroll
          for (int i = 0; i < 4; ++i) {
            const int col = lane * 4 + 256 * i;
            f32x4 a = *(const f32x4*)(p.ada_b + l * 3072 + col), b = *(const f32x4*)(p.ada_b + l * 3072 + 1024 + col);
#pragma unroll 2
            for (int ks = 0; ks < 8; ++ks) {
              const float* mp = modp + ((size_t)(ks * 2 + l) * 5 + cond) * 3072 + col;
              a += *(const f32x4*)mp; b += *(const f32x4*)(mp + 1024);
            }
            sh[i] = a; sc[i] = b;
          }
        }
        float ss = 0.f;
#pragma unroll
        for (int i = 0; i < 4; ++i) ss += x[j][i][0] * x[j][i][0] + x[j][i][1] * x[j][i][1] + x[j][i][2] * x[j][i][2] + x[j][i][3] * x[j][i][3];
        ss = wave_sum(ss);
        const float rstd = rsqrtf(ss * (1.0f / 1024.0f) + 1e-6f);
#pragma unroll
        for (int i = 0; i < 4; ++i) {
          f32x4 h = x[j][i] * rstd * nwv[i] * (sc[i] + 1.0f) + sh[i];
          u32x2 w; w.x = cvt_pk_bf16(h[0], h[1]); w.y = cvt_pk_bf16(h[2], h[3]);
          *(u32x2*)(A + (size_t)r * 1024 + lane * 4 + 256 * i) = w;
        }
      }
    }
  }
}

DI void phase_tail(const Params& p, unsigned char* shm) {
  const int tid = opaque_i((int)threadIdx.x), nb = gridDim.x, bid = blockIdx.x, wid = tid >> 6, lane = tid & 63;
  const int r16 = lane & 15, g = lane >> 4;
  float* part = (float*)shm;
  float* lowS = (float*)(shm + 50688);
  const bf16_t* A = (const bf16_t*)(p.ws + OFF_A);
  const bf16_t* Bt = (const bf16_t*)(p.ws + OFF_BTIN0) + (size_t)4096 * 1024;
  _Float16* GG = (_Float16*)(p.ws + OFF_GG);
  const int gd = tid >> 8, gc = tid & 255;
  float w[16];
#pragma unroll
  for (int r = 0; r < 16; ++r) w[r] = p.gla_gk_w[(gd * 16 + r) * 256 + gc];
  const float gb = p.gla_gk_b[gd * 256 + gc];
  for (int grp = bid; grp < TALL / 48; grp += nb) {
    const int row0 = grp * 48;
    {
      f32x4 acc[3][2];
#pragma unroll
      for (int j = 0; j < 3; ++j) { acc[j][0] = (f32x4){0.f, 0.f, 0.f, 0.f}; acc[j][1] = acc[j][0]; }
      const bf16_t* ap = A + (size_t)(row0 + r16) * 1024 + wid * 128 + 8 * g;
      const bf16_t* bp = Bt + (size_t)r16 * 1024 + wid * 128 + 8 * g;
#pragma unroll
      for (int ks = 0; ks < 4; ++ks) {
        const bf16x8 x0 = *(const bf16x8*)(bp + ks * 32), x1 = *(const bf16x8*)(bp + 16 * 1024 + ks * 32);
#pragma unroll
        for (int j = 0; j < 3; ++j) {
          const bf16x8 a = *(const bf16x8*)(ap + (size_t)j * 16 * 1024 + ks * 32);
          acc[j][0] = __builtin_amdgcn_mfma_f32_16x16x32_bf16(a, x0, acc[j][0], 0, 0, 0);
          acc[j][1] = __builtin_amdgcn_mfma_f32_16x16x32_bf16(a, x1, acc[j][1], 0, 0, 0);
        }
      }
#pragma unroll
      for (int j = 0; j < 3; ++j)
#pragma unroll
        for (int i = 0; i < 4; ++i) {
          float* d = part + ((wid * 3 + j) * 16 + 4 * g + i) * 33;
          d[r16] = acc[j][0][i]; d[16 + r16] = acc[j][1][i];
        }
    }
    __syncthreads();
    for (int e = tid; e < 1536; e += 512) {
      const int rr = e >> 5, c = e & 31, j = rr >> 4, r = rr & 15;
      float sum = 0.f;
#pragma unroll
      for (int w = 0; w < 8; ++w) sum += part[((w * 3 + j) * 16 + r) * 33 + c];
      lowS[rr * 36 + c] = sum;
    }
    __syncthreads();
    {
#pragma unroll 4
      for (int t = 0; t < 48; ++t) {
        const f32x4 l0 = *(const f32x4*)(lowS + t * 36 + 16 * gd), l1 = *(const f32x4*)(lowS + t * 36 + 16 * gd + 4),
                    l2 = *(const f32x4*)(lowS + t * 36 + 16 * gd + 8), l3 = *(const f32x4*)(lowS + t * 36 + 16 * gd + 12);
        float s0 = gb, s1 = 0.f, s2 = 0.f, s3 = 0.f;
#pragma unroll
        for (int r = 0; r < 4; ++r) { s0 += l0[r] * w[r]; s1 += l1[r] * w[4 + r]; s2 += l2[r] * w[8 + r]; s3 += l3[r] * w[12 + r]; }
        GG[(size_t)(row0 + t) * 512 + tid] = (_Float16)(1.0f - __expf(logsigmoid_f((s0 + s1) + (s2 + s3)) * 0.0625f));
      }
    }
    __syncthreads();
  }
}

enum { T_HGRN = 0, T_GLA = 1, T_RET = 2 };
#define MFMA16(a, b, c) __builtin_amdgcn_mfma_f32_16x16x32_bf16((a), (b), (c), 0, 0, 0)
DI bf16x8 ld_frag(const bf16_t* base) {
  const s16x4 lo = *(const s16x4*)base, hi = *(const s16x4*)(base + 16);
  return __builtin_shufflevector(lo, hi, 0, 1, 2, 3, 4, 5, 6, 7);
}
DI bf16x8 ld_frag_tr(const bf16_t* base, int hi_off) {
  const s16x4 lo = __builtin_amdgcn_ds_read_tr16_b64_v4i16((LAS s16x4*)base), hi = __builtin_amdgcn_ds_read_tr16_b64_v4i16((LAS s16x4*)(base + hi_off));
  return __builtin_shufflevector(lo, hi, 0, 1, 2, 3, 4, 5, 6, 7);
}
DI bf16x8 pack_frag(const f32x4& a, const f32x4& b) {
  u32x4 w; w.x = cvt_pk_bf16(a[0], a[1]); w.y = cvt_pk_bf16(a[2], a[3]); w.z = cvt_pk_bf16(b[0], b[1]); w.w = cvt_pk_bf16(b[2], b[3]);
  return __builtin_bit_cast(bf16x8, w);
}

struct LoadSet { u32x4 q, k, v, qp, kp, lg; f32x4 c0, c1, s0, s1; };
template <int KD, int TYPE>
DI void scan_unit(unsigned char* shm, const bf16_t* Pq, const bf16_t* Pk, const bf16_t* Pv, int PS, const _Float16* lgp, int LS, float lgs,
                  const float* s0, float* sout, bf16_t* O, int rowbase, int Tlen, int dir, const float* sdummy, bool rope) {
  const float* ropeT = sdummy;
  constexpr int QS = KD + 8, NP = KD / 32, NKT = KD / 16;
  constexpr int BUFB = 35840, VS = 136;
  const int tid = opaque_i((int)threadIdx.x), wid = tid >> 6, lane = tid & 63, r16 = lane & 15, g = lane >> 4;
  const bool active = wid < KD / 16;
  const int ei = lane & 31, c8 = (16 * wid + 8 * (lane >> 5)) & (KD - 1);
  const int vi = tid >> 4, j8 = (tid & 15) * 8;
  const int jcol = 16 * wid + r16;

  f32x4 accS[NKT];
#pragma unroll
  for (int kt = 0; kt < NKT; ++kt)
#pragma unroll
    for (int i = 0; i < 4; ++i) { const float sv = (s0 ? s0 : sdummy)[(size_t)(16 * kt + 4 * g + i) * 128 + jcol]; accS[kt][i] = s0 ? sv : 0.f; }

  const int nsteps = Tlen >> 5;
  LoadSet LA, LB;
  LA.q = (u32x4){0u, 0u, 0u, 0u}; LA.k = LA.q; LA.v = LA.q; LA.qp = LA.q; LA.kp = LA.q; LA.lg = LA.q;
  LA.c0 = (f32x4){0.f, 0.f, 0.f, 0.f}; LA.c1 = LA.c0; LA.s0 = LA.c0; LA.s1 = LA.c0;
  LB = LA;
  const int eiL = ei;
  auto issue_loads = [&](int n, LoadSet& X) {
    const int tb = 32 * n;
    const int tokE = dir ? Tlen - 1 - (tb + eiL) : tb + eiL;
    const int tokV = dir ? Tlen - 1 - (tb + vi) : tb + vi;
    const size_t ro = (size_t)(rowbase + tokE) * PS;
    X.q = *(const u32x4*)(Pq + ro + c8);
    if (TYPE != T_RET) X.lg = *(const u32x4*)(lgp + (size_t)(rowbase + tokE) * LS + c8);
    if (TYPE != T_HGRN) X.k = *(const u32x4*)(Pk + ro + c8);
    if (TYPE == T_RET) {
      X.qp = *(const u32x4*)(Pq + ro + (c8 ^ 32)); X.kp = *(const u32x4*)(Pk + ro + (c8 ^ 32));
      const int pos = (c8 < 64) ? (tokE >> 6) : (tokE & 63);
      const float* rp = ropeT + pos * 32 + (c8 & 31);
      X.c0 = *(const f32x4*)rp; X.c1 = *(const f32x4*)(rp + 4); X.s0 = *(const f32x4*)(rp + 2048); X.s1 = *(const f32x4*)(rp + 2052);
    }
    X.v = *(const u32x4*)(Pv + (size_t)(rowbase + tokV) * PS + j8);
  };
  auto step = [&](int n, LoadSet& X) {
    const int tb = 32 * n;
    unsigned char* buf = shm + (n & 1) * BUFB;
    bf16_t* QR = (bf16_t*)buf;
    bf16_t* KI = (bf16_t*)(buf + 8704);
    bf16_t* KDm = (bf16_t*)(buf + 17408);
    bf16_t* Vm = (bf16_t*)(buf + 26112);
    float* EV = (float*)(buf + 34816);
    if (active) {
      float pf[8], q[8], kk[8];
      const f16x8 hl = __builtin_bit_cast(f16x8, X.lg);
#pragma unroll
      for (int e = 0; e < 8; ++e) { const float v1 = (float)hl[e]; pf[e] = 1.0f - v1; if (TYPE == T_HGRN) kk[e] = v1; }
      unpack8(X.q, q);
      if (TYPE != T_HGRN) unpack8(X.k, kk);
#define DPP_MUL(ctrl) _Pragma("unroll") for (int e = 0; e < 8; ++e) pf[e] *= __builtin_bit_cast(float, __builtin_amdgcn_update_dpp(0x3f800000, __builtin_bit_cast(int, pf[e]), ctrl, 0xf, 0xf, false))
      DPP_MUL(0x111);
      DPP_MUL(0x112);
      DPP_MUL(0x114);
      DPP_MUL(0x118);
#undef DPP_MUL
      float qr[8], ki[8], kd[8], p15v[8];
      const int lR = ((lane & 32) | 15) << 2, lL = (lane | 31) << 2;
      const bool second = (lane & 16) != 0;
#pragma unroll
      for (int e = 0; e < 8; ++e) {
        const float pc = fmaxf(pf[e], 1e-30f);
        const float p15 = fmaxf(__builtin_bit_cast(float, __builtin_amdgcn_ds_bpermute(lR, __builtin_bit_cast(int, pf[e]))), 1e-30f);
        const float r = __builtin_amdgcn_rcpf(pc), rp = __builtin_amdgcn_rcpf(p15);
        const float er = second ? pc : pc * rp, ek = second ? r : p15 * r;
        const float er31 = __builtin_bit_cast(float, __builtin_amdgcn_ds_bpermute(lL, __builtin_bit_cast(int, er)));
        qr[e] = q[e] * er; ki[e] = kk[e] * ek; kd[e] = ki[e] * er31;
        p15v[e] = p15;
      }
      if ((lane & 15) == 15) {
        float* evp = EV + (second ? 0 : 128) + c8;
#pragma unroll
        for (int e = 0; e < 8; ++e) evp[e] = second ? p15v[e] * pf[e] : pf[e];
      }
      *(u32x4*)(QR + ei * QS + c8) = pack8(qr);
      *(u32x4*)(KI + ei * QS + c8) = pack8(ki);
      *(u32x4*)(KDm + ei * QS + c8) = pack8(kd);
    }
    *(u32x4*)(Vm + vi * VS + j8) = X.v;
    issue_loads(min(n + 2, nsteps - 1), X);
    __syncthreads();
    {
      const int tq = r16 >> 2, tp = r16 & 3;
      const bf16x8 vfrag = ld_frag_tr(Vm + (4 * g + tq) * VS + 16 * wid + 4 * tp, 16 * VS);
      bf16x8 qf[2][NP];
#pragma unroll
      for (int tt = 0; tt < 2; ++tt)
#pragma unroll
        for (int pp = 0; pp < NP; ++pp) qf[tt][pp] = ld_frag(QR + (16 * tt + r16) * QS + 32 * pp + 4 * g);
      f32x4 sc00 = (f32x4){0.f, 0.f, 0.f, 0.f}, sc01 = sc00, sc11 = sc00;
#pragma unroll
      for (int pp = 0; pp < NP; ++pp) {
        const bf16x8 kf0 = ld_frag(KI + r16 * QS + 32 * pp + 4 * g), kf1 = ld_frag(KI + (16 + r16) * QS + 32 * pp + 4 * g);
        sc00 = MFMA16(kf0, qf[0][pp], sc00); sc01 = MFMA16(kf0, qf[1][pp], sc01); sc11 = MFMA16(kf1, qf[1][pp], sc11);
      }
#pragma unroll
      for (int i = 0; i < 4; ++i) if (4 * g + i > r16) { sc00[i] = 0.f; sc11[i] = 0.f; }
      const f32x4 z4 = (f32x4){0.f, 0.f, 0.f, 0.f};
      const bf16x8 pf0 = pack_frag(sc00, z4), pf1 = pack_frag(sc01, sc11);
      f32x4 o0 = MFMA16(vfrag, pf0, z4), o1 = MFMA16(vfrag, pf1, z4);
#pragma unroll
      for (int pp = 0; pp < NP; ++pp) {
        f32x4 e0, e1;
        e0 = *(const f32x4*)(EV + 128 + 32 * pp + 4 * g); e1 = *(const f32x4*)(EV + 128 + 32 * pp + 16 + 4 * g);
        const bf16x8 sf = pack_frag(accS[2 * pp] * e0, accS[2 * pp + 1] * e1);
        o0 = MFMA16(sf, qf[0][pp], o0); o1 = MFMA16(sf, qf[1][pp], o1);
      }
#pragma unroll
      for (int kt = 0; kt < NKT; ++kt) {
        f32x4 eb;
        eb = *(const f32x4*)(EV + 16 * kt + 4 * g);
        const bf16x8 kdf = ld_frag_tr(KDm + (4 * g + tq) * QS + 16 * kt + 4 * tp, 16 * QS);
        accS[kt] = MFMA16(kdf, vfrag, accS[kt] * eb);
      }
      {
        const int t0 = tb + r16, t1 = tb + 16 + r16;
        const int tok0 = dir ? Tlen - 1 - t0 : t0, tok1 = dir ? Tlen - 1 - t1 : t1;
        u32x2 w0, w1; w0.x = cvt_pk_bf16(o0[0], o0[1]); w0.y = cvt_pk_bf16(o0[2], o0[3]); w1.x = cvt_pk_bf16(o1[0], o1[1]); w1.y = cvt_pk_bf16(o1[2], o1[3]);
        *(u32x2*)(O + (size_t)(rowbase + tok0) * 1024 + 16 * wid + 4 * g) = w0;
        *(u32x2*)(O + (size_t)(rowbase + tok1) * 1024 + 16 * wid + 4 * g) = w1;
      }
    }
  };
  issue_loads(0, LA);
  issue_loads(1, LB);
  for (int n = 0; n < nsteps; n += 2) { step(n, LA); step(n + 1, LB); }
  if (sout) {
#pragma unroll
    for (int kt = 0; kt < NKT; ++kt)
#pragma unroll
      for (int i = 0; i < 4; ++i) sout[(size_t)(16 * kt + 4 * g + i) * 128 + jcol] = accS[kt][i];
  }
  __syncthreads();
}


struct LoadSet3 { u32x4 q, k, v; };
DI int ret_lrow(int pk) { const int pp = pk >> 1; return 64 * (pp >> 5) + (pp & 31) + 32 * (pk & 1); }
DI void scan_unit_ret(unsigned char* shm, const bf16_t* Pq, const bf16_t* Pk, const bf16_t* Pv, float lgs, const float* s0, float* sout, bf16_t* O,
                      int rowbase, int Tlen, int dir, const float* sdummy) {
  constexpr int QS = 136, NP = 4, NKT = 8, PS = 4096, BUFB = 3 * 8704;
  const int tid = opaque_i((int)threadIdx.x), wid = tid >> 6, lane = tid & 63, r16 = lane & 15, g = lane >> 4;
  const int ei = tid >> 4, c8 = (tid & 15) * 8;
  const int jcol = 16 * wid + r16;
  f32x4 accS[NKT];
#pragma unroll
  for (int kt = 0; kt < NKT; ++kt)
#pragma unroll
    for (int i = 0; i < 4; ++i) { const float sv = (s0 ? s0 : sdummy)[(size_t)ret_lrow(16 * kt + 4 * g + i) * 128 + jcol]; accS[kt][i] = s0 ? sv : 0.f; }
  f32x4 dm, d01; float cs[8];
#pragma unroll
  for (int i = 0; i < 4; ++i) { const int dd = r16 - 4 * g - i; dm[i] = dd >= 0 ? __expf((float)dd * lgs) : 0.f; d01[i] = __expf((float)(16 + dd) * lgs); }
#pragma unroll
  for (int j = 0; j < 8; ++j) cs[j] = __expf((float)(31 - (16 * (j >> 2) + 4 * g + (j & 3))) * lgs);
  const float ct0 = __expf((float)(r16 + 1) * lgs), ct1 = __expf((float)(r16 + 17) * lgs), eb = __expf(32.0f * lgs);
  const int nsteps = Tlen >> 5;
  LoadSet3 LA, LB;
  auto issue_loads = [&](int n, LoadSet3& X) {
    const int tok = dir ? Tlen - 1 - (32 * n + ei) : 32 * n + ei;
    const size_t ro = (size_t)(rowbase + tok) * PS + c8;
    X.q = *(const u32x4*)(Pq + ro); X.k = *(const u32x4*)(Pk + ro); X.v = *(const u32x4*)(Pv + ro);
  };
  auto step = [&](int n, LoadSet3& X) {
    const int tb = 32 * n;
    unsigned char* buf = shm + (n & 1) * BUFB;
    bf16_t* Qm = (bf16_t*)buf; bf16_t* Km = (bf16_t*)(buf + 8704); bf16_t* Vm = (bf16_t*)(buf + 17408);
    *(u32x4*)(Qm + ei * QS + c8) = X.q;
    *(u32x4*)(Km + ei * QS + c8) = X.k;
    *(u32x4*)(Vm + ei * QS + c8) = X.v;
    issue_loads(min(n + 2, nsteps - 1), X);
    __syncthreads();
    const int tq = r16 >> 2, tp = r16 & 3;
    const bf16x8 vfrag = ld_frag_tr(Vm + (4 * g + tq) * QS + 16 * wid + 4 * tp, 16 * QS);
    bf16x8 qf[2][NP];
#pragma unroll
    for (int tt = 0; tt < 2; ++tt)
#pragma unroll
      for (int pp = 0; pp < NP; ++pp) qf[tt][pp] = ld_frag(Qm + (16 * tt + r16) * QS + 32 * pp + 4 * g);
    f32x4 sc00 = (f32x4){0.f, 0.f, 0.f, 0.f}, sc01 = sc00, sc11 = sc00;
#pragma unroll
    for (int pp = 0; pp < NP; ++pp) {
      const bf16x8 kf0 = ld_frag(Km + r16 * QS + 32 * pp + 4 * g), kf1 = ld_frag(Km + (16 + r16) * QS + 32 * pp + 4 * g);
      sc00 = MFMA16(kf0, qf[0][pp], sc00); sc01 = MFMA16(kf0, qf[1][pp], sc01); sc11 = MFMA16(kf1, qf[1][pp], sc11);
    }
    const f32x4 z4 = (f32x4){0.f, 0.f, 0.f, 0.f};
    const bf16x8 pf0 = pack_frag(sc00 * dm, z4), pf1 = pack_frag(sc01 * d01, sc11 * dm);
    f32x4 o0 = MFMA16(vfrag, pf0, z4), o1 = MFMA16(vfrag, pf1, z4);
    f32x4 oi0 = z4, oi1 = z4;
#pragma unroll
    for (int pp = 0; pp < NP; ++pp) {
      const bf16x8 sf = pack_frag(accS[2 * pp], accS[2 * pp + 1]);
      oi0 = MFMA16(sf, qf[0][pp], oi0); oi1 = MFMA16(sf, qf[1][pp], oi1);
    }
    o0 += oi0 * ct0; o1 += oi1 * ct1;
    bf16x8 vsf;
    {
      float vv[8];
      unpack8(__builtin_bit_cast(u32x4, vfrag), vv);
#pragma unroll
      for (int j = 0; j < 8; ++j) vv[j] *= cs[j];
      vsf = __builtin_bit_cast(bf16x8, pack8(vv));
    }
#pragma unroll
    for (int kt = 0; kt < NKT; ++kt) {
      const bf16x8 kdf = ld_frag_tr(Km + (4 * g + tq) * QS + 16 * kt + 4 * tp, 16 * QS);
      accS[kt] = MFMA16(kdf, vsf, accS[kt] * eb);
    }
    {
      const int t0 = tb + r16, t1 = tb + 16 + r16;
      const int tok0 = dir ? Tlen - 1 - t0 : t0, tok1 = dir ? Tlen - 1 - t1 : t1;
      u32x2 w0, w1; w0.x = cvt_pk_bf16(o0[0], o0[1]); w0.y = cvt_pk_bf16(o0[2], o0[3]); w1.x = cvt_pk_bf16(o1[0], o1[1]); w1.y = cvt_pk_bf16(o1[2], o1[3]);
      *(u32x2*)(O + (size_t)(rowbase + tok0) * 1024 + 16 * wid + 4 * g) = w0;
      *(u32x2*)(O + (size_t)(rowbase + tok1) * 1024 + 16 * wid + 4 * g) = w1;
    }
  };
  issue_loads(0, LA);
  issue_loads(1, LB);
  for (int n = 0; n < nsteps; n += 2) { step(n, LA); step(n + 1, LB); }
  if (sout) {
#pragma unroll
    for (int kt = 0; kt < NKT; ++kt)
#pragma unroll
      for (int i = 0; i < 4; ++i) sout[(size_t)ret_lrow(16 * kt + 4 * g + i) * 128 + jcol] = accS[kt][i];
  }
  __syncthreads();
}

DI int scan_unit_id(int k, int bid, int nb) {
  if (nb == 256) {
    if (bid < 64) return k == 0 ? bid : -1;
    const int j = bid - 64;
    if (k == 0) return 64 + j;
    if (k == 1) return 64 + 192 + j;
    if (k == 2 && j < 128) return 64 + 384 + j;
    return -1;
  }
  const int u = bid + k * nb;
  return u < 576 ? u : -1;
}

DI void phase_scan(const Params& p, int layer, unsigned char* shm) {
  const int bid = blockIdx.x, nb = gridDim.x;
  bf16_t* OF = (bf16_t*)(p.ws + OFF_OF); bf16_t* OB = (bf16_t*)(p.ws + OFF_OB);
  const bf16_t* P = (const bf16_t*)(p.ws + OFF_P);
  for (int k = 0;; ++k) {
    const int u = scan_unit_id(k, bid, nb);
    if (u < 0) break;
    const bool lat = u < 64;
    const int v = lat ? u : u - 64;
    if (layer == 0) {
      const int half = lat ? 32 : 256;
      const bool gla = v >= half;
      const int idx = gla ? v - half : v;
      const int b = idx >> 3, h = (idx >> 1) & 3, d = idx & 1;
      const int rowbase = lat ? TCTX + b * 1024 : b * 256, Tlen = lat ? 1024 : 256;
      bf16_t* O = (d ? OB : OF);
      if (!gla) {
        const float* s0 = lat ? p.state_hgrn + (size_t)((b * 2 + d) * 4 + h) * 16384 : nullptr;
        float* so = lat ? nullptr : p.out + OUT_HGRN + (size_t)((b * 2 + d) * 4 + h) * 16384;
        scan_unit<128, T_HGRN>(shm, P + h * 128, nullptr, P + 512 + h * 128, 3072, (const _Float16*)(p.ws + OFF_LG) + d * 512 + h * 128, 1024, 0.f, s0, so,
                               O + h * 128, rowbase, Tlen, d, p.state_hgrn, false);
      } else {
        const float* s0 = lat ? p.state_gla + (size_t)((b * 2 + d) * 4 + h) * 8192 : nullptr;
        float* so = lat ? nullptr : p.out + OUT_GLA + (size_t)((b * 2 + d) * 4 + h) * 8192;
        scan_unit<64, T_GLA>(shm, P + 1536 + h * 64, P + 1792 + h * 64, P + 2048 + h * 128, 3072, (const _Float16*)(p.ws + OFF_GG) + d * 256 + h * 64, 512, 0.f,
                             s0, so, O + 512 + h * 128, rowbase, Tlen, d, p.state_hgrn, false);
      }
    } else {
      const int b = v >> 4, h = (v >> 1) & 7, d = v & 1;
      const int rowbase = lat ? TCTX + b * 1024 : b * 256, Tlen = lat ? 1024 : 256;
      const float* s0 = lat ? p.state_ret + (size_t)((b * 2 + d) * 8 + h) * 16384 : nullptr;
      float* so = lat ? nullptr : p.out + OUT_RET + (size_t)((b * 2 + d) * 8 + h) * 16384;
      const float lgs = logsigmoid_f(p.ret_decay[d * 8 + h]);
      scan_unit_ret(shm, P + h * 128, P + 1024 + h * 128, P + 2048 + h * 128, lgs, s0, so, (d ? OB : OF) + h * 128, rowbase, Tlen, d, p.state_ret);
    }
  }
  if (layer == 0) {
    const bool sp = (nb == 256);
    const int slot = sp ? bid - 64 : bid, nsl = sp ? 192 : nb;
    if (slot >= 0) {
      prep_layer1(p, shm, slot, nsl);
      mod_partials(p, 1, slot * 8 + ((int)threadIdx.x >> 6), nsl * 8);
    }
  }
}

DI void phase_combine(const Params& p, int layer) {
  const int tid = opaque_i((int)threadIdx.x), nb = gridDim.x, bid = blockIdx.x, wid = tid >> 6, lane = tid & 63, gw = bid * 8 + wid, nw = nb * 8;
  const bf16_t* OF = (const bf16_t*)(p.ws + OFF_OF); const bf16_t* OB = (const bf16_t*)(p.ws + OFF_OB);
  const bf16_t* P = (const bf16_t*)(p.ws + OFF_P);
  bf16_t* A = (bf16_t*)(p.ws + OFF_A);
  const float* gn = layer == 0 ? p.gn_even : p.gn_odd;
  const int c0 = lane * 16;
  float gnv[16];
#pragma unroll
  for (int i = 0; i < 16; ++i) gnv[i] = gn[c0 + i];
  for (int rb = gw; rb < TALL; rb += 6 * nw) {
    u32x4 rf[6][2], rbk[6][2], rg[6][2];
#pragma unroll
    for (int j = 0; j < 6; ++j) {
      const int r = min(rb + j * nw, TALL - 1);
      const bf16_t* gp = layer == 0 ? P + (size_t)r * 3072 + (c0 < 512 ? 1024 + c0 : 2048 + c0) : P + (size_t)r * 4096 + 3072 + c0;
      rf[j][0] = *(const u32x4*)(OF + (size_t)r * 1024 + c0); rf[j][1] = *(const u32x4*)(OF + (size_t)r * 1024 + c0 + 8);
      rbk[j][0] = *(const u32x4*)(OB + (size_t)r * 1024 + c0); rbk[j][1] = *(const u32x4*)(OB + (size_t)r * 1024 + c0 + 8);
      rg[j][0] = *(const u32x4*)gp; rg[j][1] = *(const u32x4*)(gp + 8);
    }
#pragma unroll
    for (int j = 0; j < 6; ++j) {
      const int r = rb + j * nw;
      if (r < TALL) {
        float o[16], t[16], sg[16];
        unpack8(rf[j][0], o); unpack8(rf[j][1], o + 8); unpack8(rbk[j][0], t); unpack8(rbk[j][1], t + 8); unpack8(rg[j][0], sg); unpack8(rg[j][1], sg + 8);
        float ss = 0.f;
#pragma unroll
        for (int i = 0; i < 16; ++i) { o[i] += t[i]; ss += o[i] * o[i]; }
        ss += __shfl_xor(ss, 1); ss += __shfl_xor(ss, 2); ss += __shfl_xor(ss, 4);
        const float rstd = rsqrtf(ss * (1.0f / 128.0f) + 1e-6f);
#pragma unroll
        for (int i = 0; i < 16; ++i) o[i] = o[i] * rstd * gnv[i] * silu_f(sg[i]);
        *(u32x4*)(A + (size_t)r * 1024 + c0) = pack8(o);
        *(u32x4*)(A + (size_t)r * 1024 + c0 + 8) = pack8(o + 8);
      }
    }
  }
}

DI void phase_final_norm(const Params& p) {
  const int tid = opaque_i((int)threadIdx.x), nb = gridDim.x, bid = blockIdx.x, wid = tid >> 6, lane = tid & 63, gw = bid * 8 + wid, nw = nb * 8;
  f32x4 fw[4];
#pragma unroll
  for (int i = 0; i < 4; ++i) fw[i] = *(const f32x4*)(p.final_norm_w + lane * 4 + 256 * i);
  for (int rb = gw; rb < TALL; rb += 6 * nw) {
    f32x4 x[6][4];
#pragma unroll
    for (int j = 0; j < 6; ++j) {
      const int rr = min(rb + j * nw, TALL - 1);
      const float* row = rr < TCTX ? p.x_prompt + (size_t)rr * 1024 : p.x_sample + (size_t)(rr - TCTX) * 1024;
      const bf16_t* dp = (const bf16_t*)(p.ws + OFF_OF) + (size_t)rr * 1024 + lane * 4;
      const bf16_t* d0 = (const bf16_t*)(p.ws + OFF_D0) + (size_t)rr * 1024 + lane * 4;
#pragma unroll
      for (int i = 0; i < 4; ++i) {
        const u32x2 dv = *(const u32x2*)(dp + 256 * i), ev = *(const u32x2*)(d0 + 256 * i);
        x[j][i] = (*(const f32x4*)(row + lane * 4 + 256 * i) + (f32x4){bf_lo(ev.x), bf_hi(ev.x), bf_lo(ev.y), bf_hi(ev.y)}) + (f32x4){bf_lo(dv.x), bf_hi(dv.x), bf_lo(dv.y), bf_hi(dv.y)};
      }
    }
#pragma unroll
    for (int j = 0; j < 6; ++j) {
      const int r = rb + j * nw;
      if (r < TALL) {
        float* row = p.out + (size_t)r * 1024;
        float ss = 0.f;
#pragma unroll
        for (int i = 0; i < 4; ++i) ss += x[j][i][0] * x[j][i][0] + x[j][i][1] * x[j][i][1] + x[j][i][2] * x[j][i][2] + x[j][i][3] * x[j][i][3];
        ss = wave_sum(ss);
        const float rstd = rsqrtf(ss * (1.0f / 1024.0f) + 1e-6f);
#pragma unroll
        for (int i = 0; i < 4; ++i) *(f32x4*)(row + lane * 4 + 256 * i) = x[j][i] * rstd * fw[i];
      }
    }
  }
}

#ifndef REP_P0
#define REP_P0 1
#endif
#ifndef REP_EW
#define REP_EW 1
#endif
#ifndef REP_IN
#define REP_IN 1
#endif
#ifndef REP_SCAN
#define REP_SCAN 1
#endif
#ifndef REP_OUT
#define REP_OUT 1
#endif
__global__ void __launch_bounds__(512, 2) fwd_megakernel(Params p) {
  extern __shared__ __attribute__((aligned(16))) unsigned char shm[];
  cg::grid_group grid = cg::this_grid();
  LAS unsigned char* lds = (LAS unsigned char*)shm;
  const bf16_t* A = (const bf16_t*)(p.ws + OFF_A);
  pg8::StaticOrder S;
  volatile LAS unsigned* xst = (volatile LAS unsigned*)(lds + 131072);
  if (threadIdx.x == 0) { xst[0] = 0u; xst[1] = 0u; }
  __syncthreads();
  const XcdBarrier xb = xcd_barrier_post((unsigned*)(p.ws + OFF_BAR), xst);
  if (p.ws == nullptr) grid.sync();

  for (int rep = 0; rep < REP_P0; ++rep) phase0(p, shm);
  xcd_barrier(xb);
  phase0b_transposes(p, shm);
  for (int rep = 0; rep < REP_EW; ++rep) phase_norm_mod(p, 0, false);
  xcd_barrier(xb);
  for (int rep = 0; rep < REP_IN; ++rep) {
  phase_tail(p, shm);
    pg8::Gemm g{A, (const bf16_t*)(p.ws + OFF_BTIN0), TALL, 4096, 1024};
    EpiIn0 E{(bf16_t*)(p.ws + OFF_P), (_Float16*)(p.ws + OFF_LG), p.hgrn_lb};
    S.init(TALL, 4096, (int)gridDim.x, (int)blockIdx.x);
    pg8::gemm_phase(lds, g, S, E);
  }
  xcd_barrier(xb);
  for (int rep = 0; rep < REP_SCAN; ++rep) phase_scan(p, 0, shm);
  xcd_barrier(xb);
  for (int rep = 0; rep < REP_EW; ++rep) phase_combine(p, 0);
  xcd_barrier(xb);
  for (int rep = 0; rep < REP_OUT; ++rep) {
    pg8::Gemm g{A, (const bf16_t*)(p.ws + OFF_BTOUT0), TALL, 1024, 1024};
    EpiOut E{(const float*)(p.ws + OFF_MOD), (bf16_t*)(p.ws + OFF_D0)};
    S.init(TALL, 1024, (int)gridDim.x, (int)blockIdx.x);
    pg8::gemm_phase(lds, g, S, E);
  }
  xcd_barrier(xb);
  phase_norm_mod(p, 1, true);
  xcd_barrier(xb);
  for (int rep = 0; rep < REP_IN; ++rep) {
    pg8::Gemm g{A, (const bf16_t*)(p.ws + OFF_BTIN1), TALL, 4096, 1024};
    EpiIn1 E{(bf16_t*)(p.ws + OFF_P), (const float*)(p.ws + OFF_ROPE)};
    S.init(TALL, 4096, (int)gridDim.x, (int)blockIdx.x);
    pg8::gemm_phase(lds, g, S, E);
  }
  xcd_barrier(xb);
  for (int rep = 0; rep < REP_SCAN; ++rep) phase_scan(p, 1, shm);
  xcd_barrier(xb);
  for (int rep = 0; rep < REP_EW; ++rep) phase_combine(p, 1);
  xcd_barrier(xb);
  {
    pg8::Gemm g{A, (const bf16_t*)(p.ws + OFF_BTOUT1), TALL, 1024, 1024};
    EpiOut E{(const float*)(p.ws + OFF_MOD) + 15360, (bf16_t*)(p.ws + OFF_OF)};
    S.init(TALL, 1024, (int)gridDim.x, (int)blockIdx.x);
    pg8::gemm_phase(lds, g, S, E);
  }
  xcd_barrier(xb);
  phase_final_norm(p);
}

extern "C" void kernel_launch(void* const* d_in, const int* in_sizes, int n_in, void* d_out, int out_size, void* d_ws, size_t ws_size,
                              hipStream_t stream) {
  constexpr size_t kDynLds = 131072 + 16;
  static int grid_blocks = 0;
  if (!grid_blocks) {
    int dev = 0, cus = 0, per_cu = 0;
    (void)hipGetDevice(&dev);
    (void)hipDeviceGetAttribute(&cus, hipDeviceAttributeMultiprocessorCount, dev);
    (void)hipFuncSetAttribute((const void*)fwd_megakernel, hipFuncAttributeMaxDynamicSharedMemorySize, (int)kDynLds);
    (void)hipOccupancyMaxActiveBlocksPerMultiprocessor(&per_cu, fwd_megakernel, 512, kDynLds);
    if (per_cu < 1) per_cu = 1;
    grid_blocks = cus * per_cu;
  }
  if (ws_size < WS_NEED) fprintf(stderr, "workspace too small: %zu < %zu\n", ws_size, (size_t)WS_NEED);
  Params p{};
  const float** pp = (const float**)&p;
  for (int i = 0; i < 21; ++i) pp[i] = (const float*)d_in[i];
  p.out = (float*)d_out;
  p.ws = (unsigned char*)d_ws;
  (void)hipMemsetAsync((unsigned char*)d_ws + OFF_BAR, 0, XCD_BAR_WORDS * 4, stream);
  void* args[] = {&p};
  hipError_t e = hipLaunchCooperativeKernel((void*)fwd_megakernel, dim3(grid_blocks), dim3(512), args, kDynLds, stream);
  if (e != hipSuccess) fprintf(stderr, "cooperative launch failed: %s (grid %d)\n", hipGetErrorString(e), grid_blocks);
}
```

```cpp
#include <hip/hip_runtime.h>
#include <hip/hip_cooperative_groups.h>
#include <cstdio>
namespace cg = cooperative_groups;

#define DI __device__ __forceinline__
#define LAS __attribute__((address_space(3)))
typedef unsigned short bf16_t;
typedef short bf16x8 __attribute__((ext_vector_type(8)));
typedef short s16x4 __attribute__((ext_vector_type(4)));
typedef float f32x4 __attribute__((ext_vector_type(4)));
typedef unsigned u32x4 __attribute__((ext_vector_type(4)));
typedef unsigned u32x2 __attribute__((ext_vector_type(2)));
typedef _Float16 f16x8 __attribute__((ext_vector_type(8)));

constexpr int TCTX = 8192, TALL = 12288;
constexpr size_t OFF_BTIN0 = 0, OFF_BTOUT0 = 8454144, OFF_BTIN1 = 10551296, OFF_BTOUT1 = 18939904, OFF_MODP = 21037056,
                 OFF_MOD = 22020096, OFF_ROPE = 22142976, OFF_A = 22159360, OFF_P = 47325184, OFF_GG = OFF_P + 75497472,
                 OFF_LG = 147988480, OFF_OF = 198320128, OFF_OB = 223485952, OFF_D0 = OFF_LG + 25165824, OFF_BAR = 248651776, WS_NEED = 248651776 + 16384;
constexpr size_t OUT_HGRN = 12582912, OUT_GLA = 16777216, OUT_RET = 18874368;

struct Params {
  const float *x_prompt, *x_sample, *state_hgrn, *state_gla, *state_ret, *c, *c_ctx, *norm_w, *ada_w, *ada_b, *w_in_even, *hgrn_lb,
      *gla_gk_w, *gla_gk_b, *gn_even, *w_out_even, *w_in_odd, *ret_decay, *gn_odd, *w_out_odd, *final_norm_w;
  float* out;
  unsigned char* ws;
};

typedef float f32x2 __attribute__((ext_vector_type(2)));
typedef __bf16 bf16v2 __attribute__((ext_vector_type(2)));
DI unsigned cvt_pk_bf16(float lo, float hi) { const f32x2 v = {lo, hi}; const bf16v2 b = __builtin_convertvector(v, bf16v2); return __builtin_bit_cast(unsigned, b); }
DI int opaque_i(int x) { asm volatile("" : "+v"(x)); return x; }
DI float bf_lo(unsigned u) { return __uint_as_float(u << 16); }
DI float bf_hi(unsigned u) { return __uint_as_float(u & 0xffff0000u); }
DI float silu_f(float x) { return x * __builtin_amdgcn_rcpf(1.0f + __expf(-x)); }
DI float logsigmoid_f(float x) { return fminf(x, 0.f) - __logf(1.0f + __expf(-fabsf(x))); }
DI void unpack8(const u32x4& u, float* f) {
  f[0] = bf_lo(u.x); f[1] = bf_hi(u.x); f[2] = bf_lo(u.y); f[3] = bf_hi(u.y); f[4] = bf_lo(u.z); f[5] = bf_hi(u.z); f[6] = bf_lo(u.w); f[7] = bf_hi(u.w);
}
DI u32x4 pack8(const float* f) { u32x4 w; w.x = cvt_pk_bf16(f[0], f[1]); w.y = cvt_pk_bf16(f[2], f[3]); w.z = cvt_pk_bf16(f[4], f[5]); w.w = cvt_pk_bf16(f[6], f[7]); return w; }
DI float wave_sum(float v) {
#pragma unroll
  for (int o = 32; o >= 1; o >>= 1) v += __shfl_xor(v, o);
  return v;
}

#define XB_TMO      128
#define XB_XCNT(j)  (256  + 64 * (j))
#define XB_XSUB(j)  (1280 + 64 * (j))
#define XB_XGEN(j)  (2304 + 64 * (j))
#define XB_TOP      3328
#define XB_TOPGEN   3392
#define XCD_BAR_WORDS 3456
#define XB_SPIN_CAP (1u << 18)
DI unsigned xb_ld(unsigned* p) { return __hip_atomic_load(p, __ATOMIC_RELAXED, __HIP_MEMORY_SCOPE_AGENT); }
DI unsigned xb_add(unsigned* p, unsigned v) { return __hip_atomic_fetch_add(p, v, __ATOMIC_RELAXED, __HIP_MEMORY_SCOPE_AGENT); }
DI unsigned xb_xcc_id() { return (unsigned)__builtin_amdgcn_s_getreg((3 << 11) | 20) & 0xFu; }
#define XB_SPIN(cond, bar) do { unsigned _sp = 0; while (cond) { __builtin_amdgcn_s_sleep(1); \
    if ((++_sp & 255u) == 0u) { if (xb_ld(&(bar)[XB_TMO])) break; if (_sp > XB_SPIN_CAP) { atomicAdd(&(bar)[XB_TMO], 1u); break; } } } } while (0)
struct XcdBarrier { unsigned* bar; unsigned x; volatile LAS unsigned* st; };
DI XcdBarrier xcd_barrier_post(unsigned* bar, volatile LAS unsigned* st) {
  XcdBarrier b; b.bar = bar; b.x = xb_xcc_id(); b.st = st;
  if (threadIdx.x == 0) (void)xb_add(&bar[XB_XCNT(b.x)], 1u);
  return b;
}
DI void xcd_barrier_complete(unsigned* bar, unsigned x, unsigned& nloc, unsigned& nx) {
  const unsigned G = gridDim.x * gridDim.y * gridDim.z;
  unsigned sum, cnt, mine, sp = 0u;
  for (;;) {
    sum = 0u; cnt = 0u; mine = 0u;
#pragma unroll
    for (unsigned j = 0; j < 16; ++j) { const unsigned c = xb_ld(&bar[XB_XCNT(j)]); sum += c; cnt += (c > 0u) ? 1u : 0u; mine = (j == x) ? c : mine; }
    if (sum == G) break;
    __builtin_amdgcn_s_sleep(1);
    if ((++sp & 255u) == 0u) { if (xb_ld(&bar[XB_TMO])) break; if (sp > XB_SPIN_CAP) { atomicAdd(&bar[XB_TMO], 1u); break; } }
  }
  nloc = mine > 0u ? mine : 1u; nx = cnt > 0u ? cnt : 1u;
}
DI void xcd_barrier(const XcdBarrier& b) {
  asm volatile("s_waitcnt vmcnt(0)" ::: "memory");
  __syncthreads();
  if (threadIdx.x == 0) {
    unsigned* bar = b.bar;
    __builtin_amdgcn_s_waitcnt(0);
    unsigned nloc = b.st[0], nx = b.st[1];
    if (nloc == 0u) { xcd_barrier_complete(bar, b.x, nloc, nx); b.st[0] = nloc; b.st[1] = nx; }
    const unsigned old = xb_add(&bar[XB_XSUB(b.x)], 1u);
    const unsigned gen = old / nloc;
    if (old + 1u == (gen + 1u) * nloc) {
      __builtin_amdgcn_fence(__ATOMIC_RELEASE, "agent");
      asm volatile("s_waitcnt vmcnt(0)" ::: "memory");
      const unsigned og = xb_add(&bar[XB_TOP], 1u);
      const unsigned tg = og / nx;
      if (og + 1u == (tg + 1u) * nx) xb_add(&bar[XB_TOPGEN], 1u);
      else XB_SPIN(xb_ld(&bar[XB_TOPGEN]) == tg, bar);
      __builtin_amdgcn_fence(__ATOMIC_ACQUIRE, "agent");
      xb_add(&bar[XB_XGEN(b.x)], 1u);
      asm volatile("s_waitcnt vmcnt(0)" ::: "memory");
    } else {
      XB_SPIN(xb_ld(&bar[XB_XGEN(b.x)]) == gen, bar);
      __builtin_amdgcn_fence(__ATOMIC_ACQUIRE, "agent");
      asm volatile("s_waitcnt vmcnt(0)" ::: "memory");
    }
  }
  __syncthreads();
}

namespace pg8 {
constexpr int BM = 256, BK = 64, HALF = 128, HTB = HALF * BK * 2, STAGE_BYTES = 8 * HTB, NXCD = 8, WGM = 8;
DI int lds_byte(int r, int c) { const int st = (r >> 4) * 2 + (c >> 5), rr = r & 15, cc = c & 31, ob = rr * 64 + cc * 2; return st * 1024 + (ob ^ (((ob >> 9) & 1) << 5)); }
DI void stage_rc(int b, int& R, int& C) { const int st = b / 1024, sb = b % 1024, swz = sb ^ (((sb >> 9) & 1) << 5); R = (st >> 1) * 16 + swz / 64; C = (st & 1) * 32 + (swz % 64) / 2; }
DI int perm32(int rho) { const int n = rho >> 4, i = rho & 15; return 8 * (i >> 2) + 4 * n + (i & 3); }
struct Unit { int pm, pn; };
struct Gemm { const bf16_t* A; const bf16_t* Bt; int M, N, K; };
struct StaticOrder {
  int nM, nN, nwg, G, c;
  DI void init(int M, int N, int G_, int c_) { nM = M / BM; nN = N / BM; nwg = nM * nN; G = G_; c = c_; }
  DI bool next(int i, Unit& u) const {
    const long L = (long)i * G + c; if (L >= nwg) return false;
    int wgid = (int)L; { const int q = nwg / NXCD, r = nwg % NXCD, xcd = wgid % NXCD, off = wgid / NXCD; wgid = (xcd < r ? xcd * (q + 1) : r * (q + 1) + (xcd - r) * q) + off; }
    const int nig = WGM * nN, gid = wgid / nig, fm = gid * WGM, gsz = (nM - fm) < WGM ? (nM - fm) : WGM;
    u.pm = fm + ((wgid % nig) % gsz); u.pn = (wgid % nig) / gsz; return true;
  }
};

template <class Epi>
DI void gemm_phase(LAS unsigned char* lds, const Gemm g, const StaticOrder& S, const Epi& E) {
  const int tid = opaque_i((int)threadIdx.x), wid = __builtin_amdgcn_readfirstlane(tid >> 6), lane = tid & 63, wr = wid >> 2, wc = wid & 3, fr = lane & 15, fq = lane >> 4;
  const int K = g.K, nt = K / BK;
  unsigned voffA[2], voffB[2];
#pragma unroll
  for (int i = 0; i < 2; ++i) { int R, C; stage_rc(tid * 16 + i * 8192, R, C); const int Rb = Epi::PERM ? ((R & ~31) + perm32(R & 31)) : R;
    voffA[i] = (unsigned)(R * K + C) * 2u; voffB[i] = (unsigned)(Rb * K + C) * 2u; }
  const size_t kstep = (size_t)(BK * 2);
  const size_t hstep = (size_t)HALF * K * 2;
  const size_t tstep = 2 * hstep;
  const unsigned ldsw = (unsigned)wid * 1024u;
  const int aoff = lds_byte(wr * 64 + fr, fq * 8), boff = lds_byte(wc * 32 + fr, fq * 8);
#define PG8_SA(b, h) (((b) * 2 + (h)) * HTB)
#define PG8_SB(b, h) ((4 + (b) * 2 + (h)) * HTB)
#define PG8_STAGE(bufoff, gbase, voff) do { _Pragma("unroll") for (int _i = 0; _i < 2; ++_i) \
        __builtin_amdgcn_global_load_lds((const unsigned*)((const char*)(gbase) + (voff)[_i]), (LAS unsigned*)(lds + (bufoff) + ldsw + _i * 8192), 16, 0, 0); } while (0)
#define PG8_LDA(dst, b, h) do { _Pragma("unroll") for (int m = 0; m < 4; ++m) _Pragma("unroll") for (int k = 0; k < 2; ++k) dst[m][k] = *(const LAS bf16x8*)(lds + PG8_SA(b, h) + aoff + m * 2048 + k * 1024); } while (0)
#define PG8_LDB(dst, b, h) do { _Pragma("unroll") for (int n = 0; n < 2; ++n) _Pragma("unroll") for (int k = 0; k < 2; ++k) dst[n][k] = *(const LAS bf16x8*)(lds + PG8_SB(b, h) + boff + n * 2048 + k * 1024); } while (0)
#define PG8_MMA(ai, bj, At, Bt) do { __builtin_amdgcn_s_setprio(1); _Pragma("unroll") for (int m = 0; m < 4; ++m) _Pragma("unroll") for (int n = 0; n < 2; ++n) _Pragma("unroll") for (int k = 0; k < 2; ++k) \
        acc[ai][bj][m][n] = __builtin_amdgcn_mfma_f32_16x16x32_bf16(Bt[n][k], At[m][k], acc[ai][bj][m][n], 0, 0, 0); __builtin_amdgcn_s_setprio(0); } while (0)
#define PG8_WAIT_V(n) asm volatile("s_waitcnt vmcnt(" #n ")" ::: "memory")
#define PG8_WAIT_L(n) asm volatile("s_waitcnt lgkmcnt(" #n ")" ::: "memory")
#define PG8_BAR __builtin_amdgcn_s_barrier()
#define PG8_SCHED __builtin_amdgcn_sched_barrier(0)
  Unit cur, nxt; int ui = 0;
  if (!S.next(0, cur)) return;
  f32x4 acc[2][2][4][2];
#pragma unroll
  for (int a = 0; a < 2; ++a)
#pragma unroll
    for (int b = 0; b < 2; ++b)
#pragma unroll
      for (int m = 0; m < 4; ++m)
#pragma unroll
        for (int n = 0; n < 2; ++n) acc[a][b][m][n] = (f32x4){0.f, 0.f, 0.f, 0.f};
  bf16x8 At[4][2], B0[2][2], B1[2][2];
  const char* cA = (const char*)g.A + (size_t)cur.pm * tstep; const char* cB = (const char*)g.Bt + (size_t)cur.pn * tstep;
  PG8_STAGE(PG8_SB(0, 0), cB, voffB); PG8_STAGE(PG8_SA(0, 0), cA, voffA); PG8_STAGE(PG8_SB(0, 1), cB + hstep, voffB); PG8_STAGE(PG8_SA(0, 1), cA + hstep, voffA);
  if (wr == 1) PG8_BAR;
  PG8_WAIT_V(4); PG8_BAR;
  PG8_STAGE(PG8_SB(1, 0), cB + kstep, voffB); PG8_STAGE(PG8_SA(1, 0), cA + kstep, voffA); PG8_STAGE(PG8_SB(1, 1), cB + hstep + kstep, voffB);
  PG8_WAIT_V(6); PG8_BAR;
  for (;;) {
    const bool has_next = S.next(ui + 1, nxt);
    const char* nA = has_next ? (const char*)g.A + (size_t)nxt.pm * tstep : cA; const char* nB = has_next ? (const char*)g.Bt + (size_t)nxt.pn * tstep : cB;
    for (int t = 0; t < nt; t += 2) {
      const bool last = (t == nt - 2);
      const char* a1 = cA + (size_t)(t + 1) * kstep;
      const char* a2 = last ? nA : cA + (size_t)(t + 2) * kstep; const char* b2 = last ? nB : cB + (size_t)(t + 2) * kstep;
      const char* a3 = a2 + kstep; const char* b3 = b2 + kstep;
      PG8_LDB(B0, 0, 0); PG8_SCHED; PG8_LDA(At, 0, 0); PG8_STAGE(PG8_SA(1, 1), a1 + hstep, voffA);
      PG8_WAIT_L(8); PG8_BAR; PG8_WAIT_L(0); PG8_MMA(0, 0, At, B0); PG8_BAR; PG8_SCHED;
      PG8_LDB(B1, 0, 1); PG8_STAGE(PG8_SB(0, 0), b2, voffB);
      PG8_BAR; PG8_WAIT_L(0); PG8_MMA(0, 1, At, B1); PG8_BAR;
      PG8_LDA(At, 0, 1); PG8_STAGE(PG8_SA(0, 0), a2, voffA);
      PG8_BAR; PG8_WAIT_L(0); PG8_MMA(1, 0, At, B0); PG8_BAR; PG8_SCHED;
      PG8_STAGE(PG8_SB(0, 1), b2 + hstep, voffB);
      PG8_WAIT_V(6); PG8_BAR; PG8_MMA(1, 1, At, B1); PG8_BAR;
      PG8_LDB(B0, 1, 0); PG8_SCHED; PG8_LDA(At, 1, 0); PG8_STAGE(PG8_SA(0, 1), a2 + hstep, voffA);
      PG8_WAIT_L(8); PG8_BAR; PG8_WAIT_L(0); PG8_MMA(0, 0, At, B0); PG8_BAR; PG8_SCHED;
      PG8_LDB(B1, 1, 1); PG8_STAGE(PG8_SB(1, 0), b3, voffB);
      PG8_BAR; PG8_WAIT_L(0); PG8_MMA(0, 1, At, B1); PG8_BAR;
      PG8_LDA(At, 1, 1); PG8_STAGE(PG8_SA(1, 0), a3, voffA);
      PG8_BAR; PG8_WAIT_L(0); PG8_MMA(1, 0, At, B0); PG8_BAR; PG8_SCHED;
      PG8_STAGE(PG8_SB(1, 1), b3 + hstep, voffB);
      PG8_WAIT_V(6); PG8_BAR; PG8_MMA(1, 1, At, B1); PG8_BAR;
    }
    E(acc, cur, wr, wc, fr, fq);
    if (!has_next) break;
#pragma unroll
    for (int a = 0; a < 2; ++a)
#pragma unroll
      for (int b = 0; b < 2; ++b)
#pragma unroll
        for (int m = 0; m < 4; ++m)
#pragma unroll
          for (int n = 0; n < 2; ++n) acc[a][b][m][n] = (f32x4){0.f, 0.f, 0.f, 0.f};
    cur = nxt; cA = nA; cB = nB; ++ui;
  }
  PG8_WAIT_V(0);
  if (wr == 0) PG8_BAR;
  PG8_BAR;
#undef PG8_SA
#undef PG8_SB
#undef PG8_STAGE
#undef PG8_LDA
#undef PG8_LDB
#undef PG8_MMA
#undef PG8_WAIT_V
#undef PG8_WAIT_L
#undef PG8_BAR
#undef PG8_SCHED
}
}

struct EpiIn0 {
  static constexpr bool PERM = true;
  bf16_t* P0; _Float16* LG; const float* hlb;
  DI void operator()(const f32x4 (&acc)[2][2][4][2], const pg8::Unit& u, int wr, int wc, int fr, int fq) const {
    const int row0 = u.pm * 256 + wr * 64 + fr, pn = u.pn;
    if (pn >= 4 && pn < 8) {
#pragma unroll
      for (int bj = 0; bj < 2; ++bj) {
        const int c0 = pn * 256 + bj * 128 + wc * 32 + 8 * fq, ch = (c0 - 1024) & 511;
        float lb[8];
#pragma unroll
        for (int e = 0; e < 8; ++e) lb[e] = __builtin_amdgcn_rcpf(1.0f + __expf(hlb[512 + ch + e] - hlb[ch + e]));
#pragma unroll
        for (int ai = 0; ai < 2; ++ai)
#pragma unroll
          for (int m = 0; m < 4; ++m) {
            _Float16* dst = LG + (size_t)(row0 + ai * 128 + m * 16) * 1024 + (c0 - 1024);
            f16x8 hv;
#pragma unroll
            for (int n = 0; n < 2; ++n) {
#pragma unroll
              for (int j = 0; j < 4; ++j) { const float a = acc[ai][bj][m][n][j]; const float sg = __builtin_amdgcn_rcpf(1.0f + __expf(-a)); const float l = lb[4 * n + j]; hv[4 * n + j] = (_Float16)__logf(l + (1.0f - l) * sg); }
            }
            *(f16x8*)dst = hv;
          }
      }
    } else {
      const bool act = (pn < 2);
      const float scl = (pn == 10) ? 0.125f : 1.0f;
#pragma unroll
      for (int bj = 0; bj < 2; ++bj) {
        const int c0 = pn * 256 + bj * 128 + wc * 32 + 8 * fq, pc = c0 < 1024 ? c0 : c0 - 1024;
#pragma unroll
        for (int ai = 0; ai < 2; ++ai)
#pragma unroll
          for (int m = 0; m < 4; ++m) {
            float v[8];
#pragma unroll
            for (int j = 0; j < 4; ++j) { v[j] = acc[ai][bj][m][0][j]; v[4 + j] = acc[ai][bj][m][1][j]; }
#pragma unroll
            for (int j = 0; j < 8; ++j) v[j] = act ? silu_f(v[j]) : v[j] * scl;
            *(u32x4*)(P0 + (size_t)(row0 + ai * 128 + m * 16) * 3072 + pc) = pack8(v);
          }
      }
    }
  }
};
struct EpiIn1 {
  static constexpr bool PERM = true;
  bf16_t* P1; const float* ropeT;
  DI void operator()(const f32x4 (&acc)[2][2][4][2], const pg8::Unit& u, int wr, int wc, int fr, int fq) const {
    const int row0 = u.pm * 256 + wr * 64 + fr, pn = u.pn;
    const bool act = false, rope = (pn < 8) && (u.pm >= 32);
    const float scl = (pn >= 4 && pn < 8) ? 0.08838834764831845f : 1.0f;
    const int i0 = 16 * (wc & 1) + 4 * fq, hf = wc >> 1;
#pragma unroll
    for (int bj = 0; bj < 2; ++bj) {
      const int c0 = pn * 256 + bj * 128 + wc * 32 + 8 * fq;
#pragma unroll
      for (int ai = 0; ai < 2; ++ai)
#pragma unroll
        for (int m = 0; m < 4; ++m) {
          const int row = row0 + ai * 128 + m * 16;
          float v[8];
#pragma unroll
          for (int j = 0; j < 4; ++j) { v[j] = acc[ai][bj][m][0][j]; v[4 + j] = acc[ai][bj][m][1][j]; }
          if (rope) {
            const int t = row & 1023, pos = hf ? (t & 63) : (t >> 6);
            const f32x4 cs = *(const f32x4*)(ropeT + pos * 32 + i0), sn = *(const f32x4*)(ropeT + 2048 + pos * 32 + i0);
#pragma unroll
            for (int q = 0; q < 4; ++q) { const float a = v[2 * q], b = v[2 * q + 1]; v[2 * q] = a * cs[q] - b * sn[q]; v[2 * q + 1] = b * cs[q] + a * sn[q]; }
          }
#pragma unroll
          for (int j = 0; j < 8; ++j) v[j] = act ? silu_f(v[j]) : v[j] * scl;
          *(u32x4*)(P1 + (size_t)row * 4096 + c0) = pack8(v);
        }
    }
  }
};
struct EpiOut {
  static constexpr bool PERM = true;
  const float* gate;
  bf16_t* delta;
  DI void operator()(const f32x4 (&acc)[2][2][4][2], const pg8::Unit& u, int wr, int wc, int fr, int fq) const {
    const int pm = u.pm, row0 = pm * 256 + wr * 64 + fr, col0 = u.pn * 256 + wc * 32 + 8 * fq;
    const int cond = pm < 32 ? 0 : 1 + ((pm - 32) >> 2);
    const float* gp = gate + cond * 3072 + 2048 + col0;
    f32x4 gv[2][2];
#pragma unroll
    for (int bj = 0; bj < 2; ++bj)
#pragma unroll
      for (int n = 0; n < 2; ++n) gv[bj][n] = *(const f32x4*)(gp + bj * 128 + n * 4);
#pragma unroll
    for (int ai = 0; ai < 2; ++ai)
#pragma unroll
      for (int m = 0; m < 4; ++m) {
        bf16_t* dst = delta + (size_t)(row0 + ai * 128 + m * 16) * 1024 + col0;
#pragma unroll
        for (int bj = 0; bj < 2; ++bj) {
          const f32x4 a = gv[bj][0] * acc[ai][bj][m][0], b = gv[bj][1] * acc[ai][bj][m][1];
          u32x4 w; w.x = cvt_pk_bf16(a[0], a[1]); w.y = cvt_pk_bf16(a[2], a[3]); w.z = cvt_pk_bf16(b[0], b[1]); w.w = cvt_pk_bf16(b[2], b[3]);
          *(u32x4*)(dst + bj * 128) = w;
        }
      }
  }
};

template <bool PERMQK>
DI void tr_tile2(const float* __restrict__ W, const int N, bf16_t* __restrict__ Bt, const int nTn, const int t0, const int ntiles, float* tile) {
  const int tid = opaque_i((int)threadIdx.x);
  const int r = tid >> 4, c4 = (tid & 15) * 4;
  f32x4 v[2][2];
#pragma unroll
  for (int h = 0; h < 2; ++h) {
    const int t = min(t0 + h, ntiles - 1), k0 = (t / nTn) * 64, n0 = (t % nTn) * 64;
#pragma unroll
    for (int rr = 0; rr < 2; ++rr) {
      v[h][rr] = (f32x4){0.f, 0.f, 0.f, 0.f};
      if (n0 + c4 < N) v[h][rr] = *(const f32x4*)(W + (size_t)(k0 + r + 32 * rr) * N + n0 + c4);
    }
  }
#pragma unroll
  for (int h = 0; h < 2; ++h)
#pragma unroll
    for (int rr = 0; rr < 2; ++rr) { float* d = tile + h * 4160 + (r + 32 * rr) * 65 + c4; d[0] = v[h][rr][0]; d[1] = v[h][rr][1]; d[2] = v[h][rr][2]; d[3] = v[h][rr][3]; }
  __syncthreads();
  const int n = tid >> 3, k8 = (tid & 7) * 8;
#pragma unroll
  for (int h = 0; h < 2; ++h) {
    const int t = t0 + h;
    if (t < ntiles) {
      const int k0 = (t / nTn) * 64, n0 = (t % nTn) * 64;
      if (n0 + n < N) {
        float o[8];
#pragma unroll
        for (int j = 0; j < 8; ++j) o[j] = tile[h * 4160 + (k8 + j) * 65 + n];
        int nr = n0 + n;
        if (PERMQK && nr < 2048) { const int d = nr & 127; nr = (nr & ~127) + 64 * (d >> 6) + 2 * (d & 31) + ((d >> 5) & 1); }
        *(u32x4*)(Bt + (size_t)nr * 1024 + k0 + k8) = pack8(o);
      }
    }
  }
  __syncthreads();
}
DI void phase0b_transposes(const Params& p, unsigned char* shm) {
  const int nb = gridDim.x, bid = blockIdx.x;
  const bool sp = (nb == 256);
  const int slot = sp ? bid - 48 : bid, nsl = sp ? 208 : nb;
  if (slot < 0) return;
  float* tile = (float*)shm;
  for (int t = 2 * slot; t < 1040; t += 2 * nsl) tr_tile2<false>(p.w_in_even, 4128, (bf16_t*)(p.ws + OFF_BTIN0), 65, t, 1040, tile);
}
DI void prep_layer1(const Params& p, unsigned char* shm, const int slot, const int nsl) {
  float* tile = (float*)shm;
  for (int t = 2 * slot; t < 1024; t += 2 * nsl) tr_tile2<true>(p.w_in_odd, 4096, (bf16_t*)(p.ws + OFF_BTIN1), 64, t, 1024, tile);
  for (int t = 2 * (nsl - 1 - slot); t < 256; t += 2 * nsl) tr_tile2<false>(p.w_out_odd, 1024, (bf16_t*)(p.ws + OFF_BTOUT1), 16, t, 256, tile);
  for (int t = 2 * (nsl - 1 - slot); t < 256; t += 2 * nsl) tr_tile2<false>(p.w_out_even, 1024, (bf16_t*)(p.ws + OFF_BTOUT0), 16, t, 256, tile);
}
DI void mod_partials(const Params& p, const int l, const int gw, const int nw) {
  const int lane = opaque_i((int)threadIdx.x) & 63;
  float* modp = (float*)(p.ws + OFF_MODP);
  for (int it = gw; it < 384; it += nw) {
    const int ks = it & 7, cgp = it >> 3;
    float a0 = 0.f, a1 = 0.f, a2 = 0.f, a3 = 0.f, a4 = 0.f;
    const float* wp = p.ada_w + (size_t)l * 1024 * 3072 + (size_t)(ks * 128) * 3072 + cgp * 64 + lane;
#pragma unroll 1
    for (int hh = 0; hh < 2; ++hh) {
      const int k = ks * 128 + hh * 64 + lane;
      const float s0 = silu_f(p.c_ctx[k]), s1 = silu_f(p.c[k]), s2 = silu_f(p.c[1024 + k]), s3 = silu_f(p.c[2048 + k]), s4 = silu_f(p.c[3072 + k]);
#pragma unroll 16
      for (int kk = 0; kk < 64; ++kk) {
        const float w = wp[(size_t)(hh * 64 + kk) * 3072];
        a0 += __shfl(s0, kk) * w; a1 += __shfl(s1, kk) * w; a2 += __shfl(s2, kk) * w; a3 += __shfl(s3, kk) * w; a4 += __shfl(s4, kk) * w;
      }
    }
    float* mo = modp + ((size_t)(ks * 2 + l) * 5) * 3072 + cgp * 64 + lane;
    mo[0] = a0; mo[3072] = a1; mo[6144] = a2; mo[9216] = a3; mo[12288] = a4;
  }
}
DI void phase0(const Params& p, unsigned char* shm) {
  const int tid = opaque_i((int)threadIdx.x), nb = gridDim.x, bid = blockIdx.x;
  mod_partials(p, 0, bid * 8 + (tid >> 6), nb * 8);
  float* rope = (float*)(p.ws + OFF_ROPE);
  for (int i = bid * 512 + tid; i < 2048; i += nb * 512) {
    const int pos = i >> 5, fi = i & 31;
    const float inv = exp2f(-(float)(2 * fi) * (13.287712379549449f / 64.0f));
    const float ang = (float)pos * inv;
    const double kq = rint((double)ang * 0.15915494309189535);
    const float rr = (float)((double)ang - kq * 6.283185307179586);
    rope[i] = __cosf(rr);
    rope[2048 + i] = __sinf(rr);
  }
}

DI void phase_norm_mod(const Params& p, int l, bool with_delta) {
  const int tid = opaque_i((int)threadIdx.x), nb = gridDim.x, bid = blockIdx.x, wid = tid >> 6, lane = tid & 63, gw = bid * 8 + wid, nw = nb * 8;
  const float* modp = (const float*)(p.ws + OFF_MODP);
  bf16_t* A = (bf16_t*)(p.ws + OFF_A);
  {
    float* mod = (float*)(p.ws + OFF_MOD);
    for (int i = l * 15360 + bid * 512 + tid; i < (l + 1) * 15360; i += nb * 512) {
      float s = p.ada_b[(i / 15360) * 3072 + (i % 3072)];
#pragma unroll
      for (int ks = 0; ks < 8; ++ks) s += modp[ks * 30720 + i];
      mod[i] = s;
    }
  }
  const int rpw = (TALL + nw - 1) / nw;
  int cur = -1;
  f32x4 sc[4], sh[4], nwv[4];
#pragma unroll
  for (int i = 0; i < 4; ++i) { nwv[i] = *(const f32x4*)(p.norm_w + l * 1024 + lane * 4 + 256 * i); sc[i] = (f32x4){0.f, 0.f, 0.f, 0.f}; sh[i] = sc[i]; }
  const int rend = min(TALL, (gw + 1) * rpw);
  for (int rb = gw * rpw; rb < rend; rb += 6) {
    f32x4 x[6][4];
#pragma unroll
    for (int j = 0; j < 6; ++j) {
      const int r = min(rb + j, rend - 1);
      const float* src = r < TCTX ? p.x_prompt + (size_t)r * 1024 : p.x_sample + (size_t)(r - TCTX) * 1024;
#pragma unroll
      for (int i = 0; i < 4; ++i) x[j][i] = *(const f32x4*)(src + lane * 4 + 256 * i);
      if (with_delta) {
        const bf16_t* dp = (const bf16_t*)(p.ws + OFF_D0) + (size_t)r * 1024 + lane * 4;
#pragma unroll
        for (int i = 0; i < 4; ++i) { const u32x2 dv = *(const u32x2*)(dp + 256 * i); x[j][i] += (f32x4){bf_lo(dv.x), bf_hi(dv.x), bf_lo(dv.y), bf_hi(dv.y)}; }
      }
    }
#pragma unroll
    for (int j = 0; j < 6; ++j) {
      const int r = rb + j;
      if (r < rend) {
        const int cond = r < TCTX ? 0 : 1 + ((r - TCTX) >> 10);
        if (cond != cur) {
          cur = cond;
#pragma unroll
          for (int i = 0; i < 4; ++i) {
            const int col = lane * 4 + 256 * i;
            f32x4 a = *(const f32x4*)(p.ada_b + l * 3072 + col), b = *(const f32x4*)(p.ada_b + l * 3072 + 1024 + col);
#pragma unroll 2
            for (int ks = 0; ks < 8; ++ks) {
              const float* mp = modp + ((size_t)(ks * 2 + l) * 5 + cond) * 3072 + col;
              a += *(const f32x4*)mp; b += *(const f32x4*)(mp + 1024);
            }
            sh[i] = a; sc[i] = b;
          }
        }
        float ss = 0.f;
#pragma unroll
        for (int i = 0; i < 4; ++i) ss += x[j][i][0] * x[j][i][0] + x[j][i][1] * x[j][i][1] + x[j][i][2] * x[j][i][2] + x[j][i][3] * x[j][i][3];
        ss = wave_sum(ss);
        const float rstd = rsqrtf(ss * (1.0f / 1024.0f) + 1e-6f);
#pragma unroll
        for (int i = 0; i < 4; ++i) {
          f32x4 h = x[j][i] * rstd * nwv[i] * (sc[i] + 1.0f) + sh[i];
          u32x2 w; w.x = cvt_pk_bf16(h[0], h[1]); w.y = cvt_pk_bf16(h[2], h[3]);
          *(u32x2*)(A + (size_t)r * 1024 + lane * 4 + 256 * i) = w;
        }
      }
    }
  }
}

DI void phase_tail(const Params& p, unsigned char* shm) {
  const int tid = opaque_i((int)threadIdx.x), nb = gridDim.x, bid = blockIdx.x, wid = tid >> 6, lane = tid & 63;
  const int r16 = lane & 15, g = lane >> 4;
  float* part = (float*)shm;
  float* lowS = (float*)(shm + 50688);
  const bf16_t* A = (const bf16_t*)(p.ws + OFF_A);
  const bf16_t* Bt = (const bf16_t*)(p.ws + OFF_BTIN0) + (size_t)4096 * 1024;
  _Float16* GG = (_Float16*)(p.ws + OFF_GG);
  const int gd = tid >> 8, gc = tid & 255;
  float w[16];
#pragma unroll
  for (int r = 0; r < 16; ++r) w[r] = p.gla_gk_w[(gd * 16 + r) * 256 + gc];
  const float gb = p.gla_gk_b[gd * 256 + gc];
  for (int grp = bid; grp < TALL / 48; grp += nb) {
    const int row0 = grp * 48;
    {
      f32x4 acc[3][2];
#pragma unroll
      for (int j = 0; j < 3; ++j) { acc[j][0] = (f32x4){0.f, 0.f, 0.f, 0.f}; acc[j][1] = acc[j][0]; }
      const bf16_t* ap = A + (size_t)(row0 + r16) * 1024 + wid * 128 + 8 * g;
      const bf16_t* bp = Bt + (size_t)r16 * 1024 + wid * 128 + 8 * g;
#pragma unroll
      for (int ks = 0; ks < 4; ++ks) {
        const bf16x8 x0 = *(const bf16x8*)(bp + ks * 32), x1 = *(const bf16x8*)(bp + 16 * 1024 + ks * 32);
#pragma unroll
        for (int j = 0; j < 3; ++j) {
          const bf16x8 a = *(const bf16x8*)(ap + (size_t)j * 16 * 1024 + ks * 32);
          acc[j][0] = __builtin_amdgcn_mfma_f32_16x16x32_bf16(a, x0, acc[j][0], 0, 0, 0);
          acc[j][1] = __builtin_amdgcn_mfma_f32_16x16x32_bf16(a, x1, acc[j][1], 0, 0, 0);
        }
      }
#pragma unroll
      for (int j = 0; j < 3; ++j)
#pragma unroll
        for (int i = 0; i < 4; ++i) {
          float* d = part + ((wid * 3 + j) * 16 + 4 * g + i) * 33;
          d[r16] = acc[j][0][i]; d[16 + r16] = acc[j][1][i];
        }
    }
    __syncthreads();
    for (int e = tid; e < 1536; e += 512) {
      const int rr = e >> 5, c = e & 31, j = rr >> 4, r = rr & 15;
      float sum = 0.f;
#pragma unroll
      for (int w = 0; w < 8; ++w) sum += part[((w * 3 + j) * 16 + r) * 33 + c];
      lowS[rr * 36 + c] = sum;
    }
    __syncthreads();
    {
#pragma unroll 4
      for (int t = 0; t < 48; ++t) {
        const f32x4 l0 = *(const f32x4*)(lowS + t * 36 + 16 * gd), l1 = *(const f32x4*)(lowS + t * 36 + 16 * gd + 4),
                    l2 = *(const f32x4*)(lowS + t * 36 + 16 * gd + 8), l3 = *(const f32x4*)(lowS + t * 36 + 16 * gd + 12);
        float s0 = gb, s1 = 0.f, s2 = 0.f, s3 = 0.f;
#pragma unroll
        for (int r = 0; r < 4; ++r) { s0 += l0[r] * w[r]; s1 += l1[r] * w[4 + r]; s2 += l2[r] * w[8 + r]; s3 += l3[r] * w[12 + r]; }
        GG[(size_t)(row0 + t) * 512 + tid] = (_Float16)(logsigmoid_f((s0 + s1) + (s2 + s3)) * 0.0625f);
      }
    }
    __syncthreads();
  }
}

enum { T_HGRN = 0, T_GLA = 1, T_RET = 2 };
#define MFMA16(a, b, c) __builtin_amdgcn_mfma_f32_16x16x32_bf16((a), (b), (c), 0, 0, 0)
DI bf16x8 ld_frag(const bf16_t* base) {
  const s16x4 lo = *(const s16x4*)base, hi = *(const s16x4*)(base + 16);
  return __builtin_shufflevector(lo, hi, 0, 1, 2, 3, 4, 5, 6, 7);
}
DI bf16x8 ld_frag_tr(const bf16_t* base, int hi_off) {
  const s16x4 lo = __builtin_amdgcn_ds_read_tr16_b64_v4i16((LAS s16x4*)base), hi = __builtin_amdgcn_ds_read_tr16_b64_v4i16((LAS s16x4*)(base + hi_off));
  return __builtin_shufflevector(lo, hi, 0, 1, 2, 3, 4, 5, 6, 7);
}
DI bf16x8 pack_frag(const f32x4& a, const f32x4& b) {
  u32x4 w; w.x = cvt_pk_bf16(a[0], a[1]); w.y = cvt_pk_bf16(a[2], a[3]); w.z = cvt_pk_bf16(b[0], b[1]); w.w = cvt_pk_bf16(b[2], b[3]);
  return __builtin_bit_cast(bf16x8, w);
}

struct LoadSet { u32x4 q, k, v, qp, kp, lg; f32x4 c0, c1, s0, s1; };
template <int KD, int TYPE>
DI void scan_unit(unsigned char* shm, const bf16_t* Pq, const bf16_t* Pk, const bf16_t* Pv, int PS, const _Float16* lgp, int LS, float lgs,
                  const float* s0, float* sout, bf16_t* O, int rowbase, int Tlen, int dir, const float* sdummy, bool rope) {
  const float* ropeT = sdummy;
  constexpr int QS = KD + 8, NP = KD / 32, NKT = KD / 16;
  constexpr int BUFB = 35840, VS = 136;
  const int tid = opaque_i((int)threadIdx.x), wid = tid >> 6, lane = tid & 63, r16 = lane & 15, g = lane >> 4;
  const bool active = wid < KD / 16;
  const int ei = lane & 31, c8 = (16 * wid + 8 * (lane >> 5)) & (KD - 1);
  const int vi = tid >> 4, j8 = (tid & 15) * 8;
  const int jcol = 16 * wid + r16;

  f32x4 accS[NKT];
#pragma unroll
  for (int kt = 0; kt < NKT; ++kt)
#pragma unroll
    for (int i = 0; i < 4; ++i) { const float sv = (s0 ? s0 : sdummy)[(size_t)(16 * kt + 4 * g + i) * 128 + jcol]; accS[kt][i] = s0 ? sv : 0.f; }

  const int nsteps = Tlen >> 5;
  LoadSet LA, LB;
  LA.q = (u32x4){0u, 0u, 0u, 0u}; LA.k = LA.q; LA.v = LA.q; LA.qp = LA.q; LA.kp = LA.q; LA.lg = LA.q;
  LA.c0 = (f32x4){0.f, 0.f, 0.f, 0.f}; LA.c1 = LA.c0; LA.s0 = LA.c0; LA.s1 = LA.c0;
  LB = LA;
  const int eiL = ei;
  auto issue_loads = [&](int n, LoadSet& X) {
    const int tb = 32 * n;
    const int tokE = dir ? Tlen - 1 - (tb + eiL) : tb + eiL;
    const int tokV = dir ? Tlen - 1 - (tb + vi) : tb + vi;
    const size_t ro = (size_t)(rowbase + tokE) * PS;
    X.q = *(const u32x4*)(Pq + ro + c8);
    if (TYPE != T_RET) X.lg = *(const u32x4*)(lgp + (size_t)(rowbase + tokE) * LS + c8);
    if (TYPE != T_HGRN) X.k = *(const u32x4*)(Pk + ro + c8);
    if (TYPE == T_RET) {
      X.qp = *(const u32x4*)(Pq + ro + (c8 ^ 32)); X.kp = *(const u32x4*)(Pk + ro + (c8 ^ 32));
      const int pos = (c8 < 64) ? (tokE >> 6) : (tokE & 63);
      const float* rp = ropeT + pos * 32 + (c8 & 31);
      X.c0 = *(const f32x4*)rp; X.c1 = *(const f32x4*)(rp + 4); X.s0 = *(const f32x4*)(rp + 2048); X.s1 = *(const f32x4*)(rp + 2052);
    }
    X.v = *(const u32x4*)(Pv + (size_t)(rowbase + tokV) * PS + j8);
  };
  auto step = [&](int n, LoadSet& X) {
    const int tb = 32 * n;
    unsigned char* buf = shm + (n & 1) * BUFB;
    bf16_t* QR = (bf16_t*)buf;
    bf16_t* KI = (bf16_t*)(buf + 8704);
    bf16_t* KDm = (bf16_t*)(buf + 17408);
    bf16_t* Vm = (bf16_t*)(buf + 26112);
    float* EV = (float*)(buf + 34816);
    if (active) {
      float pre[8];
      const f16x8 hl = __builtin_bit_cast(f16x8, X.lg);
#pragma unroll
      for (int e = 0; e < 8; ++e) pre[e] = (float)hl[e];
#define DPP_ADD(ctrl, rmask, bc) _Pragma("unroll") for (int e = 0; e < 8; ++e) pre[e] += __builtin_bit_cast(float, __builtin_amdgcn_update_dpp(0, __builtin_bit_cast(int, pre[e]), ctrl, rmask, 0xf, bc))
      DPP_ADD(0x111, 0xf, true);
      DPP_ADD(0x112, 0xf, true);
      DPP_ADD(0x114, 0xf, true);
      DPP_ADD(0x118, 0xf, true);
      DPP_ADD(0x142, 0xa, false);
#undef DPP_ADD
      float q[8], kk[8];
      unpack8(X.q, q);
      if (TYPE == T_HGRN) {
#pragma unroll
        for (int e = 0; e < 8; ++e) kk[e] = 1.0f - __expf((float)hl[e]);
      } else unpack8(X.k, kk);
      float qr[8], ki[8], kd[8];
      const int lR = ((lane & 32) | 15) << 2, lL = (lane | 31) << 2;
#pragma unroll
      for (int e = 0; e < 8; ++e) {
        const float rr = __builtin_bit_cast(float, __builtin_amdgcn_ds_bpermute(lR, __builtin_bit_cast(int, pre[e])));
        const float x = __builtin_amdgcn_fmed3f(pre[e] - rr, -80.f, 80.f);
        const float er = __expf(x), ek = __builtin_amdgcn_rcpf(er);
        const float er31 = __builtin_bit_cast(float, __builtin_amdgcn_ds_bpermute(lL, __builtin_bit_cast(int, er)));
        qr[e] = q[e] * er; ki[e] = kk[e] * ek; kd[e] = ki[e] * er31;
      }
      if ((lane & 15) == 15) {
        float* evp = EV + ((lane & 16) ? 0 : 128) + c8;
#pragma unroll
        for (int e = 0; e < 8; ++e) evp[e] = __expf(pre[e]);
      }
      *(u32x4*)(QR + ei * QS + c8) = pack8(qr);
      *(u32x4*)(KI + ei * QS + c8) = pack8(ki);
      *(u32x4*)(KDm + ei * QS + c8) = pack8(kd);
    }
    *(u32x4*)(Vm + vi * VS + j8) = X.v;
    issue_loads(min(n + 2, nsteps - 1), X);
    __syncthreads();
    {
      const int tq = r16 >> 2, tp = r16 & 3;
      const bf16x8 vfrag = ld_frag_tr(Vm + (4 * g + tq) * VS + 16 * wid + 4 * tp, 16 * VS);
      bf16x8 qf[2][NP];
#pragma unroll
      for (int tt = 0; tt < 2; ++tt)
#pragma unroll
        for (int pp = 0; pp < NP; ++pp) qf[tt][pp] = ld_frag(QR + (16 * tt + r16) * QS + 32 * pp + 4 * g);
      f32x4 sc00 = (f32x4){0.f, 0.f, 0.f, 0.f}, sc01 = sc00, sc11 = sc00;
#pragma unroll
      for (int pp = 0; pp < NP; ++pp) {
        const bf16x8 kf0 = ld_frag(KI + r16 * QS + 32 * pp + 4 * g), kf1 = ld_frag(KI + (16 + r16) * QS + 32 * pp + 4 * g);
        sc00 = MFMA16(kf0, qf[0][pp], sc00); sc01 = MFMA16(kf0, qf[1][pp], sc01); sc11 = MFMA16(kf1, qf[1][pp], sc11);
      }
#pragma unroll
      for (int i = 0; i < 4; ++i) if (4 * g + i > r16) { sc00[i] = 0.f; sc11[i] = 0.f; }
      const f32x4 z4 = (f32x4){0.f, 0.f, 0.f, 0.f};
      const bf16x8 pf0 = pack_frag(sc00, z4), pf1 = pack_frag(sc01, sc11);
      f32x4 o0 = MFMA16(vfrag, pf0, z4), o1 = MFMA16(vfrag, pf1, z4);
#pragma unroll
      for (int pp = 0; pp < NP; ++pp) {
        f32x4 e0, e1;
        e0 = *(const f32x4*)(EV + 128 + 32 * pp + 4 * g); e1 = *(const f32x4*)(EV + 128 + 32 * pp + 16 + 4 * g);
        const bf16x8 sf = pack_frag(accS[2 * pp] * e0, accS[2 * pp + 1] * e1);
        o0 = MFMA16(sf, qf[0][pp], o0); o1 = MFMA16(sf, qf[1][pp], o1);
      }
#pragma unroll
      for (int kt = 0; kt < NKT; ++kt) {
        f32x4 eb;
        eb = *(const f32x4*)(EV + 16 * kt + 4 * g);
        const bf16x8 kdf = ld_frag_tr(KDm + (4 * g + tq) * QS + 16 * kt + 4 * tp, 16 * QS);
        accS[kt] = MFMA16(kdf, vfrag, accS[kt] * eb);
      }
      {
        const int t0 = tb + r16, t1 = tb + 16 + r16;
        const int tok0 = dir ? Tlen - 1 - t0 : t0, tok1 = dir ? Tlen - 1 - t1 : t1;
        u32x2 w0, w1; w0.x = cvt_pk_bf16(o0[0], o0[1]); w0.y = cvt_pk_bf16(o0[2], o0[3]); w1.x = cvt_pk_bf16(o1[0], o1[1]); w1.y = cvt_pk_bf16(o1[2], o1[3]);
        *(u32x2*)(O + (size_t)(rowbase + tok0) * 1024 + 16 * wid + 4 * g) = w0;
        *(u32x2*)(O + (size_t)(rowbase + tok1) * 1024 + 16 * wid + 4 * g) = w1;
      }
    }
  };
  issue_loads(0, LA);
  issue_loads(1, LB);
  for (int n = 0; n < nsteps; n += 2) { step(n, LA); step(n + 1, LB); }
  if (sout) {
#pragma unroll
    for (int kt = 0; kt < NKT; ++kt)
#pragma unroll
      for (int i = 0; i < 4; ++i) sout[(size_t)(16 * kt + 4 * g + i) * 128 + jcol] = accS[kt][i];
  }
  __syncthreads();
}


struct LoadSet3 { u32x4 q, k, v; };
DI int ret_lrow(int pk) { const int pp = pk >> 1; return 64 * (pp >> 5) + (pp & 31) + 32 * (pk & 1); }
DI void scan_unit_ret(unsigned char* shm, const bf16_t* Pq, const bf16_t* Pk, const bf16_t* Pv, float lgs, const float* s0, float* sout, bf16_t* O,
                      int rowbase, int Tlen, int dir, const float* sdummy) {
  constexpr int QS = 136, NP = 4, NKT = 8, PS = 4096, BUFB = 3 * 8704;
  const int tid = opaque_i((int)threadIdx.x), wid = tid >> 6, lane = tid & 63, r16 = lane & 15, g = lane >> 4;
  const int ei = tid >> 4, c8 = (tid & 15) * 8;
  const int jcol = 16 * wid + r16;
  f32x4 accS[NKT];
#pragma unroll
  for (int kt = 0; kt < NKT; ++kt)
#pragma unroll
    for (int i = 0; i < 4; ++i) { const float sv = (s0 ? s0 : sdummy)[(size_t)ret_lrow(16 * kt + 4 * g + i) * 128 + jcol]; accS[kt][i] = s0 ? sv : 0.f; }
  f32x4 dm, d01; float cs[8];
#pragma unroll
  for (int i = 0; i < 4; ++i) { const int dd = r16 - 4 * g - i; dm[i] = dd >= 0 ? __expf((float)dd * lgs) : 0.f; d01[i] = __expf((float)(16 + dd) * lgs); }
#pragma unroll
  for (int j = 0; j < 8; ++j) cs[j] = __expf((float)(31 - (16 * (j >> 2) + 4 * g + (j & 3))) * lgs);
  const float ct0 = __expf((float)(r16 + 1) * lgs), ct1 = __expf((float)(r16 + 17) * lgs), eb = __expf(32.0f * lgs);
  const int nsteps = Tlen >> 5;
  LoadSet3 LA, LB;
  auto issue_loads = [&](int n, LoadSet3& X) {
    const int tok = dir ? Tlen - 1 - (32 * n + ei) : 32 * n + ei;
    const size_t ro = (size_t)(rowbase + tok) * PS + c8;
    X.q = *(const u32x4*)(Pq + ro); X.k = *(const u32x4*)(Pk + ro); X.v = *(const u32x4*)(Pv + ro);
  };
  auto step = [&](int n, LoadSet3& X) {
    const int tb = 32 * n;
    unsigned char* buf = shm + (n & 1) * BUFB;
    bf16_t* Qm = (bf16_t*)buf; bf16_t* Km = (bf16_t*)(buf + 8704); bf16_t* Vm = (bf16_t*)(buf + 17408);
    *(u32x4*)(Qm + ei * QS + c8) = X.q;
    *(u32x4*)(Km + ei * QS + c8) = X.k;
    *(u32x4*)(Vm + ei * QS + c8) = X.v;
    issue_loads(min(n + 2, nsteps - 1), X);
    __syncthreads();
    const int tq = r16 >> 2, tp = r16 & 3;
    const bf16x8 vfrag = ld_frag_tr(Vm + (4 * g + tq) * QS + 16 * wid + 4 * tp, 16 * QS);
    bf16x8 qf[2][NP];
#pragma unroll
    for (int tt = 0; tt < 2; ++tt)
#pragma unroll
      for (int pp = 0; pp < NP; ++pp) qf[tt][pp] = ld_frag(Qm + (16 * tt + r16) * QS + 32 * pp + 4 * g);
    f32x4 sc00 = (f32x4){0.f, 0.f, 0.f, 0.f}, sc01 = sc00, sc11 = sc00;
#pragma unroll
    for (int pp = 0; pp < NP; ++pp) {
      const bf16x8 kf0 = ld_frag(Km + r16 * QS + 32 * pp + 4 * g), kf1 = ld_frag(Km + (16 + r16) * QS + 32 * pp + 4 * g);
      sc00 = MFMA16(kf0, qf[0][pp], sc00); sc01 = MFMA16(kf0, qf[1][pp], sc01); sc11 = MFMA16(kf1, qf[1][pp], sc11);
    }
    const f32x4 z4 = (f32x4){0.f, 0.f, 0.f, 0.f};
    const bf16x8 pf0 = pack_frag(sc00 * dm, z4), pf1 = pack_frag(sc01 * d01, sc11 * dm);
    f32x4 o0 = MFMA16(vfrag, pf0, z4), o1 = MFMA16(vfrag, pf1, z4);
    f32x4 oi0 = z4, oi1 = z4;
#pragma unroll
    for (int pp = 0; pp < NP; ++pp) {
      const bf16x8 sf = pack_frag(accS[2 * pp], accS[2 * pp + 1]);
      oi0 = MFMA16(sf, qf[0][pp], oi0); oi1 = MFMA16(sf, qf[1][pp], oi1);
    }
    o0 += oi0 * ct0; o1 += oi1 * ct1;
    bf16x8 vsf;
    {
      float vv[8];
      unpack8(__builtin_bit_cast(u32x4, vfrag), vv);
#pragma unroll
      for (int j = 0; j < 8; ++j) vv[j] *= cs[j];
      vsf = __builtin_bit_cast(bf16x8, pack8(vv));
    }
#pragma unroll
    for (int kt = 0; kt < NKT; ++kt) {
      const bf16x8 kdf = ld_frag_tr(Km + (4 * g + tq) * QS + 16 * kt + 4 * tp, 16 * QS);
      accS[kt] = MFMA16(kdf, vsf, accS[kt] * eb);
    }
    {
      const int t0 = tb + r16, t1 = tb + 16 + r16;
      const int tok0 = dir ? Tlen - 1 - t0 : t0, tok1 = dir ? Tlen - 1 - t1 : t1;
      u32x2 w0, w1; w0.x = cvt_pk_bf16(o0[0], o0[1]); w0.y = cvt_pk_bf16(o0[2], o0[3]); w1.x = cvt_pk_bf16(o1[0], o1[1]); w1.y = cvt_pk_bf16(o1[2], o1[3]);
      *(u32x2*)(O + (size_t)(rowbase + tok0) * 1024 + 16 * wid + 4 * g) = w0;
      *(u32x2*)(O + (size_t)(rowbase + tok1) * 1024 + 16 * wid + 4 * g) = w1;
    }
  };
  issue_loads(0, LA);
  issue_loads(1, LB);
  for (int n = 0; n < nsteps; n += 2) { step(n, LA); step(n + 1, LB); }
  if (sout) {
#pragma unroll
    for (int kt = 0; kt < NKT; ++kt)
#pragma unroll
      for (int i = 0; i < 4; ++i) sout[(size_t)ret_lrow(16 * kt + 4 * g + i) * 128 + jcol] = accS[kt][i];
  }
  __syncthreads();
}

DI int scan_unit_id(int k, int bid, int nb) {
  if (nb == 256) {
    if (bid < 64) return k == 0 ? bid : -1;
    const int j = bid - 64;
    if (k == 0) return 64 + j;
    if (k == 1) return 64 + 192 + j;
    if (k == 2 && j < 128) return 64 + 384 + j;
    return -1;
  }
  const int u = bid + k * nb;
  return u < 576 ? u : -1;
}

DI void phase_scan(const Params& p, int layer, unsigned char* shm) {
  const int bid = blockIdx.x, nb = gridDim.x;
  bf16_t* OF = (bf16_t*)(p.ws + OFF_OF); bf16_t* OB = (bf16_t*)(p.ws + OFF_OB);
  const bf16_t* P = (const bf16_t*)(p.ws + OFF_P);
  for (int k = 0;; ++k) {
    const int u = scan_unit_id(k, bid, nb);
    if (u < 0) break;
    const bool lat = u < 64;
    const int v = lat ? u : u - 64;
    if (layer == 0) {
      const int half = lat ? 32 : 256;
      const bool gla = v >= half;
      const int idx = gla ? v - half : v;
      const int b = idx >> 3, h = (idx >> 1) & 3, d = idx & 1;
      const int rowbase = lat ? TCTX + b * 1024 : b * 256, Tlen = lat ? 1024 : 256;
      bf16_t* O = (d ? OB : OF);
      if (!gla) {
        const float* s0 = lat ? p.state_hgrn + (size_t)((b * 2 + d) * 4 + h) * 16384 : nullptr;
        float* so = lat ? nullptr : p.out + OUT_HGRN + (size_t)((b * 2 + d) * 4 + h) * 16384;
        scan_unit<128, T_HGRN>(shm, P + h * 128, nullptr, P + 512 + h * 128, 3072, (const _Float16*)(p.ws + OFF_LG) + d * 512 + h * 128, 1024, 0.f, s0, so,
                               O + h * 128, rowbase, Tlen, d, p.state_hgrn, false);
      } else {
        const float* s0 = lat ? p.state_gla + (size_t)((b * 2 + d) * 4 + h) * 8192 : nullptr;
        float* so = lat ? nullptr : p.out + OUT_GLA + (size_t)((b * 2 + d) * 4 + h) * 8192;
        scan_unit<64, T_GLA>(shm, P + 1536 + h * 64, P + 1792 + h * 64, P + 2048 + h * 128, 3072, (const _Float16*)(p.ws + OFF_GG) + d * 256 + h * 64, 512, 0.f,
                             s0, so, O + 512 + h * 128, rowbase, Tlen, d, p.state_hgrn, false);
      }
    } else {
      const int b = v >> 4, h = (v >> 1) & 7, d = v & 1;
      const int rowbase = lat ? TCTX + b * 1024 : b * 256, Tlen = lat ? 1024 : 256;
      const float* s0 = lat ? p.state_ret + (size_t)((b * 2 + d) * 8 + h) * 16384 : nullptr;
      float* so = lat ? nullptr : p.out + OUT_RET + (size_t)((b * 2 + d) * 8 + h) * 16384;
      const float lgs = logsigmoid_f(p.ret_decay[d * 8 + h]);
      scan_unit_ret(shm, P + h * 128, P + 1024 + h * 128, P + 2048 + h * 128, lgs, s0, so, (d ? OB : OF) + h * 128, rowbase, Tlen, d, p.state_ret);
    }
  }
  if (layer == 0) {
    const bool sp = (nb == 256);
    const int slot = sp ? bid - 64 : bid, nsl = sp ? 192 : nb;
    if (slot >= 0) {
      prep_layer1(p, shm, slot, nsl);
      mod_partials(p, 1, slot * 8 + ((int)threadIdx.x >> 6), nsl * 8);
    }
  }
}

DI void phase_combine(const Params& p, int layer) {
  const int tid = opaque_i((int)threadIdx.x), nb = gridDim.x, bid = blockIdx.x, wid = tid >> 6, lane = tid & 63, gw = bid * 8 + wid, nw = nb * 8;
  const bf16_t* OF = (const bf16_t*)(p.ws + OFF_OF); const bf16_t* OB = (const bf16_t*)(p.ws + OFF_OB);
  const bf16_t* P = (const bf16_t*)(p.ws + OFF_P);
  bf16_t* A = (bf16_t*)(p.ws + OFF_A);
  const float* gn = layer == 0 ? p.gn_even : p.gn_odd;
  const int c0 = lane * 16;
  float gnv[16];
#pragma unroll
  for (int i = 0; i < 16; ++i) gnv[i] = gn[c0 + i];
  for (int rb = gw; rb < TALL; rb += 6 * nw) {
    u32x4 rf[6][2], rbk[6][2], rg[6][2];
#pragma unroll
    for (int j = 0; j < 6; ++j) {
      const int r = min(rb + j * nw, TALL - 1);
      const bf16_t* gp = layer == 0 ? P + (size_t)r * 3072 + (c0 < 512 ? 1024 + c0 : 2048 + c0) : P + (size_t)r * 4096 + 3072 + c0;
      rf[j][0] = *(const u32x4*)(OF + (size_t)r * 1024 + c0); rf[j][1] = *(const u32x4*)(OF + (size_t)r * 1024 + c0 + 8);
      rbk[j][0] = *(const u32x4*)(OB + (size_t)r * 1024 + c0); rbk[j][1] = *(const u32x4*)(OB + (size_t)r * 1024 + c0 + 8);
      rg[j][0] = *(const u32x4*)gp; rg[j][1] = *(const u32x4*)(gp + 8);
    }
#pragma unroll
    for (int j = 0; j < 6; ++j) {
      const int r = rb + j * nw;
      if (r < TALL) {
        float o[16], t[16], sg[16];
        unpack8(rf[j][0], o); unpack8(rf[j][1], o + 8); unpack8(rbk[j][0], t); unpack8(rbk[j][1], t + 8); unpack8(rg[j][0], sg); unpack8(rg[j][1], sg + 8);
        float ss = 0.f;
#pragma unroll
        for (int i = 0; i < 16; ++i) { o[i] += t[i]; ss += o[i] * o[i]; }
        ss += __shfl_xor(ss, 1); ss += __shfl_xor(ss, 2); ss += __shfl_xor(ss, 4);
        const float rstd = rsqrtf(ss * (1.0f / 128.0f) + 1e-6f);
#pragma unroll
        for (int i = 0; i < 16; ++i) o[i] = o[i] * rstd * gnv[i] * silu_f(sg[i]);
        *(u32x4*)(A + (size_t)r * 1024 + c0) = pack8(o);
        *(u32x4*)(A + (size_t)r * 1024 + c0 + 8) = pack8(o + 8);
      }
    }
  }
}

DI void phase_final_norm(const Params& p) {
  const int tid = opaque_i((int)threadIdx.x), nb = gridDim.x, bid = blockIdx.x, wid = tid >> 6, lane = tid & 63, gw = bid * 8 + wid, nw = nb * 8;
  f32x4 fw[4];
#pragma unroll
  for (int i = 0; i < 4; ++i) fw[i] = *(const f32x4*)(p.final_norm_w + lane * 4 + 256 * i);
  for (int rb = gw; rb < TALL; rb += 6 * nw) {
    f32x4 x[6][4];
#pragma unroll
    for (int j = 0; j < 6; ++j) {
      const int rr = min(rb + j * nw, TALL - 1);
      const float* row = rr < TCTX ? p.x_prompt + (size_t)rr * 1024 : p.x_sample + (size_t)(rr - TCTX) * 1024;
      const bf16_t* dp = (const bf16_t*)(p.ws + OFF_OF) + (size_t)rr * 1024 + lane * 4;
      const bf16_t* d0 = (const bf16_t*)(p.ws + OFF_D0) + (size_t)rr * 1024 + lane * 4;
#pragma unroll
      for (int i = 0; i < 4; ++i) {
        const u32x2 dv = *(const u32x2*)(dp + 256 * i), ev = *(const u32x2*)(d0 + 256 * i);
        x[j][i] = (*(const f32x4*)(row + lane * 4 + 256 * i) + (f32x4){bf_lo(ev.x), bf_hi(ev.x), bf_lo(ev.y), bf_hi(ev.y)}) + (f32x4){bf_lo(dv.x), bf_hi(dv.x), bf_lo(dv.y), bf_hi(dv.y)};
      }
    }
#pragma unroll
    for (int j = 0; j < 6; ++j) {
      const int r = rb + j * nw;
      if (r < TALL) {
        float* row = p.out + (size_t)r * 1024;
        float ss = 0.f;
#pragma unroll
        for (int i = 0; i < 4; ++i) ss += x[j][i][0] * x[j][i][0] + x[j][i][1] * x[j][i][1] + x[j][i][2] * x[j][i][2] + x[j][i][3] * x[j][i][3];
        ss = wave_sum(ss);
        const float rstd = rsqrtf(ss * (1.0f / 1024.0f) + 1e-6f);
#pragma unroll
        for (int i = 0; i < 4; ++i) *(f32x4*)(row + lane * 4 + 256 * i) = x[j][i] * rstd * fw[i];
      }
    }
  }
}

#ifndef REP_P0
#define REP_P0 1
#endif
#ifndef REP_EW
#define REP_EW 1
#endif
#ifndef REP_IN
#define REP_IN 1
#endif
#ifndef REP_SCAN
#define REP_SCAN 1
#endif
#ifndef REP_OUT
#define REP_OUT 1
#endif
__global__ void __launch_bounds__(512, 2) fwd_megakernel(Params p) {
  extern __shared__ __attribute__((aligned(16))) unsigned char shm[];
  cg::grid_group grid = cg::this_grid();
  LAS unsigned char* lds = (LAS unsigned char*)shm;
  const bf16_t* A = (const bf16_t*)(p.ws + OFF_A);
  pg8::StaticOrder S;
  volatile LAS unsigned* xst = (volatile LAS unsigned*)(lds + 131072);
  if (threadIdx.x == 0) { xst[0] = 0u; xst[1] = 0u; }
  __syncthreads();
  const XcdBarrier xb = xcd_barrier_post((unsigned*)(p.ws + OFF_BAR), xst);
  if (p.ws == nullptr) grid.sync();

  for (int rep = 0; rep < REP_P0; ++rep) phase0(p, shm);
  phase0b_transposes(p, shm);
  xcd_barrier(xb);
  for (int rep = 0; rep < REP_EW; ++rep) phase_norm_mod(p, 0, false);
  xcd_barrier(xb);
  for (int rep = 0; rep < REP_IN; ++rep) {
  phase_tail(p, shm);
    pg8::Gemm g{A, (const bf16_t*)(p.ws + OFF_BTIN0), TALL, 4096, 1024};
    EpiIn0 E{(bf16_t*)(p.ws + OFF_P), (_Float16*)(p.ws + OFF_LG), p.hgrn_lb};
    S.init(TALL, 4096, (int)gridDim.x, (int)blockIdx.x);
    pg8::gemm_phase(lds, g, S, E);
  }
  xcd_barrier(xb);
  for (int rep = 0; rep < REP_SCAN; ++rep) phase_scan(p, 0, shm);
  xcd_barrier(xb);
  for (int rep = 0; rep < REP_EW; ++rep) phase_combine(p, 0);
  xcd_barrier(xb);
  for (int rep = 0; rep < REP_OUT; ++rep) {
    pg8::Gemm g{A, (const bf16_t*)(p.ws + OFF_BTOUT0), TALL, 1024, 1024};
    EpiOut E{(const float*)(p.ws + OFF_MOD), (bf16_t*)(p.ws + OFF_D0)};
    S.init(TALL, 1024, (int)gridDim.x, (int)blockIdx.x);
    pg8::gemm_phase(lds, g, S, E);
  }
  xcd_barrier(xb);
  phase_norm_mod(p, 1, true);
  xcd_barrier(xb);
  for (int rep = 0; rep < REP_IN; ++rep) {
    pg8::Gemm g{A, (const bf16_t*)(p.ws + OFF_BTIN1), TALL, 4096, 1024};
    EpiIn1 E{(bf16_t*)(p.ws + OFF_P), (const float*)(p.ws + OFF_ROPE)};
    S.init(TALL, 4096, (int)gridDim.x, (int)blockIdx.x);
    pg8::gemm_phase(lds, g, S, E);
  }
  xcd_barrier(xb);
  for (int rep = 0; rep < REP_SCAN; ++rep) phase_scan(p, 1, shm);
  xcd_barrier(xb);
  for (int rep = 0; rep < REP_EW; ++rep) phase_combine(p, 1);
  xcd_barrier(xb);
  {
    pg8::Gemm g{A, (const bf16_t*)(p.ws + OFF_BTOUT1), TALL, 1024, 1024};
    EpiOut E{(const float*)(p.ws + OFF_MOD) + 15360, (bf16_t*)(p.ws + OFF_OF)};
    S.init(TALL, 1024, (int)gridDim.x, (int)blockIdx.x);
    pg8::gemm_phase(lds, g, S, E);
  }
  xcd_barrier(xb);
  phase_final_norm(p);
}

extern "C" void kernel_launch(void* const* d_in, const int* in_sizes, int n_in, void* d_out, int out_size, void* d_ws, size_t ws_size,
                              hipStream_t stream) {
  constexpr size_t kDynLds = 131072 + 16;
  static int grid_blocks = 0;
  if (!grid_blocks) {
    int dev = 0, cus = 0, per_cu = 0;
    (void)hipGetDevice(&dev);
    (void)hipDeviceGetAttribute(&cus, hipDeviceAttributeMultiprocessorCount, dev);
    (void)hipFuncSetAttribute((const void*)fwd_megakernel, hipFuncAttributeMaxDynamicSharedMemorySize, (int)kDynLds);
    (void)hipOccupancyMaxActiveBlocksPerMultiprocessor(&per_cu, fwd_megakernel, 512, kDynLds);
    if (per_cu < 1) per_cu = 1;
    grid_blocks = cus * per_cu;
  }
  if (ws_size < WS_NEED) fprintf(stderr, "workspace too small: %zu < %zu\n", ws_size, (size_t)WS_NEED);
  Params p{};
  const float** pp = (const float**)&p;
  for (int i = 0; i < 21; ++i) pp[i] = (const float*)d_in[i];
  p.out = (float*)d_out;
  p.ws = (unsigned char*)d_ws;
  (void)hipMemsetAsync((unsigned char*)d_ws + OFF_BAR, 0, XCD_BAR_WORDS * 4, stream);
  void* args[] = {&p};
  hipError_t e = hipLaunchCooperativeKernel((void*)fwd_megakernel, dim3(grid_blocks), dim3(512), args, kDynLds, stream);
  if (e != hipSuccess) fprintf(stderr, "cooperative launch failed: %s (grid %d)\n", hipGetErrorString(e), grid_blocks);
}
```

```cpp
#include <hip/hip_runtime.h>
#include <hip/hip_cooperative_groups.h>
#include <cstdio>
namespace cg = cooperative_groups;

#define DI __device__ __forceinline__
#define LAS __attribute__((address_space(3)))
typedef unsigned short bf16_t;
typedef short bf16x8 __attribute__((ext_vector_type(8)));
typedef short s16x4 __attribute__((ext_vector_type(4)));
typedef float f32x4 __attribute__((ext_vector_type(4)));
typedef unsigned u32x4 __attribute__((ext_vector_type(4)));
typedef unsigned u32x2 __attribute__((ext_vector_type(2)));
typedef _Float16 f16x8 __attribute__((ext_vector_type(8)));

constexpr int TCTX = 8192, TALL = 12288;
constexpr size_t OFF_BTIN0 = 0, OFF_BTOUT0 = 8454144, OFF_BTIN1 = 10551296, OFF_BTOUT1 = 18939904, OFF_MODP = 21037056,
                 OFF_MOD = 22020096, OFF_ROPE = 22142976, OFF_A = 22159360, OFF_P = 47325184, OFF_GG = OFF_P + 75497472,
                 OFF_LG = 147988480, OFF_OF = 198320128, OFF_OB = 223485952, OFF_D0 = OFF_LG + 25165824, OFF_BAR = 248651776, WS_NEED = 248651776 + 16384;
constexpr size_t OUT_HGRN = 12582912, OUT_GLA = 16777216, OUT_RET = 18874368;

struct Params {
  const float *x_prompt, *x_sample, *state_hgrn, *state_gla, *state_ret, *c, *c_ctx, *norm_w, *ada_w, *ada_b, *w_in_even, *hgrn_lb,
      *gla_gk_w, *gla_gk_b, *gn_even, *w_out_even, *w_in_odd, *ret_decay, *gn_odd, *w_out_odd, *final_norm_w;
  float* out;
  unsigned char* ws;
};

typedef float f32x2 __attribute__((ext_vector_type(2)));
typedef __bf16 bf16v2 __attribute__((ext_vector_type(2)));
DI unsigned cvt_pk_bf16(float lo, float hi) { const f32x2 v = {lo, hi}; const bf16v2 b = __builtin_convertvector(v, bf16v2); return __builtin_bit_cast(unsigned, b); }
DI int opaque_i(int x) { asm volatile("" : "+v"(x)); return x; }
DI float bf_lo(unsigned u) { return __uint_as_float(u << 16); }
DI float bf_hi(unsigned u) { return __uint_as_float(u & 0xffff0000u); }
DI float silu_f(float x) { return x * __builtin_amdgcn_rcpf(1.0f + __expf(-x)); }
DI float logsigmoid_f(float x) { return fminf(x, 0.f) - __logf(1.0f + __expf(-fabsf(x))); }
DI void unpack8(const u32x4& u, float* f) {
  f[0] = bf_lo(u.x); f[1] = bf_hi(u.x); f[2] = bf_lo(u.y); f[3] = bf_hi(u.y); f[4] = bf_lo(u.z); f[5] = bf_hi(u.z); f[6] = bf_lo(u.w); f[7] = bf_hi(u.w);
}
DI u32x4 pack8(const float* f) { u32x4 w; w.x = cvt_pk_bf16(f[0], f[1]); w.y = cvt_pk_bf16(f[2], f[3]); w.z = cvt_pk_bf16(f[4], f[5]); w.w = cvt_pk_bf16(f[6], f[7]); return w; }
DI float wave_sum(float v) {
#pragma unroll
  for (int o = 32; o >= 1; o >>= 1) v += __shfl_xor(v, o);
  return v;
}

#define XB_TMO      128
#define XB_XCNT(j)  (256  + 64 * (j))
#define XB_XSUB(j)  (1280 + 64 * (j))
#define XB_XGEN(j)  (2304 + 64 * (j))
#define XB_TOP      3328
#define XB_TOPGEN   3392
#define XCD_BAR_WORDS 3456
#define XB_SPIN_CAP (1u << 18)
DI unsigned xb_ld(unsigned* p) { return __hip_atomic_load(p, __ATOMIC_RELAXED, __HIP_MEMORY_SCOPE_AGENT); }
DI unsigned xb_add(unsigned* p, unsigned v) { return __hip_atomic_fetch_add(p, v, __ATOMIC_RELAXED, __HIP_MEMORY_SCOPE_AGENT); }
DI unsigned xb_xcc_id() { return (unsigned)__builtin_amdgcn_s_getreg((3 << 11) | 20) & 0xFu; }
#define XB_SPIN(cond, bar) do { unsigned _sp = 0; while (cond) { __builtin_amdgcn_s_sleep(1); \
    if ((++_sp & 255u) == 0u) { if (xb_ld(&(bar)[XB_TMO])) break; if (_sp > XB_SPIN_CAP) { atomicAdd(&(bar)[XB_TMO], 1u); break; } } } } while (0)
struct XcdBarrier { unsigned* bar; unsigned x; volatile LAS unsigned* st; };
DI XcdBarrier xcd_barrier_post(unsigned* bar, volatile LAS unsigned* st) {
  XcdBarrier b; b.bar = bar; b.x = xb_xcc_id(); b.st = st;
  if (threadIdx.x == 0) (void)xb_add(&bar[XB_XCNT(b.x)], 1u);
  return b;
}
DI void xcd_barrier_complete(unsigned* bar, unsigned x, unsigned& nloc, unsigned& nx) {
  const unsigned G = gridDim.x * gridDim.y * gridDim.z;
  unsigned sum, cnt, mine, sp = 0u;
  for (;;) {
    sum = 0u; cnt = 0u; mine = 0u;
#pragma unroll
    for (unsigned j = 0; j < 16; ++j) { const unsigned c = xb_ld(&bar[XB_XCNT(j)]); sum += c; cnt += (c > 0u) ? 1u : 0u; mine = (j == x) ? c : mine; }
    if (sum == G) break;
    __builtin_amdgcn_s_sleep(1);
    if ((++sp & 255u) == 0u) { if (xb_ld(&bar[XB_TMO])) break; if (sp > XB_SPIN_CAP) { atomicAdd(&bar[XB_TMO], 1u); break; } }
  }
  nloc = mine > 0u ? mine : 1u; nx = cnt > 0u ? cnt : 1u;
}
DI void xcd_barrier(const XcdBarrier& b) {
  asm volatile("s_waitcnt vmcnt(0)" ::: "memory");
  __syncthreads();
  if (threadIdx.x == 0) {
    unsigned* bar = b.bar;
    __builtin_amdgcn_s_waitcnt(0);
    unsigned nloc = b.st[0], nx = b.st[1];
    if (nloc == 0u) { xcd_barrier_complete(bar, b.x, nloc, nx); b.st[0] = nloc; b.st[1] = nx; }
    const unsigned old = xb_add(&bar[XB_XSUB(b.x)], 1u);
    const unsigned gen = old / nloc;
    if (old + 1u == (gen + 1u) * nloc) {
      __builtin_amdgcn_fence(__ATOMIC_RELEASE, "agent");
      asm volatile("s_waitcnt vmcnt(0)" ::: "memory");
      const unsigned og = xb_add(&bar[XB_TOP], 1u);
      const unsigned tg = og / nx;
      if (og + 1u == (tg + 1u) * nx) xb_add(&bar[XB_TOPGEN], 1u);
      else XB_SPIN(xb_ld(&bar[XB_TOPGEN]) == tg, bar);
      __builtin_amdgcn_fence(__ATOMIC_ACQUIRE, "agent");
      xb_add(&bar[XB_XGEN(b.x)], 1u);
      asm volatile("s_waitcnt vmcnt(0)" ::: "memory");
    } else {
      XB_SPIN(xb_ld(&bar[XB_XGEN(b.x)]) == gen, bar);
      __builtin_amdgcn_fence(__ATOMIC_ACQUIRE, "agent");
      asm volatile("s_waitcnt vmcnt(0)" ::: "memory");
    }
  }
  __syncthreads();
}

namespace pg8 {
constexpr int BM = 256, BK = 64, HALF = 128, HTB = HALF * BK * 2, STAGE_BYTES = 8 * HTB, NXCD = 8, WGM = 8;
DI int lds_byte(int r, int c) { const int st = (r >> 4) * 2 + (c >> 5), rr = r & 15, cc = c & 31, ob = rr * 64 + cc * 2; return st * 1024 + (ob ^ (((ob >> 9) & 1) << 5)); }
DI void stage_rc(int b, int& R, int& C) { const int st = b / 1024, sb = b % 1024, swz = sb ^ (((sb >> 9) & 1) << 5); R = (st >> 1) * 16 + swz / 64; C = (st & 1) * 32 + (swz % 64) / 2; }
DI int perm32(int rho) { const int n = rho >> 4, i = rho & 15; return 8 * (i >> 2) + 4 * n + (i & 3); }
struct Unit { int pm, pn; };
struct Gemm { const bf16_t* A; const bf16_t* Bt; int M, N, K; };
struct StaticOrder {
  int nM, nN, nwg, G, c;
  DI void init(int M, int N, int G_, int c_) { nM = M / BM; nN = N / BM; nwg = nM * nN; G = G_; c = c_; }
  DI bool next(int i, Unit& u) const {
    const long L = (long)i * G + c; if (L >= nwg) return false;
    int wgid = (int)L; { const int q = nwg / NXCD, r = nwg % NXCD, xcd = wgid % NXCD, off = wgid / NXCD; wgid = (xcd < r ? xcd * (q + 1) : r * (q + 1) + (xcd - r) * q) + off; }
    const int nig = WGM * nN, gid = wgid / nig, fm = gid * WGM, gsz = (nM - fm) < WGM ? (nM - fm) : WGM;
    u.pm = fm + ((wgid % nig) % gsz); u.pn = (wgid % nig) / gsz; return true;
  }
};

template <class Epi>
DI void gemm_phase(LAS unsigned char* lds, const Gemm g, const StaticOrder& S, const Epi& E) {
  const int tid = opaque_i((int)threadIdx.x), wid = __builtin_amdgcn_readfirstlane(tid >> 6), lane = tid & 63, wr = wid >> 2, wc = wid & 3, fr = lane & 15, fq = lane >> 4;
  const int K = g.K, nt = K / BK;
  unsigned voffA[2], voffB[2];
#pragma unroll
  for (int i = 0; i < 2; ++i) { int R, C; stage_rc(tid * 16 + i * 8192, R, C); const int Rb = Epi::PERM ? ((R & ~31) + perm32(R & 31)) : R;
    voffA[i] = (unsigned)(R * K + C) * 2u; voffB[i] = (unsigned)(Rb * K + C) * 2u; }
  const size_t kstep = (size_t)(BK * 2);
  const size_t hstep = (size_t)HALF * K * 2;
  const size_t tstep = 2 * hstep;
  const unsigned ldsw = (unsigned)wid * 1024u;
  const int aoff = lds_byte(wr * 64 + fr, fq * 8), boff = lds_byte(wc * 32 + fr, fq * 8);
#define PG8_SA(b, h) (((b) * 2 + (h)) * HTB)
#define PG8_SB(b, h) ((4 + (b) * 2 + (h)) * HTB)
#define PG8_STAGE(bufoff, gbase, voff) do { _Pragma("unroll") for (int _i = 0; _i < 2; ++_i) \
        __builtin_amdgcn_global_load_lds((const unsigned*)((const char*)(gbase) + (voff)[_i]), (LAS unsigned*)(lds + (bufoff) + ldsw + _i * 8192), 16, 0, 0); } while (0)
#define PG8_LDA(dst, b, h) do { _Pragma("unroll") for (int m = 0; m < 4; ++m) _Pragma("unroll") for (int k = 0; k < 2; ++k) dst[m][k] = *(const LAS bf16x8*)(lds + PG8_SA(b, h) + aoff + m * 2048 + k * 1024); } while (0)
#define PG8_LDB(dst, b, h) do { _Pragma("unroll") for (int n = 0; n < 2; ++n) _Pragma("unroll") for (int k = 0; k < 2; ++k) dst[n][k] = *(const LAS bf16x8*)(lds + PG8_SB(b, h) + boff + n * 2048 + k * 1024); } while (0)
#define PG8_MMA(ai, bj, At, Bt) do { __builtin_amdgcn_s_setprio(1); _Pragma("unroll") for (int m = 0; m < 4; ++m) _Pragma("unroll") for (int n = 0; n < 2; ++n) _Pragma("unroll") for (int k = 0; k < 2; ++k) \
        acc[ai][bj][m][n] = __builtin_amdgcn_mfma_f32_16x16x32_bf16(Bt[n][k], At[m][k], acc[ai][bj][m][n], 0, 0, 0); __builtin_amdgcn_s_setprio(0); } while (0)
#define PG8_WAIT_V(n) asm volatile("s_waitcnt vmcnt(" #n ")" ::: "memory")
#define PG8_WAIT_L(n) asm volatile("s_waitcnt lgkmcnt(" #n ")" ::: "memory")
#define PG8_BAR __builtin_amdgcn_s_barrier()
#define PG8_SCHED __builtin_amdgcn_sched_barrier(0)
  Unit cur, nxt; int ui = 0;
  if (!S.next(0, cur)) return;
  f32x4 acc[2][2][4][2];
#pragma unroll
  for (int a = 0; a < 2; ++a)
#pragma unroll
    for (int b = 0; b < 2; ++b)
#pragma unroll
      for (int m = 0; m < 4; ++m)
#pragma unroll
        for (int n = 0; n < 2; ++n) acc[a][b][m][n] = (f32x4){0.f, 0.f, 0.f, 0.f};
  bf16x8 At[4][2], B0[2][2], B1[2][2];
  const char* cA = (const char*)g.A + (size_t)cur.pm * tstep; const char* cB = (const char*)g.Bt + (size_t)cur.pn * tstep;
  PG8_STAGE(PG8_SB(0, 0), cB, voffB); PG8_STAGE(PG8_SA(0, 0), cA, voffA); PG8_STAGE(PG8_SB(0, 1), cB + hstep, voffB); PG8_STAGE(PG8_SA(0, 1), cA + hstep, voffA);
  if (wr == 1) PG8_BAR;
  PG8_WAIT_V(4); PG8_BAR;
  PG8_STAGE(PG8_SB(1, 0), cB + kstep, voffB); PG8_STAGE(PG8_SA(1, 0), cA + kstep, voffA); PG8_STAGE(PG8_SB(1, 1), cB + hstep + kstep, voffB);
  PG8_WAIT_V(6); PG8_BAR;
  for (;;) {
    const bool has_next = S.next(ui + 1, nxt);
    const char* nA = has_next ? (const char*)g.A + (size_t)nxt.pm * tstep : cA; const char* nB = has_next ? (const char*)g.Bt + (size_t)nxt.pn * tstep : cB;
    for (int t = 0; t < nt; t += 2) {
      const bool last = (t == nt - 2);
      const char* a1 = cA + (size_t)(t + 1) * kstep;
      const char* a2 = last ? nA : cA + (size_t)(t + 2) * kstep; const char* b2 = last ? nB : cB + (size_t)(t + 2) * kstep;
      const char* a3 = a2 + kstep; const char* b3 = b2 + kstep;
      PG8_LDB(B0, 0, 0); PG8_SCHED; PG8_LDA(At, 0, 0); PG8_STAGE(PG8_SA(1, 1), a1 + hstep, voffA);
      PG8_WAIT_L(8); PG8_BAR; PG8_WAIT_L(0); PG8_MMA(0, 0, At, B0); PG8_BAR; PG8_SCHED;
      PG8_LDB(B1, 0, 1); PG8_STAGE(PG8_SB(0, 0), b2, voffB);
      PG8_BAR; PG8_WAIT_L(0); PG8_MMA(0, 1, At, B1); PG8_BAR;
      PG8_LDA(At, 0, 1); PG8_STAGE(PG8_SA(0, 0), a2, voffA);
      PG8_BAR; PG8_WAIT_L(0); PG8_MMA(1, 0, At, B0); PG8_BAR; PG8_SCHED;
      PG8_STAGE(PG8_SB(0, 1), b2 + hstep, voffB);
      PG8_WAIT_V(6); PG8_BAR; PG8_MMA(1, 1, At, B1); PG8_BAR;
      PG8_LDB(B0, 1, 0); PG8_SCHED; PG8_LDA(At, 1, 0); PG8_STAGE(PG8_SA(0, 1), a2 + hstep, voffA);
      PG8_WAIT_L(8); PG8_BAR; PG8_WAIT_L(0); PG8_MMA(0, 0, At, B0); PG8_BAR; PG8_SCHED;
      PG8_LDB(B1, 1, 1); PG8_STAGE(PG8_SB(1, 0), b3, voffB);
      PG8_BAR; PG8_WAIT_L(0); PG8_MMA(0, 1, At, B1); PG8_BAR;
      PG8_LDA(At, 1, 1); PG8_STAGE(PG8_SA(1, 0), a3, voffA);
      PG8_BAR; PG8_WAIT_L(0); PG8_MMA(1, 0, At, B0); PG8_BAR; PG8_SCHED;
      PG8_STAGE(PG8_SB(1, 1), b3 + hstep, voffB);
      PG8_WAIT_V(6); PG8_BAR; PG8_MMA(1, 1, At, B1); PG8_BAR;
    }
    E(acc, cur, wr, wc, fr, fq);
    if (!has_next) break;
#pragma unroll
    for (int a = 0; a < 2; ++a)
#pragma unroll
      for (int b = 0; b < 2; ++b)
#pragma unroll
        for (int m = 0; m < 4; ++m)
#pragma unroll
          for (int n = 0; n < 2; ++n) acc[a][b][m][n] = (f32x4){0.f, 0.f, 0.f, 0.f};
    cur = nxt; cA = nA; cB = nB; ++ui;
  }
  PG8_WAIT_V(0);
  if (wr == 0) PG8_BAR;
  PG8_BAR;
#undef PG8_SA
#undef PG8_SB
#undef PG8_STAGE
#undef PG8_LDA
#undef PG8_LDB
#undef PG8_MMA
#undef PG8_WAIT_V
#undef PG8_WAIT_L
#undef PG8_BAR
#undef PG8_SCHED
}
}

struct EpiIn0 {
  static constexpr bool PERM = true;
  bf16_t* P0; _Float16* LG; const float* hlb;
  DI void operator()(const f32x4 (&acc)[2][2][4][2], const pg8::Unit& u, int wr, int wc, int fr, int fq) const {
    const int row0 = u.pm * 256 + wr * 64 + fr, pn = u.pn;
    if (pn >= 4 && pn < 8) {
#pragma unroll
      for (int bj = 0; bj < 2; ++bj) {
        const int c0 = pn * 256 + bj * 128 + wc * 32 + 8 * fq, ch = (c0 - 1024) & 511;
        float lb[8];
#pragma unroll
        for (int e = 0; e < 8; ++e) lb[e] = __builtin_amdgcn_rcpf(1.0f + __expf(hlb[512 + ch + e] - hlb[ch + e]));
#pragma unroll
        for (int ai = 0; ai < 2; ++ai)
#pragma unroll
          for (int m = 0; m < 4; ++m) {
            _Float16* dst = LG + (size_t)(row0 + ai * 128 + m * 16) * 1024 + (c0 - 1024);
            f16x8 hv;
#pragma unroll
            for (int n = 0; n < 2; ++n) {
#pragma unroll
              for (int j = 0; j < 4; ++j) { const float a = acc[ai][bj][m][n][j]; const float sg = __builtin_amdgcn_rcpf(1.0f + __expf(-a)); const float l = lb[4 * n + j]; hv[4 * n + j] = (_Float16)__logf(l + (1.0f - l) * sg); }
            }
            *(f16x8*)dst = hv;
          }
      }
    } else {
      const bool act = (pn < 2);
      const float scl = (pn == 10) ? 0.125f : 1.0f;
#pragma unroll
      for (int bj = 0; bj < 2; ++bj) {
        const int c0 = pn * 256 + bj * 128 + wc * 32 + 8 * fq, pc = c0 < 1024 ? c0 : c0 - 1024;
#pragma unroll
        for (int ai = 0; ai < 2; ++ai)
#pragma unroll
          for (int m = 0; m < 4; ++m) {
            float v[8];
#pragma unroll
            for (int j = 0; j < 4; ++j) { v[j] = acc[ai][bj][m][0][j]; v[4 + j] = acc[ai][bj][m][1][j]; }
#pragma unroll
            for (int j = 0; j < 8; ++j) v[j] = act ? silu_f(v[j]) : v[j] * scl;
            *(u32x4*)(P0 + (size_t)(row0 + ai * 128 + m * 16) * 3072 + pc) = pack8(v);
          }
      }
    }
  }
};
struct EpiIn1 {
  static constexpr bool PERM = true;
  bf16_t* P1; const float* ropeT;
  DI void operator()(const f32x4 (&acc)[2][2][4][2], const pg8::Unit& u, int wr, int wc, int fr, int fq) const {
    const int row0 = u.pm * 256 + wr * 64 + fr, pn = u.pn;
    const bool act = false, rope = (pn < 8) && (u.pm >= 32);
    const float scl = (pn >= 4 && pn < 8) ? 0.08838834764831845f : 1.0f;
    const int i0 = 16 * (wc & 1) + 4 * fq, hf = wc >> 1;
#pragma unroll
    for (int bj = 0; bj < 2; ++bj) {
      const int c0 = pn * 256 + bj * 128 + wc * 32 + 8 * fq;
#pragma unroll
      for (int ai = 0; ai < 2; ++ai)
#pragma unroll
        for (int m = 0; m < 4; ++m) {
          const int row = row0 + ai * 128 + m * 16;
          float v[8];
#pragma unroll
          for (int j = 0; j < 4; ++j) { v[j] = acc[ai][bj][m][0][j]; v[4 + j] = acc[ai][bj][m][1][j]; }
          if (rope) {
            const int t = row & 1023, pos = hf ? (t & 63) : (t >> 6);
            const f32x4 cs = *(const f32x4*)(ropeT + pos * 32 + i0), sn = *(const f32x4*)(ropeT + 2048 + pos * 32 + i0);
#pragma unroll
            for (int q = 0; q < 4; ++q) { const float a = v[2 * q], b = v[2 * q + 1]; v[2 * q] = a * cs[q] - b * sn[q]; v[2 * q + 1] = b * cs[q] + a * sn[q]; }
          }
#pragma unroll
          for (int j = 0; j < 8; ++j) v[j] = act ? silu_f(v[j]) : v[j] * scl;
          *(u32x4*)(P1 + (size_t)row * 4096 + c0) = pack8(v);
        }
    }
  }
};
struct EpiOut {
  static constexpr bool PERM = true;
  const float* gate;
  bf16_t* delta;
  DI void operator()(const f32x4 (&acc)[2][2][4][2], const pg8::Unit& u, int wr, int wc, int fr, int fq) const {
    const int pm = u.pm, row0 = pm * 256 + wr * 64 + fr, col0 = u.pn * 256 + wc * 32 + 8 * fq;
    const int cond = pm < 32 ? 0 : 1 + ((pm - 32) >> 2);
    const float* gp = gate + cond * 3072 + 2048 + col0;
    f32x4 gv[2][2];
#pragma unroll
    for (int bj = 0; bj < 2; ++bj)
#pragma unroll
      for (int n = 0; n < 2; ++n) gv[bj][n] = *(const f32x4*)(gp + bj * 128 + n * 4);
#pragma unroll
    for (int ai = 0; ai < 2; ++ai)
#pragma unroll
      for (int m = 0; m < 4; ++m) {
        bf16_t* dst = delta + (size_t)(row0 + ai * 128 + m * 16) * 1024 + col0;
#pragma unroll
        for (int bj = 0; bj < 2; ++bj) {
          const f32x4 a = gv[bj][0] * acc[ai][bj][m][0], b = gv[bj][1] * acc[ai][bj][m][1];
          u32x4 w; w.x = cvt_pk_bf16(a[0], a[1]); w.y = cvt_pk_bf16(a[2], a[3]); w.z = cvt_pk_bf16(b[0], b[1]); w.w = cvt_pk_bf16(b[2], b[3]);
          *(u32x4*)(dst + bj * 128) = w;
        }
      }
  }
};

template <bool PERMQK>
DI void tr_tile2(const float* __restrict__ W, const int N, bf16_t* __restrict__ Bt, const int nTn, const int t0, const int ntiles, float* tile) {
  const int tid = opaque_i((int)threadIdx.x);
  const int r = tid >> 4, c4 = (tid & 15) * 4;
  f32x4 v[2][2];
#pragma unroll
  for (int h = 0; h < 2; ++h) {
    const int t = min(t0 + h, ntiles - 1), k0 = (t / nTn) * 64, n0 = (t % nTn) * 64;
#pragma unroll
    for (int rr = 0; rr < 2; ++rr) {
      v[h][rr] = (f32x4){0.f, 0.f, 0.f, 0.f};
      if (n0 + c4 < N) v[h][rr] = __builtin_nontemporal_load((const f32x4*)(W + (size_t)(k0 + r + 32 * rr) * N + n0 + c4));
    }
  }
#pragma unroll
  for (int h = 0; h < 2; ++h)
#pragma unroll
    for (int rr = 0; rr < 2; ++rr) { float* d = tile + h * 4160 + (r + 32 * rr) * 65 + c4; d[0] = v[h][rr][0]; d[1] = v[h][rr][1]; d[2] = v[h][rr][2]; d[3] = v[h][rr][3]; }
  __syncthreads();
  const int n = tid >> 3, k8 = (tid & 7) * 8;
#pragma unroll
  for (int h = 0; h < 2; ++h) {
    const int t = t0 + h;
    if (t < ntiles) {
      const int k0 = (t / nTn) * 64, n0 = (t % nTn) * 64;
      if (n0 + n < N) {
        float o[8];
#pragma unroll
        for (int j = 0; j < 8; ++j) o[j] = tile[h * 4160 + (k8 + j) * 65 + n];
        int nr = n0 + n;
        if (PERMQK && nr < 2048) { const int d = nr & 127; nr = (nr & ~127) + 64 * (d >> 6) + 2 * (d & 31) + ((d >> 5) & 1); }
        *(u32x4*)(Bt + (size_t)nr * 1024 + k0 + k8) = pack8(o);
      }
    }
  }
  __syncthreads();
}
DI void phase0b_transposes(const Params& p, unsigned char* shm) {
  const int nb = gridDim.x, bid = blockIdx.x;
  const bool sp = (nb == 256);
  const int slot = sp ? bid - 48 : bid, nsl = sp ? 208 : nb;
  if (slot < 0) return;
  float* tile = (float*)shm;
  for (int t = 2 * slot; t < 1040; t += 2 * nsl) tr_tile2<false>(p.w_in_even, 4128, (bf16_t*)(p.ws + OFF_BTIN0), 65, t, 1040, tile);
}
DI void prep_layer1(const Params& p, unsigned char* shm, const int slot, const int nsl) {
  float* tile = (float*)shm;
  for (int t = 2 * slot; t < 1024; t += 2 * nsl) tr_tile2<true>(p.w_in_odd, 4096, (bf16_t*)(p.ws + OFF_BTIN1), 64, t, 1024, tile);
  for (int t = 2 * (nsl - 1 - slot); t < 256; t += 2 * nsl) tr_tile2<false>(p.w_out_odd, 1024, (bf16_t*)(p.ws + OFF_BTOUT1), 16, t, 256, tile);
  for (int t = 2 * (nsl - 1 - slot); t < 256; t += 2 * nsl) tr_tile2<false>(p.w_out_even, 1024, (bf16_t*)(p.ws + OFF_BTOUT0), 16, t, 256, tile);
}
DI void mod_partials(const Params& p, const int l, const int gw, const int nw) {
  const int lane = opaque_i((int)threadIdx.x) & 63;
  float* modp = (float*)(p.ws + OFF_MODP);
  for (int it = gw; it < 384; it += nw) {
    const int ks = it & 7, cgp = it >> 3;
    float a0 = 0.f, a1 = 0.f, a2 = 0.f, a3 = 0.f, a4 = 0.f;
    const float* wp = p.ada_w + (size_t)l * 1024 * 3072 + (size_t)(ks * 128) * 3072 + cgp * 64 + lane;
#pragma unroll 1
    for (int hh = 0; hh < 2; ++hh) {
      const int k = ks * 128 + hh * 64 + lane;
      const float s0 = silu_f(p.c_ctx[k]), s1 = silu_f(p.c[k]), s2 = silu_f(p.c[1024 + k]), s3 = silu_f(p.c[2048 + k]), s4 = silu_f(p.c[3072 + k]);
#pragma unroll 16
      for (int kk = 0; kk < 64; ++kk) {
        const float w = __builtin_nontemporal_load(wp + (size_t)(hh * 64 + kk) * 3072);
        a0 += __shfl(s0, kk) * w; a1 += __shfl(s1, kk) * w; a2 += __shfl(s2, kk) * w; a3 += __shfl(s3, kk) * w; a4 += __shfl(s4, kk) * w;
      }
    }
    float* mo = modp + ((size_t)(ks * 2 + l) * 5) * 3072 + cgp * 64 + lane;
    mo[0] = a0; mo[3072] = a1; mo[6144] = a2; mo[9216] = a3; mo[12288] = a4;
  }
}
DI void phase0(const Params& p, unsigned char* shm) {
  const int tid = opaque_i((int)threadIdx.x), nb = gridDim.x, bid = blockIdx.x;
  mod_partials(p, 0, bid * 8 + (tid >> 6), nb * 8);
  float* rope = (float*)(p.ws + OFF_ROPE);
  for (int i = bid * 512 + tid; i < 2048; i += nb * 512) {
    const int pos = i >> 5, fi = i & 31;
    const float inv = exp2f(-(float)(2 * fi) * (13.287712379549449f / 64.0f));
    const float ang = (float)pos * inv;
    const double kq = rint((double)ang * 0.15915494309189535);
    const float rr = (float)((double)ang - kq * 6.283185307179586);
    rope[i] = __cosf(rr);
    rope[2048 + i] = __sinf(rr);
  }
}

DI void phase_norm_mod(const Params& p, int l, bool with_delta) {
  const int tid = opaque_i((int)threadIdx.x), nb = gridDim.x, bid = blockIdx.x, wid = tid >> 6, lane = tid & 63, gw = bid * 8 + wid, nw = nb * 8;
  const float* modp = (const float*)(p.ws + OFF_MODP);
  bf16_t* A = (bf16_t*)(p.ws + OFF_A);
  {
    float* mod = (float*)(p.ws + OFF_MOD);
    for (int i = l * 15360 + bid * 512 + tid; i < (l + 1) * 15360; i += nb * 512) {
      float s = p.ada_b[(i / 15360) * 3072 + (i % 3072)];
#pragma unroll
      for (int ks = 0; ks < 8; ++ks) s += modp[ks * 30720 + i];
      mod[i] = s;
    }
  }
  const int rpw = (TALL + nw - 1) / nw;
  int cur = -1;
  f32x4 sc[4], sh[4], nwv[4];
#pragma unroll
  for (int i = 0; i < 4; ++i) { nwv[i] = *(const f32x4*)(p.norm_w + l * 1024 + lane * 4 + 256 * i); sc[i] = (f32x4){0.f, 0.f, 0.f, 0.f}; sh[i] = sc[i]; }
  const int rend = min(TALL, (gw + 1) * rpw);
  for (int rb = gw * rpw; rb < rend; rb += 6) {
    f32x4 x[6][4];
#pragma unroll
    for (int j = 0; j < 6; ++j) {
      const int r = min(rb + j, rend - 1);
      const float* src = r < TCTX ? p.x_prompt + (size_t)r * 1024 : p.x_sample + (size_t)(r - TCTX) * 1024;
#pragma unroll
      for (int i = 0; i < 4; ++i) x[j][i] = __builtin_nontemporal_load((const f32x4*)(src + lane * 4 + 256 * i));
      if (with_delta) {
        const bf16_t* dp = (const bf16_t*)(p.ws + OFF_D0) + (size_t)r * 1024 + lane * 4;
#pragma unroll
        for (int i = 0; i < 4; ++i) { const u32x2 dv = *(const u32x2*)(dp + 256 * i); x[j][i] += (f32x4){bf_lo(dv.x), bf_hi(dv.x), bf_lo(dv.y), bf_hi(dv.y)}; }
      }
    }
#pragma unroll
    for (int j = 0; j < 6; ++j) {
      const int r = rb + j;
      if (r < rend) {
        const int cond = r < TCTX ? 0 : 1 + ((r - TCTX) >> 10);
        if (cond != cur) {
          cur = cond;
#pragma unroll
          for (int i = 0; i < 4; ++i) {
            const int col = lane * 4 + 256 * i;
            f32x4 a = *(const f32x4*)(p.ada_b + l * 3072 + col), b = *(const f32x4*)(p.ada_b + l * 3072 + 1024 + col);
#pragma unroll 2
            for (int ks = 0; ks < 8; ++ks) {
              const float* mp = modp + ((size_t)(ks * 2 + l) * 5 + cond) * 3072 + col;
              a += *(const f32x4*)mp; b += *(const f32x4*)(mp + 1024);
            }
            sh[i] = a; sc[i] = b;
          }
        }
        float ss = 0.f;
#pragma unroll
        for (int i = 0; i < 4; ++i) ss += x[j][i][0] * x[j][i][0] + x[j][i][1] * x[j][i][1] + x[j][i][2] * x[j][i][2] + x[j][i][3] * x[j][i][3];
        ss = wave_sum(ss);
        const float rstd = rsqrtf(ss * (1.0f / 1024.0f) + 1e-6f);
#pragma unroll
        for (int i = 0; i < 4; ++i) {
          f32x4 h = x[j][i] * rstd * nwv[i] * (sc[i] + 1.0f) + sh[i];
          u32x2 w; w.x = cvt_pk_bf16(h[0], h[1]); w.y = cvt_pk_bf16(h[2], h[3]);
          *(u32x2*)(A + (size_t)r * 1024 + lane * 4 + 256 * i) = w;
        }
      }
    }
  }
}

DI void phase_tail(const Params& p, unsigned char* shm) {
  const int tid = opaque_i((int)threadIdx.x), nb = gridDim.x, bid = blockIdx.x, wid = tid >> 6, lane = tid & 63;
  const int r16 = lane & 15, g = lane >> 4;
  float* part = (float*)shm;
  float* lowS = (float*)(shm + 50688);
  const bf16_t* A = (const bf16_t*)(p.ws + OFF_A);
  const bf16_t* Bt = (const bf16_t*)(p.ws + OFF_BTIN0) + (size_t)4096 * 1024;
  _Float16* GG = (_Float16*)(p.ws + OFF_GG);
  const int gd = tid >> 8, gc = tid & 255;
  float w[16];
#pragma unroll
  for (int r = 0; r < 16; ++r) w[r] = p.gla_gk_w[(gd * 16 + r) * 256 + gc];
  const float gb = p.gla_gk_b[gd * 256 + gc];
  for (int grp = bid; grp < TALL / 48; grp += nb) {
    const int row0 = grp * 48;
    {
      f32x4 acc[3][2];
#pragma unroll
      for (int j = 0; j < 3; ++j) { acc[j][0] = (f32x4){0.f, 0.f, 0.f, 0.f}; acc[j][1] = acc[j][0]; }
      const bf16_t* ap = A + (size_t)(row0 + r16) * 1024 + wid * 128 + 8 * g;
      const bf16_t* bp = Bt + (size_t)r16 * 1024 + wid * 128 + 8 * g;
#pragma unroll
      for (int ks = 0; ks < 4; ++ks) {
        const bf16x8 x0 = *(const bf16x8*)(bp + ks * 32), x1 = *(const bf16x8*)(bp + 16 * 1024 + ks * 32);
#pragma unroll
        for (int j = 0; j < 3; ++j) {
          const bf16x8 a = *(const bf16x8*)(ap + (size_t)j * 16 * 1024 + ks * 32);
          acc[j][0] = __builtin_amdgcn_mfma_f32_16x16x32_bf16(a, x0, acc[j][0], 0, 0, 0);
          acc[j][1] = __builtin_amdgcn_mfma_f32_16x16x32_bf16(a, x1, acc[j][1], 0, 0, 0);
        }
      }
#pragma unroll
      for (int j = 0; j < 3; ++j)
#pragma unroll
        for (int i = 0; i < 4; ++i) {
          float* d = part + ((wid * 3 + j) * 16 + 4 * g + i) * 33;
          d[r16] = acc[j][0][i]; d[16 + r16] = acc[j][1][i];
        }
    }
    __syncthreads();
    for (int e = tid; e < 1536; e += 512) {
      const int rr = e >> 5, c = e & 31, j = rr >> 4, r = rr & 15;
      float sum = 0.f;
#pragma unroll
      for (int w = 0; w < 8; ++w) sum += part[((w * 3 + j) * 16 + r) * 33 + c];
      lowS[rr * 36 + c] = sum;
    }
    __syncthreads();
    {
#pragma unroll 4
      for (int t = 0; t < 48; ++t) {
        const f32x4 l0 = *(const f32x4*)(lowS + t * 36 + 16 * gd), l1 = *(const f32x4*)(lowS + t * 36 + 16 * gd + 4),
                    l2 = *(const f32x4*)(lowS + t * 36 + 16 * gd + 8), l3 = *(const f32x4*)(lowS + t * 36 + 16 * gd + 12);
        float s0 = gb, s1 = 0.f, s2 = 0.f, s3 = 0.f;
#pragma unroll
        for (int r = 0; r < 4; ++r) { s0 += l0[r] * w[r]; s1 += l1[r] * w[4 + r]; s2 += l2[r] * w[8 + r]; s3 += l3[r] * w[12 + r]; }
        GG[(size_t)(row0 + t) * 512 + tid] = (_Float16)(logsigmoid_f((s0 + s1) + (s2 + s3)) * 0.0625f);
      }
    }
    __syncthreads();
  }
}

enum { T_HGRN = 0, T_GLA = 1, T_RET = 2 };
#define MFMA16(a, b, c) __builtin_amdgcn_mfma_f32_16x16x32_bf16((a), (b), (c), 0, 0, 0)
DI bf16x8 ld_frag(const bf16_t* base) {
  const s16x4 lo = *(const s16x4*)base, hi = *(const s16x4*)(base + 16);
  return __builtin_shufflevector(lo, hi, 0, 1, 2, 3, 4, 5, 6, 7);
}
DI bf16x8 ld_frag_tr(const bf16_t* base, int hi_off) {
  const s16x4 lo = __builtin_amdgcn_ds_read_tr16_b64_v4i16((LAS s16x4*)base), hi = __builtin_amdgcn_ds_read_tr16_b64_v4i16((LAS s16x4*)(base + hi_off));
  return __builtin_shufflevector(lo, hi, 0, 1, 2, 3, 4, 5, 6, 7);
}
DI bf16x8 pack_frag(const f32x4& a, const f32x4& b) {
  u32x4 w; w.x = cvt_pk_bf16(a[0], a[1]); w.y = cvt_pk_bf16(a[2], a[3]); w.z = cvt_pk_bf16(b[0], b[1]); w.w = cvt_pk_bf16(b[2], b[3]);
  return __builtin_bit_cast(bf16x8, w);
}

struct LoadSet { u32x4 q, k, v, qp, kp, lg; f32x4 c0, c1, s0, s1; };
template <int KD, int TYPE>
DI void scan_unit(unsigned char* shm, const bf16_t* Pq, const bf16_t* Pk, const bf16_t* Pv, int PS, const _Float16* lgp, int LS, float lgs,
                  const float* s0, float* sout, bf16_t* O, int rowbase, int Tlen, int dir, const float* sdummy, bool rope) {
  const float* ropeT = sdummy;
  constexpr int QS = KD + 8, NP = KD / 32, NKT = KD / 16;
  constexpr int BUFB = 35840, VS = 136;
  const int tid = opaque_i((int)threadIdx.x), wid = tid >> 6, lane = tid & 63, r16 = lane & 15, g = lane >> 4;
  const bool active = wid < KD / 16;
  const int ei = lane & 31, c8 = (16 * wid + 8 * (lane >> 5)) & (KD - 1);
  const int vi = tid >> 4, j8 = (tid & 15) * 8;
  const int jcol = 16 * wid + r16;

  f32x4 accS[NKT];
#pragma unroll
  for (int kt = 0; kt < NKT; ++kt)
#pragma unroll
    for (int i = 0; i < 4; ++i) { const float sv = (s0 ? s0 : sdummy)[(size_t)(16 * kt + 4 * g + i) * 128 + jcol]; accS[kt][i] = s0 ? sv : 0.f; }

  const int nsteps = Tlen >> 5;
  LoadSet LA, LB;
  LA.q = (u32x4){0u, 0u, 0u, 0u}; LA.k = LA.q; LA.v = LA.q; LA.qp = LA.q; LA.kp = LA.q; LA.lg = LA.q;
  LA.c0 = (f32x4){0.f, 0.f, 0.f, 0.f}; LA.c1 = LA.c0; LA.s0 = LA.c0; LA.s1 = LA.c0;
  LB = LA;
  const int eiL = ei;
  auto issue_loads = [&](int n, LoadSet& X) {
    const int tb = 32 * n;
    const int tokE = dir ? Tlen - 1 - (tb + eiL) : tb + eiL;
    const int tokV = dir ? Tlen - 1 - (tb + vi) : tb + vi;
    const size_t ro = (size_t)(rowbase + tokE) * PS;
    X.q = *(const u32x4*)(Pq + ro + c8);
    if (TYPE != T_RET) X.lg = *(const u32x4*)(lgp + (size_t)(rowbase + tokE) * LS + c8);
    if (TYPE != T_HGRN) X.k = *(const u32x4*)(Pk + ro + c8);
    if (TYPE == T_RET) {
      X.qp = *(const u32x4*)(Pq + ro + (c8 ^ 32)); X.kp = *(const u32x4*)(Pk + ro + (c8 ^ 32));
      const int pos = (c8 < 64) ? (tokE >> 6) : (tokE & 63);
      const float* rp = ropeT + pos * 32 + (c8 & 31);
      X.c0 = *(const f32x4*)rp; X.c1 = *(const f32x4*)(rp + 4); X.s0 = *(const f32x4*)(rp + 2048); X.s1 = *(const f32x4*)(rp + 2052);
    }
    X.v = *(const u32x4*)(Pv + (size_t)(rowbase + tokV) * PS + j8);
  };
  auto step = [&](int n, LoadSet& X) {
    const int tb = 32 * n;
    unsigned char* buf = shm + (n & 1) * BUFB;
    bf16_t* QR = (bf16_t*)buf;
    bf16_t* KI = (bf16_t*)(buf + 8704);
    bf16_t* KDm = (bf16_t*)(buf + 17408);
    bf16_t* Vm = (bf16_t*)(buf + 26112);
    float* EV = (float*)(buf + 34816);
    if (active) {
      float pre[8];
      const f16x8 hl = __builtin_bit_cast(f16x8, X.lg);
#pragma unroll
      for (int e = 0; e < 8; ++e) pre[e] = (float)hl[e];
#define DPP_ADD(ctrl, rmask, bc) _Pragma("unroll") for (int e = 0; e < 8; ++e) pre[e] += __builtin_bit_cast(float, __builtin_amdgcn_update_dpp(0, __builtin_bit_cast(int, pre[e]), ctrl, rmask, 0xf, bc))
      DPP_ADD(0x111, 0xf, true);
      DPP_ADD(0x112, 0xf, true);
      DPP_ADD(0x114, 0xf, true);
      DPP_ADD(0x118, 0xf, true);
      DPP_ADD(0x142, 0xa, false);
#undef DPP_ADD
      float q[8], kk[8];
      unpack8(X.q, q);
      if (TYPE == T_HGRN) {
#pragma unroll
        for (int e = 0; e < 8; ++e) kk[e] = 1.0f - __expf((float)hl[e]);
      } else unpack8(X.k, kk);
      float qr[8], ki[8], kd[8];
      const int lR = ((lane & 32) | 15) << 2, lL = (lane | 31) << 2;
#pragma unroll
      for (int e = 0; e < 8; ++e) {
        const float rr = __builtin_bit_cast(float, __builtin_amdgcn_ds_bpermute(lR, __builtin_bit_cast(int, pre[e])));
        const float x = __builtin_amdgcn_fmed3f(pre[e] - rr, -80.f, 80.f);
        const float er = __expf(x), ek = __builtin_amdgcn_rcpf(er);
        const float er31 = __builtin_bit_cast(float, __builtin_amdgcn_ds_bpermute(lL, __builtin_bit_cast(int, er)));
        qr[e] = q[e] * er; ki[e] = kk[e] * ek; kd[e] = ki[e] * er31;
      }
      if ((lane & 15) == 15) {
        float* evp = EV + ((lane & 16) ? 0 : 128) + c8;
#pragma unroll
        for (int e = 0; e < 8; ++e) evp[e] = __expf(pre[e]);
      }
      *(u32x4*)(QR + ei * QS + c8) = pack8(qr);
      *(u32x4*)(KI + ei * QS + c8) = pack8(ki);
      *(u32x4*)(KDm + ei * QS + c8) = pack8(kd);
    }
    *(u32x4*)(Vm + vi * VS + j8) = X.v;
    issue_loads(min(n + 2, nsteps - 1), X);
    __syncthreads();
    {
      const int tq = r16 >> 2, tp = r16 & 3;
      const bf16x8 vfrag = ld_frag_tr(Vm + (4 * g + tq) * VS + 16 * wid + 4 * tp, 16 * VS);
      bf16x8 qf[2][NP];
#pragma unroll
      for (int tt = 0; tt < 2; ++tt)
#pragma unroll
        for (int pp = 0; pp < NP; ++pp) qf[tt][pp] = ld_frag(QR + (16 * tt + r16) * QS + 32 * pp + 4 * g);
      f32x4 sc00 = (f32x4){0.f, 0.f, 0.f, 0.f}, sc01 = sc00, sc11 = sc00;
#pragma unroll
      for (int pp = 0; pp < NP; ++pp) {
        const bf16x8 kf0 = ld_frag(KI + r16 * QS + 32 * pp + 4 * g), kf1 = ld_frag(KI + (16 + r16) * QS + 32 * pp + 4 * g);
        sc00 = MFMA16(kf0, qf[0][pp], sc00); sc01 = MFMA16(kf0, qf[1][pp], sc01); sc11 = MFMA16(kf1, qf[1][pp], sc11);
      }
#pragma unroll
      for (int i = 0; i < 4; ++i) if (4 * g + i > r16) { sc00[i] = 0.f; sc11[i] = 0.f; }
      const f32x4 z4 = (f32x4){0.f, 0.f, 0.f, 0.f};
      const bf16x8 pf0 = pack_frag(sc00, z4), pf1 = pack_frag(sc01, sc11);
      f32x4 o0 = MFMA16(vfrag, pf0, z4), o1 = MFMA16(vfrag, pf1, z4);
#pragma unroll
      for (int pp = 0; pp < NP; ++pp) {
        f32x4 e0, e1;
        e0 = *(const f32x4*)(EV + 128 + 32 * pp + 4 * g); e1 = *(const f32x4*)(EV + 128 + 32 * pp + 16 + 4 * g);
        const bf16x8 sf = pack_frag(accS[2 * pp] * e0, accS[2 * pp + 1] * e1);
        o0 = MFMA16(sf, qf[0][pp], o0); o1 = MFMA16(sf, qf[1][pp], o1);
      }
#pragma unroll
      for (int kt = 0; kt < NKT; ++kt) {
        f32x4 eb;
        eb = *(const f32x4*)(EV + 16 * kt + 4 * g);
        const bf16x8 kdf = ld_frag_tr(KDm + (4 * g + tq) * QS + 16 * kt + 4 * tp, 16 * QS);
        accS[kt] = MFMA16(kdf, vfrag, accS[kt] * eb);
      }
      {
        const int t0 = tb + r16, t1 = tb + 16 + r16;
        const int tok0 = dir ? Tlen - 1 - t0 : t0, tok1 = dir ? Tlen - 1 - t1 : t1;
        u32x2 w0, w1; w0.x = cvt_pk_bf16(o0[0], o0[1]); w0.y = cvt_pk_bf16(o0[2], o0[3]); w1.x = cvt_pk_bf16(o1[0], o1[1]); w1.y = cvt_pk_bf16(o1[2], o1[3]);
        *(u32x2*)(O + (size_t)(rowbase + tok0) * 1024 + 16 * wid + 4 * g) = w0;
        *(u32x2*)(O + (size_t)(rowbase + tok1) * 1024 + 16 * wid + 4 * g) = w1;
      }
    }
  };
  issue_loads(0, LA);
  issue_loads(1, LB);
  for (int n = 0; n < nsteps; n += 2) { step(n, LA); step(n + 1, LB); }
  if (sout) {
#pragma unroll
    for (int kt = 0; kt < NKT; ++kt)
#pragma unroll
      for (int i = 0; i < 4; ++i) sout[(size_t)(16 * kt + 4 * g + i) * 128 + jcol] = accS[kt][i];
  }
  __syncthreads();
}


struct LoadSet3 { u32x4 q, k, v; };
DI int ret_lrow(int pk) { const int pp = pk >> 1; return 64 * (pp >> 5) + (pp & 31) + 32 * (pk & 1); }
DI void scan_unit_ret(unsigned char* shm, const bf16_t* Pq, const bf16_t* Pk, const bf16_t* Pv, float lgs, const float* s0, float* sout, bf16_t* O,
                      int rowbase, int Tlen, int dir, const float* sdummy) {
  constexpr int QS = 136, NP = 4, NKT = 8, PS = 4096, BUFB = 3 * 8704;
  const int tid = opaque_i((int)threadIdx.x), wid = tid >> 6, lane = tid & 63, r16 = lane & 15, g = lane >> 4;
  const int ei = tid >> 4, c8 = (tid & 15) * 8;
  const int jcol = 16 * wid + r16;
  f32x4 accS[NKT];
#pragma unroll
  for (int kt = 0; kt < NKT; ++kt)
#pragma unroll
    for (int i = 0; i < 4; ++i) { const float sv = (s0 ? s0 : sdummy)[(size_t)ret_lrow(16 * kt + 4 * g + i) * 128 + jcol]; accS[kt][i] = s0 ? sv : 0.f; }
  f32x4 dm, d01; float cs[8];
#pragma unroll
  for (int i = 0; i < 4; ++i) { const int dd = r16 - 4 * g - i; dm[i] = dd >= 0 ? __expf((float)dd * lgs) : 0.f; d01[i] = __expf((float)(16 + dd) * lgs); }
#pragma unroll
  for (int j = 0; j < 8; ++j) cs[j] = __expf((float)(31 - (16 * (j >> 2) + 4 * g + (j & 3))) * lgs);
  const float ct0 = __expf((float)(r16 + 1) * lgs), ct1 = __expf((float)(r16 + 17) * lgs), eb = __expf(32.0f * lgs);
  const int nsteps = Tlen >> 5;
  LoadSet3 LA, LB;
  auto issue_loads = [&](int n, LoadSet3& X) {
    const int tok = dir ? Tlen - 1 - (32 * n + ei) : 32 * n + ei;
    const size_t ro = (size_t)(rowbase + tok) * PS + c8;
    X.q = *(const u32x4*)(Pq + ro); X.k = *(const u32x4*)(Pk + ro); X.v = *(const u32x4*)(Pv + ro);
  };
  auto step = [&](int n, LoadSet3& X) {
    const int tb = 32 * n;
    unsigned char* buf = shm + (n & 1) * BUFB;
    bf16_t* Qm = (bf16_t*)buf; bf16_t* Km = (bf16_t*)(buf + 8704); bf16_t* Vm = (bf16_t*)(buf + 17408);
    *(u32x4*)(Qm + ei * QS + c8) = X.q;
    *(u32x4*)(Km + ei * QS + c8) = X.k;
    *(u32x4*)(Vm + ei * QS + c8) = X.v;
    issue_loads(min(n + 2, nsteps - 1), X);
    __syncthreads();
    const int tq = r16 >> 2, tp = r16 & 3;
    const bf16x8 vfrag = ld_frag_tr(Vm + (4 * g + tq) * QS + 16 * wid + 4 * tp, 16 * QS);
    bf16x8 qf[2][NP];
#pragma unroll
    for (int tt = 0; tt < 2; ++tt)
#pragma unroll
      for (int pp = 0; pp < NP; ++pp) qf[tt][pp] = ld_frag(Qm + (16 * tt + r16) * QS + 32 * pp + 4 * g);
    f32x4 sc00 = (f32x4){0.f, 0.f, 0.f, 0.f}, sc01 = sc00, sc11 = sc00;
#pragma unroll
    for (int pp = 0; pp < NP; ++pp) {
      const bf16x8 kf0 = ld_frag(Km + r16 * QS + 32 * pp + 4 * g), kf1 = ld_frag(Km + (16 + r16) * QS + 32 * pp + 4 * g);
      sc00 = MFMA16(kf0, qf[0][pp], sc00); sc01 = MFMA16(kf0, qf[1][pp], sc01); sc11 = MFMA16(kf1, qf[1][pp], sc11);
    }
    const f32x4 z4 = (f32x4){0.f, 0.f, 0.f, 0.f};
    const bf16x8 pf0 = pack_frag(sc00 * dm, z4), pf1 = pack_frag(sc01 * d01, sc11 * dm);
    f32x4 o0 = MFMA16(vfrag, pf0, z4), o1 = MFMA16(vfrag, pf1, z4);
    f32x4 oi0 = z4, oi1 = z4;
#pragma unroll
    for (int pp = 0; pp < NP; ++pp) {
      const bf16x8 sf = pack_frag(accS[2 * pp], accS[2 * pp + 1]);
      oi0 = MFMA16(sf, qf[0][pp], oi0); oi1 = MFMA16(sf, qf[1][pp], oi1);
    }
    o0 += oi0 * ct0; o1 += oi1 * ct1;
    bf16x8 vsf;
    {
      float vv[8];
      unpack8(__builtin_bit_cast(u32x4, vfrag), vv);
#pragma unroll
      for (int j = 0; j < 8; ++j) vv[j] *= cs[j];
      vsf = __builtin_bit_cast(bf16x8, pack8(vv));
    }
#pragma unroll
    for (int kt = 0; kt < NKT; ++kt) {
      const bf16x8 kdf = ld_frag_tr(Km + (4 * g + tq) * QS + 16 * kt + 4 * tp, 16 * QS);
      accS[kt] = MFMA16(kdf, vsf, accS[kt] * eb);
    }
    {
      const int t0 = tb + r16, t1 = tb + 16 + r16;
      const int tok0 = dir ? Tlen - 1 - t0 : t0, tok1 = dir ? Tlen - 1 - t1 : t1;
      u32x2 w0, w1; w0.x = cvt_pk_bf16(o0[0], o0[1]); w0.y = cvt_pk_bf16(o0[2], o0[3]); w1.x = cvt_pk_bf16(o1[0], o1[1]); w1.y = cvt_pk_bf16(o1[2], o1[3]);
      *(u32x2*)(O + (size_t)(rowbase + tok0) * 1024 + 16 * wid + 4 * g) = w0;
      *(u32x2*)(O + (size_t)(rowbase + tok1) * 1024 + 16 * wid + 4 * g) = w1;
    }
  };
  issue_loads(0, LA);
  issue_loads(1, LB);
  for (int n = 0; n < nsteps; n += 2) { step(n, LA); step(n + 1, LB); }
  if (sout) {
#pragma unroll
    for (int kt = 0; kt < NKT; ++kt)
#pragma unroll
      for (int i = 0; i < 4; ++i) sout[(size_t)ret_lrow(16 * kt + 4 * g + i) * 128 + jcol] = accS[kt][i];
  }
  __syncthreads();
}

DI int scan_unit_id(int k, int bid, int nb) {
  if (nb == 256) {
    if (bid < 64) return k == 0 ? bid : -1;
    const int j = bid - 64;
    if (k == 0) return 64 + j;
    if (k == 1) return 64 + 192 + j;
    if (k == 2 && j < 128) return 64 + 384 + j;
    return -1;
  }
  const int u = bid + k * nb;
  return u < 576 ? u : -1;
}

DI void phase_scan(const Params& p, int layer, unsigned char* shm) {
  const int bid = blockIdx.x, nb = gridDim.x;
  bf16_t* OF = (bf16_t*)(p.ws + OFF_OF); bf16_t* OB = (bf16_t*)(p.ws + OFF_OB);
  const bf16_t* P = (const bf16_t*)(p.ws + OFF_P);
  for (int k = 0;; ++k) {
    const int u = scan_unit_id(k, bid, nb);
    if (u < 0) break;
    const bool lat = u < 64;
    const int v = lat ? u : u - 64;
    if (layer == 0) {
      const int half = lat ? 32 : 256;
      const bool gla = v >= half;
      const int idx = gla ? v - half : v;
      const int b = idx >> 3, h = (idx >> 1) & 3, d = idx & 1;
      const int rowbase = lat ? TCTX + b * 1024 : b * 256, Tlen = lat ? 1024 : 256;
      bf16_t* O = (d ? OB : OF);
      if (!gla) {
        const float* s0 = lat ? p.state_hgrn + (size_t)((b * 2 + d) * 4 + h) * 16384 : nullptr;
        float* so = lat ? nullptr : p.out + OUT_HGRN + (size_t)((b * 2 + d) * 4 + h) * 16384;
        scan_unit<128, T_HGRN>(shm, P + h * 128, nullptr, P + 512 + h * 128, 3072, (const _Float16*)(p.ws + OFF_LG) + d * 512 + h * 128, 1024, 0.f, s0, so,
                               O + h * 128, rowbase, Tlen, d, p.state_hgrn, false);
      } else {
        const float* s0 = lat ? p.state_gla + (size_t)((b * 2 + d) * 4 + h) * 8192 : nullptr;
        float* so = lat ? nullptr : p.out + OUT_GLA + (size_t)((b * 2 + d) * 4 + h) * 8192;
        scan_unit<64, T_GLA>(shm, P + 1536 + h * 64, P + 1792 + h * 64, P + 2048 + h * 128, 3072, (const _Float16*)(p.ws + OFF_GG) + d * 256 + h * 64, 512, 0.f,
                             s0, so, O + 512 + h * 128, rowbase, Tlen, d, p.state_hgrn, false);
      }
    } else {
      const int b = v >> 4, h = (v >> 1) & 7, d = v & 1;
      const int rowbase = lat ? TCTX + b * 1024 : b * 256, Tlen = lat ? 1024 : 256;
      const float* s0 = lat ? p.state_ret + (size_t)((b * 2 + d) * 8 + h) * 16384 : nullptr;
      float* so = lat ? nullptr : p.out + OUT_RET + (size_t)((b * 2 + d) * 8 + h) * 16384;
      const float lgs = logsigmoid_f(p.ret_decay[d * 8 + h]);
      scan_unit_ret(shm, P + h * 128, P + 1024 + h * 128, P + 2048 + h * 128, lgs, s0, so, (d ? OB : OF) + h * 128, rowbase, Tlen, d, p.state_ret);
    }
  }
  if (layer == 0) {
    const bool sp = (nb == 256);
    const int slot = sp ? bid - 64 : bid, nsl = sp ? 192 : nb;
    if (slot >= 0) {
      prep_layer1(p, shm, slot, nsl);
      mod_partials(p, 1, slot * 8 + ((int)threadIdx.x >> 6), nsl * 8);
    }
  }
}

DI void phase_combine(const Params& p, int layer) {
  const int tid = opaque_i((int)threadIdx.x), nb = gridDim.x, bid = blockIdx.x, wid = tid >> 6, lane = tid & 63, gw = bid * 8 + wid, nw = nb * 8;
  const bf16_t* OF = (const bf16_t*)(p.ws + OFF_OF); const bf16_t* OB = (const bf16_t*)(p.ws + OFF_OB);
  const bf16_t* P = (const bf16_t*)(p.ws + OFF_P);
  bf16_t* A = (bf16_t*)(p.ws + OFF_A);
  const float* gn = layer == 0 ? p.gn_even : p.gn_odd;
  const int c0 = lane * 16;
  float gnv[16];
#pragma unroll
  for (int i = 0; i < 16; ++i) gnv[i] = gn[c0 + i];
  for (int rb = gw; rb < TALL; rb += 6 * nw) {
    u32x4 rf[6][2], rbk[6][2], rg[6][2];
#pragma unroll
    for (int j = 0; j < 6; ++j) {
      const int r = min(rb + j * nw, TALL - 1);
      const bf16_t* gp = layer == 0 ? P + (size_t)r * 3072 + (c0 < 512 ? 1024 + c0 : 2048 + c0) : P + (size_t)r * 4096 + 3072 + c0;
      rf[j][0] = *(const u32x4*)(OF + (size_t)r * 1024 + c0); rf[j][1] = *(const u32x4*)(OF + (size_t)r * 1024 + c0 + 8);
      rbk[j][0] = *(const u32x4*)(OB + (size_t)r * 1024 + c0); rbk[j][1] = *(const u32x4*)(OB + (size_t)r * 1024 + c0 + 8);
      rg[j][0] = *(const u32x4*)gp; rg[j][1] = *(const u32x4*)(gp + 8);
    }
#pragma unroll
    for (int j = 0; j < 6; ++j) {
      const int r = rb + j * nw;
      if (r < TALL) {
        float o[16], t[16], sg[16];
        unpack8(rf[j][0], o); unpack8(rf[j][1], o + 8); unpack8(rbk[j][0], t); unpack8(rbk[j][1], t + 8); unpack8(rg[j][0], sg); unpack8(rg[j][1], sg + 8);
        float ss = 0.f;
#pragma unroll
        for (int i = 0; i < 16; ++i) { o[i] += t[i]; ss += o[i] * o[i]; }
        ss += __shfl_xor(ss, 1); ss += __shfl_xor(ss, 2); ss += __shfl_xor(ss, 4);
        const float rstd = rsqrtf(ss * (1.0f / 128.0f) + 1e-6f);
#pragma unroll
        for (int i = 0; i < 16; ++i) o[i] = o[i] * rstd * gnv[i] * silu_f(sg[i]);
        *(u32x4*)(A + (size_t)r * 1024 + c0) = pack8(o);
        *(u32x4*)(A + (size_t)r * 1024 + c0 + 8) = pack8(o + 8);
      }
    }
  }
}

DI void phase_final_norm(const Params& p) {
  const int tid = opaque_i((int)threadIdx.x), nb = gridDim.x, bid = blockIdx.x, wid = tid >> 6, lane = tid & 63, gw = bid * 8 + wid, nw = nb * 8;
  f32x4 fw[4];
#pragma unroll
  for (int i = 0; i < 4; ++i) fw[i] = *(const f32x4*)(p.final_norm_w + lane * 4 + 256 * i);
  for (int rb = gw; rb < TALL; rb += 6 * nw) {
    f32x4 x[6][4];
#pragma unroll
    for (int j = 0; j < 6; ++j) {
      const int rr = min(rb + j * nw, TALL - 1);
      const float* row = rr < TCTX ? p.x_prompt + (size_t)rr * 1024 : p.x_sample + (size_t)(rr - TCTX) * 1024;
      const bf16_t* dp = (const bf16_t*)(p.ws + OFF_OF) + (size_t)rr * 1024 + lane * 4;
      const bf16_t* d0 = (const bf16_t*)(p.ws + OFF_D0) + (size_t)rr * 1024 + lane * 4;
#pragma unroll
      for (int i = 0; i < 4; ++i) {
        const u32x2 dv = *(const u32x2*)(dp + 256 * i), ev = *(const u32x2*)(d0 + 256 * i);
        x[j][i] = (__builtin_nontemporal_load((const f32x4*)(row + lane * 4 + 256 * i)) + (f32x4){bf_lo(ev.x), bf_hi(ev.x), bf_lo(ev.y), bf_hi(ev.y)}) + (f32x4){bf_lo(dv.x), bf_hi(dv.x), bf_lo(dv.y), bf_hi(dv.y)};
      }
    }
#pragma unroll
    for (int j = 0; j < 6; ++j) {
      const int r = rb + j * nw;
      if (r < TALL) {
        float* row = p.out + (size_t)r * 1024;
        float ss = 0.f;
#pragma unroll
        for (int i = 0; i < 4; ++i) ss += x[j][i][0] * x[j][i][0] + x[j][i][1] * x[j][i][1] + x[j][i][2] * x[j][i][2] + x[j][i][3] * x[j][i][3];
        ss = wave_sum(ss);
        const float rstd = rsqrtf(ss * (1.0f / 1024.0f) + 1e-6f);
#pragma unroll
        for (int i = 0; i < 4; ++i) __builtin_nontemporal_store(x[j][i] * rstd * fw[i], (f32x4*)(row + lane * 4 + 256 * i));
      }
    }
  }
}

#ifndef REP_P0
#define REP_P0 1
#endif
#ifndef REP_EW
#define REP_EW 1
#endif
#ifndef REP_IN
#define REP_IN 1
#endif
#ifndef REP_SCAN
#define REP_SCAN 1
#endif
#ifndef REP_OUT
#define REP_OUT 1
#endif
__global__ void __launch_bounds__(512, 2) fwd_megakernel(Params p) {
  extern __shared__ __attribute__((aligned(16))) unsigned char shm[];
  cg::grid_group grid = cg::this_grid();
  LAS unsigned char* lds = (LAS unsigned char*)shm;
  const bf16_t* A = (const bf16_t*)(p.ws + OFF_A);
  pg8::StaticOrder S;
  volatile LAS unsigned* xst = (volatile LAS unsigned*)(lds + 131072);
  if (threadIdx.x == 0) { xst[0] = 0u; xst[1] = 0u; }
  __syncthreads();
  const XcdBarrier xb = xcd_barrier_post((unsigned*)(p.ws + OFF_BAR), xst);
  if (p.ws == nullptr) grid.sync();

  for (int rep = 0; rep < REP_P0; ++rep) phase0(p, shm);
  phase0b_transposes(p, shm);
  xcd_barrier(xb);
  for (int rep = 0; rep < REP_EW; ++rep) phase_norm_mod(p, 0, false);
  xcd_barrier(xb);
  for (int rep = 0; rep < REP_IN; ++rep) {
  phase_tail(p, shm);
    pg8::Gemm g{A, (const bf16_t*)(p.ws + OFF_BTIN0), TALL, 4096, 1024};
    EpiIn0 E{(bf16_t*)(p.ws + OFF_P), (_Float16*)(p.ws + OFF_LG), p.hgrn_lb};
    S.init(TALL, 4096, (int)gridDim.x, (int)blockIdx.x);
    pg8::gemm_phase(lds, g, S, E);
  }
  xcd_barrier(xb);
  for (int rep = 0; rep < REP_SCAN; ++rep) phase_scan(p, 0, shm);
  xcd_barrier(xb);
  for (int rep = 0; rep < REP_EW; ++rep) phase_combine(p, 0);
  xcd_barrier(xb);
  for (int rep = 0; rep < REP_OUT; ++rep) {
    pg8::Gemm g{A, (const bf16_t*)(p.ws + OFF_BTOUT0), TALL, 1024, 1024};
    EpiOut E{(const float*)(p.ws + OFF_MOD), (bf16_t*)(p.ws + OFF_D0)};
    S.init(TALL, 1024, (int)gridDim.x, (int)blockIdx.x);
    pg8::gemm_phase(lds, g, S, E);
  }
  xcd_barrier(xb);
  phase_norm_mod(p, 1, true);
  xcd_barrier(xb);
  for (int rep = 0; rep < REP_IN; ++rep) {
    pg8::Gemm g{A, (const bf16_t*)(p.ws + OFF_BTIN1), TALL, 4096, 1024};
    EpiIn1 E{(bf16_t*)(p.ws + OFF_P), (const float*)(p.ws + OFF_ROPE)};
    S.init(TALL, 4096, (int)gridDim.x, (int)blockIdx.x);
    pg8::gemm_phase(lds, g, S, E);
  }
  xcd_barrier(xb);
  for (int rep = 0; rep < REP_SCAN; ++rep) phase_scan(p, 1, shm);
  xcd_barrier(xb);
  for (int rep = 0; rep < REP_EW; ++rep) phase_combine(p, 1);
  xcd_barrier(xb);
  {
    pg8::Gemm g{A, (const bf16_t*)(p.ws + OFF_BTOUT1), TALL, 1024, 1024};
    EpiOut E{(const float*)(p.ws + OFF_MOD) + 15360, (bf16_t*)(p.ws + OFF_OF)};
    S.init(TALL, 1024, (int)gridDim.x, (int)blockIdx.x);
    pg8::gemm_phase(lds, g, S, E);
  }
  xcd_barrier(xb);
  phase_final_norm(p);
}

extern "C" void kernel_launch(void* const* d_in, const int* in_sizes, int n_in, void* d_out, int out_size, void* d_ws, size_t ws_size,
                              hipStream_t stream) {
  constexpr size_t kDynLds = 131072 + 16;
  static int grid_blocks = 0;
  if (!grid_blocks) {
    int dev = 0, cus = 0, per_cu = 0;
    (void)hipGetDevice(&dev);
    (void)hipDeviceGetAttribute(&cus, hipDeviceAttributeMultiprocessorCount, dev);
    (void)hipFuncSetAttribute((const void*)fwd_megakernel, hipFuncAttributeMaxDynamicSharedMemorySize, (int)kDynLds);
    (void)hipOccupancyMaxActiveBlocksPerMultiprocessor(&per_cu, fwd_megakernel, 512, kDynLds);
    if (per_cu < 1) per_cu = 1;
    grid_blocks = cus * per_cu;
  }
  if (ws_size < WS_NEED) fprintf(stderr, "workspace too small: %zu < %zu\n", ws_size, (size_t)WS_NEED);
  Params p{};
  const float** pp = (const float**)&p;
  for (int i = 0; i < 21; ++i) pp[i] = (const float*)d_in[i];
  p.out = (float*)d_out;
  p.ws = (unsigned char*)d_ws;
  (void)hipMemsetAsync((unsigned char*)d_ws + OFF_BAR, 0, XCD_BAR_WORDS * 4, stream);
  void* args[] = {&p};
  hipError_t e = hipLaunchCooperativeKernel((void*)fwd_megakernel, dim3(grid_blocks), dim3(512), args, kDynLds, stream);
  if (e != hipSuccess) fprintf(stderr, "cooperative launch failed: %s (grid %d)\n", hipGetErrorString(e), grid_blocks);
}
```

```cpp
#include <hip/hip_runtime.h>
#include <hip/hip_cooperative_groups.h>
#include <cstdio>
namespace cg = cooperative_groups;

#define DI __device__ __forceinline__
#define LAS __attribute__((address_space(3)))
typedef unsigned short bf16_t;
typedef short bf16x8 __attribute__((ext_vector_type(8)));
typedef short s16x4 __attribute__((ext_vector_type(4)));
typedef float f32x4 __attribute__((ext_vector_type(4)));
typedef unsigned u32x4 __attribute__((ext_vector_type(4)));
typedef unsigned u32x2 __attribute__((ext_vector_type(2)));
typedef _Float16 f16x8 __attribute__((ext_vector_type(8)));

constexpr int TCTX = 8192, TALL = 12288;
constexpr size_t OFF_BTIN0 = 0, OFF_BTOUT0 = 8454144, OFF_BTIN1 = 10551296, OFF_BTOUT1 = 18939904, OFF_MODP = 21037056,
                 OFF_MOD = 22020096, OFF_ROPE = 22142976, OFF_A = 22159360, OFF_P = 47325184, OFF_GG = OFF_P + 75497472,
                 OFF_LG = 147988480, OFF_OF = 198320128, OFF_OB = 223485952, OFF_D0 = OFF_LG + 25165824, OFF_BAR = 248651776, WS_NEED = 248651776 + 16384;
constexpr size_t OUT_HGRN = 12582912, OUT_GLA = 16777216, OUT_RET = 18874368;

struct Params {
  const float *x_prompt, *x_sample, *state_hgrn, *state_gla, *state_ret, *c, *c_ctx, *norm_w, *ada_w, *ada_b, *w_in_even, *hgrn_lb,
      *gla_gk_w, *gla_gk_b, *gn_even, *w_out_even, *w_in_odd, *ret_decay, *gn_odd, *w_out_odd, *final_norm_w;
  float* out;
  unsigned char* ws;
};

typedef float f32x2 __attribute__((ext_vector_type(2)));
typedef __bf16 bf16v2 __attribute__((ext_vector_type(2)));
DI unsigned cvt_pk_bf16(float lo, float hi) { const f32x2 v = {lo, hi}; const bf16v2 b = __builtin_convertvector(v, bf16v2); return __builtin_bit_cast(unsigned, b); }
DI int opaque_i(int x) { asm volatile("" : "+v"(x)); return x; }
DI float bf_lo(unsigned u) { return __uint_as_float(u << 16); }
DI float bf_hi(unsigned u) { return __uint_as_float(u & 0xffff0000u); }
DI float silu_f(float x) { return x * __builtin_amdgcn_rcpf(1.0f + __expf(-x)); }
DI float logsigmoid_f(float x) { return fminf(x, 0.f) - __logf(1.0f + __expf(-fabsf(x))); }
DI void unpack8(const u32x4& u, float* f) {
  f[0] = bf_lo(u.x); f[1] = bf_hi(u.x); f[2] = bf_lo(u.y); f[3] = bf_hi(u.y); f[4] = bf_lo(u.z); f[5] = bf_hi(u.z); f[6] = bf_lo(u.w); f[7] = bf_hi(u.w);
}
DI u32x4 pack8(const float* f) { u32x4 w; w.x = cvt_pk_bf16(f[0], f[1]); w.y = cvt_pk_bf16(f[2], f[3]); w.z = cvt_pk_bf16(f[4], f[5]); w.w = cvt_pk_bf16(f[6], f[7]); return w; }
DI float wave_sum(float v) {
#pragma unroll
  for (int o = 32; o >= 1; o >>= 1) v += __shfl_xor(v, o);
  return v;
}

#define XB_TMO      128
#define XB_XCNT(j)  (256  + 64 * (j))
#define XB_XSUB(j)  (1280 + 64 * (j))
#define XB_XGEN(j)  (2304 + 64 * (j))
#define XB_TOP      3328
#define XB_TOPGEN   3392
#define XCD_BAR_WORDS 3456
#define XB_SPIN_CAP (1u << 18)
DI unsigned xb_ld(unsigned* p) { return __hip_atomic_load(p, __ATOMIC_RELAXED, __HIP_MEMORY_SCOPE_AGENT); }
DI unsigned xb_add(unsigned* p, unsigned v) { return __hip_atomic_fetch_add(p, v, __ATOMIC_RELAXED, __HIP_MEMORY_SCOPE_AGENT); }
DI unsigned xb_xcc_id() { return (unsigned)__builtin_amdgcn_s_getreg((3 << 11) | 20) & 0xFu; }
#define XB_SPIN(cond, bar) do { unsigned _sp = 0; while (cond) { __builtin_amdgcn_s_sleep(1); \
    if ((++_sp & 255u) == 0u) { if (xb_ld(&(bar)[XB_TMO])) break; if (_sp > XB_SPIN_CAP) { atomicAdd(&(bar)[XB_TMO], 1u); break; } } } } while (0)
struct XcdBarrier { unsigned* bar; unsigned x; volatile LAS unsigned* st; };
DI XcdBarrier xcd_barrier_post(unsigned* bar, volatile LAS unsigned* st) {
  XcdBarrier b; b.bar = bar; b.x = xb_xcc_id(); b.st = st;
  if (threadIdx.x == 0) (void)xb_add(&bar[XB_XCNT(b.x)], 1u);
  return b;
}
DI void xcd_barrier_complete(unsigned* bar, unsigned x, unsigned& nloc, unsigned& nx) {
  const unsigned G = gridDim.x * gridDim.y * gridDim.z;
  unsigned sum, cnt, mine, sp = 0u;
  for (;;) {
    sum = 0u; cnt = 0u; mine = 0u;
#pragma unroll
    for (unsigned j = 0; j < 16; ++j) { const unsigned c = xb_ld(&bar[XB_XCNT(j)]); sum += c; cnt += (c > 0u) ? 1u : 0u; mine = (j == x) ? c : mine; }
    if (sum == G) break;
    __builtin_amdgcn_s_sleep(1);
    if ((++sp & 255u) == 0u) { if (xb_ld(&bar[XB_TMO])) break; if (sp > XB_SPIN_CAP) { atomicAdd(&bar[XB_TMO], 1u); break; } }
  }
  nloc = mine > 0u ? mine : 1u; nx = cnt > 0u ? cnt : 1u;
}
DI void xcd_barrier(const XcdBarrier& b) {
  asm volatile("s_waitcnt vmcnt(0)" ::: "memory");
  __syncthreads();
  if (threadIdx.x == 0) {
    unsigned* bar = b.bar;
    __builtin_amdgcn_s_waitcnt(0);
    unsigned nloc = b.st[0], nx = b.st[1];
    if (nloc == 0u) { xcd_barrier_complete(bar, b.x, nloc, nx); b.st[0] = nloc; b.st[1] = nx; }
    const unsigned old = xb_add(&bar[XB_XSUB(b.x)], 1u);
    const unsigned gen = old / nloc;
    if (old + 1u == (gen + 1u) * nloc) {
      __builtin_amdgcn_fence(__ATOMIC_RELEASE, "agent");
      asm volatile("s_waitcnt vmcnt(0)" ::: "memory");
      const unsigned og = xb_add(&bar[XB_TOP], 1u);
      const unsigned tg = og / nx;
      if (og + 1u == (tg + 1u) * nx) xb_add(&bar[XB_TOPGEN], 1u);
      else XB_SPIN(xb_ld(&bar[XB_TOPGEN]) == tg, bar);
      __builtin_amdgcn_fence(__ATOMIC_ACQUIRE, "agent");
      xb_add(&bar[XB_XGEN(b.x)], 1u);
      asm volatile("s_waitcnt vmcnt(0)" ::: "memory");
    } else {
      XB_SPIN(xb_ld(&bar[XB_XGEN(b.x)]) == gen, bar);
      __builtin_amdgcn_fence(__ATOMIC_ACQUIRE, "agent");
      asm volatile("s_waitcnt vmcnt(0)" ::: "memory");
    }
  }
  __syncthreads();
}

namespace pg8 {
constexpr int BM = 256, BK = 64, HALF = 128, HTB = HALF * BK * 2, STAGE_BYTES = 8 * HTB, NXCD = 8, WGM = 8;
DI int lds_byte(int r, int c) { const int st = (r >> 4) * 2 + (c >> 5), rr = r & 15, cc = c & 31, ob = rr * 64 + cc * 2; return st * 1024 + (ob ^ (((ob >> 9) & 1) << 5)); }
DI void stage_rc(int b, int& R, int& C) { const int st = b / 1024, sb = b % 1024, swz = sb ^ (((sb >> 9) & 1) << 5); R = (st >> 1) * 16 + swz / 64; C = (st & 1) * 32 + (swz % 64) / 2; }
DI int perm32(int rho) { const int n = rho >> 4, i = rho & 15; return 8 * (i >> 2) + 4 * n + (i & 3); }
struct Unit { int pm, pn; };
struct Gemm { const bf16_t* A; const bf16_t* Bt; int M, N, K; };
struct StaticOrder {
  int nM, nN, nwg, G, c;
  DI void init(int M, int N, int G_, int c_) { nM = M / BM; nN = N / BM; nwg = nM * nN; G = G_; c = c_; }
  DI bool next(int i, Unit& u) const {
    const long L = (long)i * G + c; if (L >= nwg) return false;
    int wgid = (int)L; { const int q = nwg / NXCD, r = nwg % NXCD, xcd = wgid % NXCD, off = wgid / NXCD; wgid = (xcd < r ? xcd * (q + 1) : r * (q + 1) + (xcd - r) * q) + off; }
    const int nig = WGM * nN, gid = wgid / nig, fm = gid * WGM, gsz = (nM - fm) < WGM ? (nM - fm) : WGM;
    u.pm = fm + ((wgid % nig) % gsz); u.pn = (wgid % nig) / gsz; return true;
  }
};

template <class Epi>
DI void gemm_phase(LAS unsigned char* lds, const Gemm g, const StaticOrder& S, const Epi& E) {
  const int tid = opaque_i((int)threadIdx.x), wid = __builtin_amdgcn_readfirstlane(tid >> 6), lane = tid & 63, wr = wid >> 2, wc = wid & 3, fr = lane & 15, fq = lane >> 4;
  const int K = g.K, nt = K / BK;
  unsigned voffA[2], voffB[2];
#pragma unroll
  for (int i = 0; i < 2; ++i) { int R, C; stage_rc(tid * 16 + i * 8192, R, C); const int Rb = Epi::PERM ? ((R & ~31) + perm32(R & 31)) : R;
    voffA[i] = (unsigned)(R * K + C) * 2u; voffB[i] = (unsigned)(Rb * K + C) * 2u; }
  const size_t kstep = (size_t)(BK * 2);
  const size_t hstep = (size_t)HALF * K * 2;
  const size_t tstep = 2 * hstep;
  const unsigned ldsw = (unsigned)wid * 1024u;
  const int aoff = lds_byte(wr * 64 + fr, fq * 8), boff = lds_byte(wc * 32 + fr, fq * 8);
#define PG8_SA(b, h) (((b) * 2 + (h)) * HTB)
#define PG8_SB(b, h) ((4 + (b) * 2 + (h)) * HTB)
#define PG8_STAGE(bufoff, gbase, voff) do { _Pragma("unroll") for (int _i = 0; _i < 2; ++_i) \
        __builtin_amdgcn_global_load_lds((const unsigned*)((const char*)(gbase) + (voff)[_i]), (LAS unsigned*)(lds + (bufoff) + ldsw + _i * 8192), 16, 0, 0); } while (0)
#define PG8_LDA(dst, b, h) do { _Pragma("unroll") for (int m = 0; m < 4; ++m) _Pragma("unroll") for (int k = 0; k < 2; ++k) dst[m][k] = *(const LAS bf16x8*)(lds + PG8_SA(b, h) + aoff + m * 2048 + k * 1024); } while (0)
#define PG8_LDB(dst, b, h) do { _Pragma("unroll") for (int n = 0; n < 2; ++n) _Pragma("unroll") for (int k = 0; k < 2; ++k) dst[n][k] = *(const LAS bf16x8*)(lds + PG8_SB(b, h) + boff + n * 2048 + k * 1024); } while (0)
#define PG8_MMA(ai, bj, At, Bt) do { __builtin_amdgcn_s_setprio(1); _Pragma("unroll") for (int m = 0; m < 4; ++m) _Pragma("unroll") for (int n = 0; n < 2; ++n) _Pragma("unroll") for (int k = 0; k < 2; ++k) \
        acc[ai][bj][m][n] = __builtin_amdgcn_mfma_f32_16x16x32_bf16(Bt[n][k], At[m][k], acc[ai][bj][m][n], 0, 0, 0); __builtin_amdgcn_s_setprio(0); } while (0)
#define PG8_WAIT_V(n) asm volatile("s_waitcnt vmcnt(" #n ")" ::: "memory")
#define PG8_WAIT_L(n) asm volatile("s_waitcnt lgkmcnt(" #n ")" ::: "memory")
#define PG8_BAR __builtin_amdgcn_s_barrier()
#define PG8_SCHED __builtin_amdgcn_sched_barrier(0)
  Unit cur, nxt; int ui = 0;
  if (!S.next(0, cur)) return;
  f32x4 acc[2][2][4][2];
#pragma unroll
  for (int a = 0; a < 2; ++a)
#pragma unroll
    for (int b = 0; b < 2; ++b)
#pragma unroll
      for (int m = 0; m < 4; ++m)
#pragma unroll
        for (int n = 0; n < 2; ++n) acc[a][b][m][n] = (f32x4){0.f, 0.f, 0.f, 0.f};
  bf16x8 At[4][2], B0[2][2], B1[2][2];
  const char* cA = (const char*)g.A + (size_t)cur.pm * tstep; const char* cB = (const char*)g.Bt + (size_t)cur.pn * tstep;
  PG8_STAGE(PG8_SB(0, 0), cB, voffB); PG8_STAGE(PG8_SA(0, 0), cA, voffA); PG8_STAGE(PG8_SB(0, 1), cB + hstep, voffB); PG8_STAGE(PG8_SA(0, 1), cA + hstep, voffA);
  if (wr == 1) PG8_BAR;
  PG8_WAIT_V(4); PG8_BAR;
  PG8_STAGE(PG8_SB(1, 0), cB + kstep, voffB); PG8_STAGE(PG8_SA(1, 0), cA + kstep, voffA); PG8_STAGE(PG8_SB(1, 1), cB + hstep + kstep, voffB);
  PG8_WAIT_V(6); PG8_BAR;
  for (;;) {
    const bool has_next = S.next(ui + 1, nxt);
    const char* nA = has_next ? (const char*)g.A + (size_t)nxt.pm * tstep : cA; const char* nB = has_next ? (const char*)g.Bt + (size_t)nxt.pn * tstep : cB;
    for (int t = 0; t < nt; t += 2) {
      const bool last = (t == nt - 2);
      const char* a1 = cA + (size_t)(t + 1) * kstep;
      const char* a2 = last ? nA : cA + (size_t)(t + 2) * kstep; const char* b2 = last ? nB : cB + (size_t)(t + 2) * kstep;
      const char* a3 = a2 + kstep; const char* b3 = b2 + kstep;
      PG8_LDB(B0, 0, 0); PG8_SCHED; PG8_LDA(At, 0, 0); PG8_STAGE(PG8_SA(1, 1), a1 + hstep, voffA);
      PG8_WAIT_L(8); PG8_BAR; PG8_WAIT_L(0); PG8_MMA(0, 0, At, B0); PG8_BAR; PG8_SCHED;
      PG8_LDB(B1, 0, 1); PG8_STAGE(PG8_SB(0, 0), b2, voffB);
      PG8_BAR; PG8_WAIT_L(0); PG8_MMA(0, 1, At, B1); PG8_BAR;
      PG8_LDA(At, 0, 1); PG8_STAGE(PG8_SA(0, 0), a2, voffA);
      PG8_BAR; PG8_WAIT_L(0); PG8_MMA(1, 0, At, B0); PG8_BAR; PG8_SCHED;
      PG8_STAGE(PG8_SB(0, 1), b2 + hstep, voffB);
      PG8_WAIT_V(6); PG8_BAR; PG8_MMA(1, 1, At, B1); PG8_BAR;
      PG8_LDB(B0, 1, 0); PG8_SCHED; PG8_LDA(At, 1, 0); PG8_STAGE(PG8_SA(0, 1), a2 + hstep, voffA);
      PG8_WAIT_L(8); PG8_BAR; PG8_WAIT_L(0); PG8_MMA(0, 0, At, B0); PG8_BAR; PG8_SCHED;
      PG8_LDB(B1, 1, 1); PG8_STAGE(PG8_SB(1, 0), b3, voffB);
      PG8_BAR; PG8_WAIT_L(0); PG8_MMA(0, 1, At, B1); PG8_BAR;
      PG8_LDA(At, 1, 1); PG8_STAGE(PG8_SA(1, 0), a3, voffA);
      PG8_BAR; PG8_WAIT_L(0); PG8_MMA(1, 0, At, B0); PG8_BAR; PG8_SCHED;
      PG8_STAGE(PG8_SB(1, 1), b3 + hstep, voffB);
      PG8_WAIT_V(6); PG8_BAR; PG8_MMA(1, 1, At, B1); PG8_BAR;
    }
    E(acc, cur, wr, wc, fr, fq);
    if (!has_next) break;
#pragma unroll
    for (int a = 0; a < 2; ++a)
#pragma unroll
      for (int b = 0; b < 2; ++b)
#pragma unroll
        for (int m = 0; m < 4; ++m)
#pragma unroll
          for (int n = 0; n < 2; ++n) acc[a][b][m][n] = (f32x4){0.f, 0.f, 0.f, 0.f};
    cur = nxt; cA = nA; cB = nB; ++ui;
  }
  PG8_WAIT_V(0);
  if (wr == 0) PG8_BAR;
  PG8_BAR;
#undef PG8_SA
#undef PG8_SB
#undef PG8_STAGE
#undef PG8_LDA
#undef PG8_LDB
#undef PG8_MMA
#undef PG8_WAIT_V
#undef PG8_WAIT_L
#undef PG8_BAR
#undef PG8_SCHED
}
}

struct EpiIn0 {
  static constexpr bool PERM = true;
  bf16_t* P0; _Float16* LG; const float* hlb;
  DI void operator()(const f32x4 (&acc)[2][2][4][2], const pg8::Unit& u, int wr, int wc, int fr, int fq) const {
    const int row0 = u.pm * 256 + wr * 64 + fr, pn = u.pn;
    if (pn >= 4 && pn < 8) {
#pragma unroll
      for (int bj = 0; bj < 2; ++bj) {
        const int c0 = pn * 256 + bj * 128 + wc * 32 + 8 * fq, ch = (c0 - 1024) & 511;
        float lb[8];
#pragma unroll
        for (int e = 0; e < 8; ++e) lb[e] = __builtin_amdgcn_rcpf(1.0f + __expf(hlb[512 + ch + e] - hlb[ch + e]));
#pragma unroll
        for (int ai = 0; ai < 2; ++ai)
#pragma unroll
          for (int m = 0; m < 4; ++m) {
            _Float16* dst = LG + (size_t)(row0 + ai * 128 + m * 16) * 1024 + (c0 - 1024);
            f16x8 hv;
#pragma unroll
            for (int n = 0; n < 2; ++n) {
#pragma unroll
              for (int j = 0; j < 4; ++j) { const float a = acc[ai][bj][m][n][j]; const float sg = __builtin_amdgcn_rcpf(1.0f + __expf(-a)); const float l = lb[4 * n + j]; hv[4 * n + j] = (_Float16)__logf(l + (1.0f - l) * sg); }
            }
            *(f16x8*)dst = hv;
          }
      }
    } else {
      const bool act = (pn < 2);
      const float scl = (pn == 10) ? 0.125f : 1.0f;
#pragma unroll
      for (int bj = 0; bj < 2; ++bj) {
        const int c0 = pn * 256 + bj * 128 + wc * 32 + 8 * fq, pc = c0 < 1024 ? c0 : c0 - 1024;
#pragma unroll
        for (int ai = 0; ai < 2; ++ai)
#pragma unroll
          for (int m = 0; m < 4; ++m) {
            float v[8];
#pragma unroll
            for (int j = 0; j < 4; ++j) { v[j] = acc[ai][bj][m][0][j]; v[4 + j] = acc[ai][bj][m][1][j]; }
#pragma unroll
            for (int j = 0; j < 8; ++j) v[j] = act ? silu_f(v[j]) : v[j] * scl;
            *(u32x4*)(P0 + (size_t)(row0 + ai * 128 + m * 16) * 3072 + pc) = pack8(v);
          }
      }
    }
  }
};
struct EpiIn1 {
  static constexpr bool PERM = true;
  bf16_t* P1; const float* ropeT;
  DI void operator()(const f32x4 (&acc)[2][2][4][2], const pg8::Unit& u, int wr, int wc, int fr, int fq) const {
    const int row0 = u.pm * 256 + wr * 64 + fr, pn = u.pn;
    const bool act = false, rope = (pn < 8) && (u.pm >= 32);
    const float scl = (pn >= 4 && pn < 8) ? 0.08838834764831845f : 1.0f;
    const int i0 = 16 * (wc & 1) + 4 * fq, hf = wc >> 1;
#pragma unroll
    for (int bj = 0; bj < 2; ++bj) {
      const int c0 = pn * 256 + bj * 128 + wc * 32 + 8 * fq;
#pragma unroll
      for (int ai = 0; ai < 2; ++ai)
#pragma unroll
        for (int m = 0; m < 4; ++m) {
          const int row = row0 + ai * 128 + m * 16;
          float v[8];
#pragma unroll
          for (int j = 0; j < 4; ++j) { v[j] = acc[ai][bj][m][0][j]; v[4 + j] = acc[ai][bj][m][1][j]; }
          if (rope) {
            const int t = row & 1023, pos = hf ? (t & 63) : (t >> 6);
            const f32x4 cs = *(const f32x4*)(ropeT + pos * 32 + i0), sn = *(const f32x4*)(ropeT + 2048 + pos * 32 + i0);
#pragma unroll
            for (int q = 0; q < 4; ++q) { const float a = v[2 * q], b = v[2 * q + 1]; v[2 * q] = a * cs[q] - b * sn[q]; v[2 * q + 1] = b * cs[q] + a * sn[q]; }
          }
#pragma unroll
          for (int j = 0; j < 8; ++j) v[j] = act ? silu_f(v[j]) : v[j] * scl;
          *(u32x4*)(P1 + (size_t)row * 4096 + c0) = pack8(v);
        }
    }
  }
};
struct EpiOut {
  static constexpr bool PERM = true;
  const float* gate;
  bf16_t* delta;
  DI void operator()(const f32x4 (&acc)[2][2][4][2], const pg8::Unit& u, int wr, int wc, int fr, int fq) const {
    const int pm = u.pm, row0 = pm * 256 + wr * 64 + fr, col0 = u.pn * 256 + wc * 32 + 8 * fq;
    const int cond = pm < 32 ? 0 : 1 + ((pm - 32) >> 2);
    const float* gp = gate + cond * 3072 + 2048 + col0;
    f32x4 gv[2][2];
#pragma unroll
    for (int bj = 0; bj < 2; ++bj)
#pragma unroll
      for (int n = 0; n < 2; ++n) gv[bj][n] = *(const f32x4*)(gp + bj * 128 + n * 4);
#pragma unroll
    for (int ai = 0; ai < 2; ++ai)
#pragma unroll
      for (int m = 0; m < 4; ++m) {
        bf16_t* dst = delta + (size_t)(row0 + ai * 128 + m * 16) * 1024 + col0;
#pragma unroll
        for (int bj = 0; bj < 2; ++bj) {
          const f32x4 a = gv[bj][0] * acc[ai][bj][m][0], b = gv[bj][1] * acc[ai][bj][m][1];
          u32x4 w; w.x = cvt_pk_bf16(a[0], a[1]); w.y = cvt_pk_bf16(a[2], a[3]); w.z = cvt_pk_bf16(b[0], b[1]); w.w = cvt_pk_bf16(b[2], b[3]);
          *(u32x4*)(dst + bj * 128) = w;
        }
      }
  }
};

template <bool PERMQK>
DI void tr_tile2(const float* __restrict__ W, const int N, bf16_t* __restrict__ Bt, const int nTn, const int t0, const int ntiles, float* tile) {
  const int tid = opaque_i((int)threadIdx.x);
  const int r = tid >> 4, c4 = (tid & 15) * 4;
  f32x4 v[2][2];
#pragma unroll
  for (int h = 0; h < 2; ++h) {
    const int t = min(t0 + h, ntiles - 1), k0 = (t / nTn) * 64, n0 = (t % nTn) * 64;
#pragma unroll
    for (int rr = 0; rr < 2; ++rr) {
      v[h][rr] = (f32x4){0.f, 0.f, 0.f, 0.f};
      if (n0 + c4 < N) v[h][rr] = __builtin_nontemporal_load((const f32x4*)(W + (size_t)(k0 + r + 32 * rr) * N + n0 + c4));
    }
  }
#pragma unroll
  for (int h = 0; h < 2; ++h)
#pragma unroll
    for (int rr = 0; rr < 2; ++rr) { float* d = tile + h * 4160 + (r + 32 * rr) * 65 + c4; d[0] = v[h][rr][0]; d[1] = v[h][rr][1]; d[2] = v[h][rr][2]; d[3] = v[h][rr][3]; }
  __syncthreads();
  const int n = tid >> 3, k8 = (tid & 7) * 8;
#pragma unroll
  for (int h = 0; h < 2; ++h) {
    const int t = t0 + h;
    if (t < ntiles) {
      const int k0 = (t / nTn) * 64, n0 = (t % nTn) * 64;
      if (n0 + n < N) {
        float o[8];
#pragma unroll
        for (int j = 0; j < 8; ++j) o[j] = tile[h * 4160 + (k8 + j) * 65 + n];
        int nr = n0 + n;
        if (PERMQK && nr < 2048) { const int d = nr & 127; nr = (nr & ~127) + 64 * (d >> 6) + 2 * (d & 31) + ((d >> 5) & 1); }
        *(u32x4*)(Bt + (size_t)nr * 1024 + k0 + k8) = pack8(o);
      }
    }
  }
  __syncthreads();
}
DI void phase0b_transposes(const Params& p, unsigned char* shm) {
  const int nb = gridDim.x, bid = blockIdx.x;
  const bool sp = (nb == 256);
  const int slot = sp ? bid - 48 : bid, nsl = sp ? 208 : nb;
  if (slot < 0) return;
  float* tile = (float*)shm;
  for (int t = 2 * slot; t < 1040; t += 2 * nsl) tr_tile2<false>(p.w_in_even, 4128, (bf16_t*)(p.ws + OFF_BTIN0), 65, t, 1040, tile);
}
DI void prep_layer1(const Params& p, unsigned char* shm, const int slot, const int nsl) {
  float* tile = (float*)shm;
  for (int t = 2 * slot; t < 1024; t += 2 * nsl) tr_tile2<true>(p.w_in_odd, 4096, (bf16_t*)(p.ws + OFF_BTIN1), 64, t, 1024, tile);
  for (int t = 2 * (nsl - 1 - slot); t < 256; t += 2 * nsl) tr_tile2<false>(p.w_out_odd, 1024, (bf16_t*)(p.ws + OFF_BTOUT1), 16, t, 256, tile);
  for (int t = 2 * (nsl - 1 - slot); t < 256; t += 2 * nsl) tr_tile2<false>(p.w_out_even, 1024, (bf16_t*)(p.ws + OFF_BTOUT0), 16, t, 256, tile);
}
DI void mod_partials(const Params& p, const int l, const int gw, const int nw) {
  const int lane = opaque_i((int)threadIdx.x) & 63;
  float* modp = (float*)(p.ws + OFF_MODP);
  for (int it = gw; it < 384; it += nw) {
    const int ks = it & 7, cgp = it >> 3;
    float a0 = 0.f, a1 = 0.f, a2 = 0.f, a3 = 0.f, a4 = 0.f;
    const float* wp = p.ada_w + (size_t)l * 1024 * 3072 + (size_t)(ks * 128) * 3072 + cgp * 64 + lane;
#pragma unroll 1
    for (int hh = 0; hh < 2; ++hh) {
      const int k = ks * 128 + hh * 64 + lane;
      const float s0 = silu_f(p.c_ctx[k]), s1 = silu_f(p.c[k]), s2 = silu_f(p.c[1024 + k]), s3 = silu_f(p.c[2048 + k]), s4 = silu_f(p.c[3072 + k]);
#pragma unroll 16
      for (int kk = 0; kk < 64; ++kk) {
        const float w = __builtin_nontemporal_load(wp + (size_t)(hh * 64 + kk) * 3072);
        a0 += __shfl(s0, kk) * w; a1 += __shfl(s1, kk) * w; a2 += __shfl(s2, kk) * w; a3 += __shfl(s3, kk) * w; a4 += __shfl(s4, kk) * w;
      }
    }
    float* mo = modp + ((size_t)(ks * 2 + l) * 5) * 3072 + cgp * 64 + lane;
    mo[0] = a0; mo[3072] = a1; mo[6144] = a2; mo[9216] = a3; mo[12288] = a4;
  }
}
DI void phase0(const Params& p, unsigned char* shm) {
  const int tid = opaque_i((int)threadIdx.x), nb = gridDim.x, bid = blockIdx.x;
  mod_partials(p, 0, bid * 8 + (tid >> 6), nb * 8);
  float* rope = (float*)(p.ws + OFF_ROPE);
  for (int i = bid * 512 + tid; i < 2048; i += nb * 512) {
    const int pos = i >> 5, fi = i & 31;
    const float inv = exp2f(-(float)(2 * fi) * (13.287712379549449f / 64.0f));
    const float ang = (float)pos * inv;
    const double kq = rint((double)ang * 0.15915494309189535);
    const float rr = (float)((double)ang - kq * 6.283185307179586);
    rope[i] = __cosf(rr);
    rope[2048 + i] = __sinf(rr);
  }
}

DI void phase_norm_mod(const Params& p, int l, bool with_delta) {
  const int tid = opaque_i((int)threadIdx.x), nb = gridDim.x, bid = blockIdx.x, wid = tid >> 6, lane = tid & 63, gw = bid * 8 + wid, nw = nb * 8;
  const float* modp = (const float*)(p.ws + OFF_MODP);
  bf16_t* A = (bf16_t*)(p.ws + OFF_A);
  {
    float* mod = (float*)(p.ws + OFF_MOD);
    for (int i = l * 15360 + bid * 512 + tid; i < (l + 1) * 15360; i += nb * 512) {
      float s = p.ada_b[(i / 15360) * 3072 + (i % 3072)];
#pragma unroll
      for (int ks = 0; ks < 8; ++ks) s += modp[ks * 30720 + i];
      mod[i] = s;
    }
  }
  const int rpw = (TALL + nw - 1) / nw;
  int cur = -1;
  f32x4 sc[4], sh[4], nwv[4];
#pragma unroll
  for (int i = 0; i < 4; ++i) { nwv[i] = *(const f32x4*)(p.norm_w + l * 1024 + lane * 4 + 256 * i); sc[i] = (f32x4){0.f, 0.f, 0.f, 0.f}; sh[i] = sc[i]; }
  const int rend = min(TALL, (gw + 1) * rpw);
  for (int rb = gw * rpw; rb < rend; rb += 6) {
    f32x4 x[6][4];
#pragma unroll
    for (int j = 0; j < 6; ++j) {
      const int r = min(rb + j, rend - 1);
      const float* src = r < TCTX ? p.x_prompt + (size_t)r * 1024 : p.x_sample + (size_t)(r - TCTX) * 1024;
#pragma unroll
      for (int i = 0; i < 4; ++i) x[j][i] = __builtin_nontemporal_load((const f32x4*)(src + lane * 4 + 256 * i));
      if (with_delta) {
        const bf16_t* dp = (const bf16_t*)(p.ws + OFF_D0) + (size_t)r * 1024 + lane * 4;
#pragma unroll
        for (int i = 0; i < 4; ++i) { const u32x2 dv = *(const u32x2*)(dp + 256 * i); x[j][i] += (f32x4){bf_lo(dv.x), bf_hi(dv.x), bf_lo(dv.y), bf_hi(dv.y)}; }
      }
    }
#pragma unroll
    for (int j = 0; j < 6; ++j) {
      const int r = rb + j;
      if (r < rend) {
        const int cond = r < TCTX ? 0 : 1 + ((r - TCTX) >> 10);
        if (cond != cur) {
          cur = cond;
#pragma unroll
          for (int i = 0; i < 4; ++i) {
            const int col = lane * 4 + 256 * i;
            f32x4 a = *(const f32x4*)(p.ada_b + l * 3072 + col), b = *(const f32x4*)(p.ada_b + l * 3072 + 1024 + col);
#pragma unroll 2
            for (int ks = 0; ks < 8; ++ks) {
              const float* mp = modp + ((size_t)(ks * 2 + l) * 5 + cond) * 3072 + col;
              a += *(const f32x4*)mp; b += *(const f32x4*)(mp + 1024);
            }
            sh[i] = a; sc[i] = b;
          }
        }
        float ss = 0.f;
#pragma unroll
        for (int i = 0; i < 4; ++i) ss += x[j][i][0] * x[j][i][0] + x[j][i][1] * x[j][i][1] + x[j][i][2] * x[j][i][2] + x[j][i][3] * x[j][i][3];
        ss = wave_sum(ss);
        const float rstd = rsqrtf(ss * (1.0f / 1024.0f) + 1e-6f);
#pragma unroll
        for (int i = 0; i < 4; ++i) {
          f32x4 h = x[j][i] * rstd * nwv[i] * (sc[i] + 1.0f) + sh[i];
          u32x2 w; w.x = cvt_pk_bf16(h[0], h[1]); w.y = cvt_pk_bf16(h[2], h[3]);
          *(u32x2*)(A + (size_t)r * 1024 + lane * 4 + 256 * i) = w;
        }
      }
    }
  }
}

DI void phase_tail(const Params& p, unsigned char* shm) {
  const int tid = opaque_i((int)threadIdx.x), nb = gridDim.x, bid = blockIdx.x, wid = tid >> 6, lane = tid & 63;
  const int r16 = lane & 15, g = lane >> 4;
  float* part = (float*)shm;
  float* lowS = (float*)(shm + 50688);
  const bf16_t* A = (const bf16_t*)(p.ws + OFF_A);
  const bf16_t* Bt = (const bf16_t*)(p.ws + OFF_BTIN0) + (size_t)4096 * 1024;
  _Float16* GG = (_Float16*)(p.ws + OFF_GG);
  const int gd = tid >> 8, gc = tid & 255;
  float w[16];
#pragma unroll
  for (int r = 0; r < 16; ++r) w[r] = p.gla_gk_w[(gd * 16 + r) * 256 + gc];
  const float gb = p.gla_gk_b[gd * 256 + gc];
  for (int grp = bid; grp < TALL / 48; grp += nb) {
    const int row0 = grp * 48;
    {
      f32x4 acc[3][2];
#pragma unroll
      for (int j = 0; j < 3; ++j) { acc[j][0] = (f32x4){0.f, 0.f, 0.f, 0.f}; acc[j][1] = acc[j][0]; }
      const bf16_t* ap = A + (size_t)(row0 + r16) * 1024 + wid * 128 + 8 * g;
      const bf16_t* bp = Bt + (size_t)r16 * 1024 + wid * 128 + 8 * g;
#pragma unroll
      for (int ks = 0; ks < 4; ++ks) {
        const bf16x8 x0 = *(const bf16x8*)(bp + ks * 32), x1 = *(const bf16x8*)(bp + 16 * 1024 + ks * 32);
#pragma unroll
        for (int j = 0; j < 3; ++j) {
          const bf16x8 a = *(const bf16x8*)(ap + (size_t)j * 16 * 1024 + ks * 32);
          acc[j][0] = __builtin_amdgcn_mfma_f32_16x16x32_bf16(a, x0, acc[j][0], 0, 0, 0);
          acc[j][1] = __builtin_amdgcn_mfma_f32_16x16x32_bf16(a, x1, acc[j][1], 0, 0, 0);
        }
      }
#pragma unroll
      for (int j = 0; j < 3; ++j)
#pragma unroll
        for (int i = 0; i < 4; ++i) {
          float* d = part + ((wid * 3 + j) * 16 + 4 * g + i) * 33;
          d[r16] = acc[j][0][i]; d[16 + r16] = acc[j][1][i];
        }
    }
    __syncthreads();
    for (int e = tid; e < 1536; e += 512) {
      const int rr = e >> 5, c = e & 31, j = rr >> 4, r = rr & 15;
      float sum = 0.f;
#pragma unroll
      for (int w = 0; w < 8; ++w) sum += part[((w * 3 + j) * 16 + r) * 33 + c];
      lowS[rr * 36 + c] = sum;
    }
    __syncthreads();
    {
#pragma unroll 4
      for (int t = 0; t < 48; ++t) {
        const f32x4 l0 = *(const f32x4*)(lowS + t * 36 + 16 * gd), l1 = *(const f32x4*)(lowS + t * 36 + 16 * gd + 4),
                    l2 = *(const f32x4*)(lowS + t * 36 + 16 * gd + 8), l3 = *(const f32x4*)(lowS + t * 36 + 16 * gd + 12);
        float s0 = gb, s1 = 0.f, s2 = 0.f, s3 = 0.f;
#pragma unroll
        for (int r = 0; r < 4; ++r) { s0 += l0[r] * w[r]; s1 += l1[r] * w[4 + r]; s2 += l2[r] * w[8 + r]; s3 += l3[r] * w[12 + r]; }
        GG[(size_t)(row0 + t) * 512 + tid] = (_Float16)(logsigmoid_f((s0 + s1) + (s2 + s3)) * 0.0625f);
      }
    }
    __syncthreads();
  }
}

enum { T_HGRN = 0, T_GLA = 1, T_RET = 2 };
#define MFMA16(a, b, c) __builtin_amdgcn_mfma_f32_16x16x32_bf16((a), (b), (c), 0, 0, 0)
DI bf16x8 ld_frag(const bf16_t* base) {
  const s16x4 lo = *(const s16x4*)base, hi = *(const s16x4*)(base + 16);
  return __builtin_shufflevector(lo, hi, 0, 1, 2, 3, 4, 5, 6, 7);
}
DI bf16x8 ld_frag_tr(const bf16_t* base, int hi_off) {
  const s16x4 lo = __builtin_amdgcn_ds_read_tr16_b64_v4i16((LAS s16x4*)base), hi = __builtin_amdgcn_ds_read_tr16_b64_v4i16((LAS s16x4*)(base + hi_off));
  return __builtin_shufflevector(lo, hi, 0, 1, 2, 3, 4, 5, 6, 7);
}
DI bf16x8 pack_frag(const f32x4& a, const f32x4& b) {
  u32x4 w; w.x = cvt_pk_bf16(a[0], a[1]); w.y = cvt_pk_bf16(a[2], a[3]); w.z = cvt_pk_bf16(b[0], b[1]); w.w = cvt_pk_bf16(b[2], b[3]);
  return __builtin_bit_cast(bf16x8, w);
}

struct LoadSet { u32x4 q, k, v, qp, kp, lg; f32x4 c0, c1, s0, s1; };
template <int KD, int TYPE>
DI void scan_unit(unsigned char* shm, const bf16_t* Pq, const bf16_t* Pk, const bf16_t* Pv, int PS, const _Float16* lgp, int LS, float lgs,
                  const float* s0, float* sout, bf16_t* O, int rowbase, int Tlen, int dir, const float* sdummy, bool rope) {
  const float* ropeT = sdummy;
  constexpr int QS = KD + 8, NP = KD / 32, NKT = KD / 16;
  constexpr int BUFB = 35840, VS = 136;
  const int tid = opaque_i((int)threadIdx.x), wid = tid >> 6, lane = tid & 63, r16 = lane & 15, g = lane >> 4;
  const bool active = wid < KD / 16;
  const int ei = lane & 31, c8 = (16 * wid + 8 * (lane >> 5)) & (KD - 1);
  const int vi = tid >> 4, j8 = (tid & 15) * 8;
  const int jcol = 16 * wid + r16;

  f32x4 accS[NKT];
#pragma unroll
  for (int kt = 0; kt < NKT; ++kt)
#pragma unroll
    for (int i = 0; i < 4; ++i) { const float sv = (s0 ? s0 : sdummy)[(size_t)(16 * kt + 4 * g + i) * 128 + jcol]; accS[kt][i] = s0 ? sv : 0.f; }

  const int nsteps = Tlen >> 5;
  LoadSet LA, LB;
  LA.q = (u32x4){0u, 0u, 0u, 0u}; LA.k = LA.q; LA.v = LA.q; LA.qp = LA.q; LA.kp = LA.q; LA.lg = LA.q;
  LA.c0 = (f32x4){0.f, 0.f, 0.f, 0.f}; LA.c1 = LA.c0; LA.s0 = LA.c0; LA.s1 = LA.c0;
  LB = LA;
  const int eiL = ei;
  auto issue_loads = [&](int n, LoadSet& X) {
    const int tb = 32 * n;
    const int tokE = dir ? Tlen - 1 - (tb + eiL) : tb + eiL;
    const int tokV = dir ? Tlen - 1 - (tb + vi) : tb + vi;
    const size_t ro = (size_t)(rowbase + tokE) * PS;
    X.q = *(const u32x4*)(Pq + ro + c8);
    if (TYPE != T_RET) X.lg = *(const u32x4*)(lgp + (size_t)(rowbase + tokE) * LS + c8);
    if (TYPE != T_HGRN) X.k = *(const u32x4*)(Pk + ro + c8);
    if (TYPE == T_RET) {
      X.qp = *(const u32x4*)(Pq + ro + (c8 ^ 32)); X.kp = *(const u32x4*)(Pk + ro + (c8 ^ 32));
      const int pos = (c8 < 64) ? (tokE >> 6) : (tokE & 63);
      const float* rp = ropeT + pos * 32 + (c8 & 31);
      X.c0 = *(const f32x4*)rp; X.c1 = *(const f32x4*)(rp + 4); X.s0 = *(const f32x4*)(rp + 2048); X.s1 = *(const f32x4*)(rp + 2052);
    }
    X.v = *(const u32x4*)(Pv + (size_t)(rowbase + tokV) * PS + j8);
  };
  auto step = [&](int n, LoadSet& X) {
    const int tb = 32 * n;
    unsigned char* buf = shm + (n & 1) * BUFB;
    bf16_t* QR = (bf16_t*)buf;
    bf16_t* KI = (bf16_t*)(buf + 8704);
    bf16_t* KDm = (bf16_t*)(buf + 17408);
    bf16_t* Vm = (bf16_t*)(buf + 26112);
    float* EV = (float*)(buf + 34816);
    if (active) {
      float pre[8];
      const f16x8 hl = __builtin_bit_cast(f16x8, X.lg);
#pragma unroll
      for (int e = 0; e < 8; ++e) pre[e] = (float)hl[e];
#define DPP_ADD(ctrl, rmask, bc) _Pragma("unroll") for (int e = 0; e < 8; ++e) pre[e] += __builtin_bit_cast(float, __builtin_amdgcn_update_dpp(0, __builtin_bit_cast(int, pre[e]), ctrl, rmask, 0xf, bc))
      DPP_ADD(0x111, 0xf, true);
      DPP_ADD(0x112, 0xf, true);
      DPP_ADD(0x114, 0xf, true);
      DPP_ADD(0x118, 0xf, true);
      DPP_ADD(0x142, 0xa, false);
#undef DPP_ADD
      float q[8], kk[8];
      unpack8(X.q, q);
      if (TYPE == T_HGRN) {
#pragma unroll
        for (int e = 0; e < 8; ++e) kk[e] = 1.0f - __expf((float)hl[e]);
      } else unpack8(X.k, kk);
      float qr[8], ki[8], kd[8];
      const int lR = ((lane & 32) | 15) << 2, lL = (lane | 31) << 2;
#pragma unroll
      for (int e = 0; e < 8; ++e) {
        const float rr = __builtin_bit_cast(float, __builtin_amdgcn_ds_bpermute(lR, __builtin_bit_cast(int, pre[e])));
        const float x = __builtin_amdgcn_fmed3f(pre[e] - rr, -80.f, 80.f);
        const float er = __expf(x), ek = __builtin_amdgcn_rcpf(er);
        const float er31 = __builtin_bit_cast(float, __builtin_amdgcn_ds_bpermute(lL, __builtin_bit_cast(int, er)));
        qr[e] = q[e] * er; ki[e] = kk[e] * ek; kd[e] = ki[e] * er31;
      }
      if ((lane & 15) == 15) {
        float* evp = EV + ((lane & 16) ? 0 : 128) + c8;
#pragma unroll
        for (int e = 0; e < 8; ++e) evp[e] = __expf(pre[e]);
      }
      *(u32x4*)(QR + ei * QS + c8) = pack8(qr);
      *(u32x4*)(KI + ei * QS + c8) = pack8(ki);
      *(u32x4*)(KDm + ei * QS + c8) = pack8(kd);
    }
    *(u32x4*)(Vm + vi * VS + j8) = X.v;
    issue_loads(min(n + 2, nsteps - 1), X);
    __syncthreads();
    {
      const int tq = r16 >> 2, tp = r16 & 3;
      const bf16x8 vfrag = ld_frag_tr(Vm + (4 * g + tq) * VS + 16 * wid + 4 * tp, 16 * VS);
      bf16x8 qf[2][NP];
#pragma unroll
      for (int tt = 0; tt < 2; ++tt)
#pragma unroll
        for (int pp = 0; pp < NP; ++pp) qf[tt][pp] = ld_frag(QR + (16 * tt + r16) * QS + 32 * pp + 4 * g);
      f32x4 sc00 = (f32x4){0.f, 0.f, 0.f, 0.f}, sc01 = sc00, sc11 = sc00;
#pragma unroll
      for (int pp = 0; pp < NP; ++pp) {
        const bf16x8 kf0 = ld_frag(KI + r16 * QS + 32 * pp + 4 * g), kf1 = ld_frag(KI + (16 + r16) * QS + 32 * pp + 4 * g);
        sc00 = MFMA16(kf0, qf[0][pp], sc00); sc01 = MFMA16(kf0, qf[1][pp], sc01); sc11 = MFMA16(kf1, qf[1][pp], sc11);
      }
#pragma unroll
      for (int i = 0; i < 4; ++i) if (4 * g + i > r16) { sc00[i] = 0.f; sc11[i] = 0.f; }
      const f32x4 z4 = (f32x4){0.f, 0.f, 0.f, 0.f};
      const bf16x8 pf0 = pack_frag(sc00, z4), pf1 = pack_frag(sc01, sc11);
      f32x4 o0 = MFMA16(vfrag, pf0, z4), o1 = MFMA16(vfrag, pf1, z4);
#pragma unroll
      for (int pp = 0; pp < NP; ++pp) {
        f32x4 e0, e1;
        e0 = *(const f32x4*)(EV + 128 + 32 * pp + 4 * g); e1 = *(const f32x4*)(EV + 128 + 32 * pp + 16 + 4 * g);
        const bf16x8 sf = pack_frag(accS[2 * pp] * e0, accS[2 * pp + 1] * e1);
        o0 = MFMA16(sf, qf[0][pp], o0); o1 = MFMA16(sf, qf[1][pp], o1);
      }
#pragma unroll
      for (int kt = 0; kt < NKT; ++kt) {
        f32x4 eb;
        eb = *(const f32x4*)(EV + 16 * kt + 4 * g);
        const bf16x8 kdf = ld_frag_tr(KDm + (4 * g + tq) * QS + 16 * kt + 4 * tp, 16 * QS);
        accS[kt] = MFMA16(kdf, vfrag, accS[kt] * eb);
      }
      {
        const int t0 = tb + r16, t1 = tb + 16 + r16;
        const int tok0 = dir ? Tlen - 1 - t0 : t0, tok1 = dir ? Tlen - 1 - t1 : t1;
        u32x2 w0, w1; w0.x = cvt_pk_bf16(o0[0], o0[1]); w0.y = cvt_pk_bf16(o0[2], o0[3]); w1.x = cvt_pk_bf16(o1[0], o1[1]); w1.y = cvt_pk_bf16(o1[2], o1[3]);
        *(u32x2*)(O + (size_t)(rowbase + tok0) * 1024 + 16 * wid + 4 * g) = w0;
        *(u32x2*)(O + (size_t)(rowbase + tok1) * 1024 + 16 * wid + 4 * g) = w1;
      }
    }
  };
  issue_loads(0, LA);
  issue_loads(1, LB);
  for (int n = 0; n < nsteps; n += 2) { step(n, LA); step(n + 1, LB); }
  if (sout) {
#pragma unroll
    for (int kt = 0; kt < NKT; ++kt)
#pragma unroll
      for (int i = 0; i < 4; ++i) __builtin_nontemporal_store(accS[kt][i], sout + (size_t)(16 * kt + 4 * g + i) * 128 + jcol);
  }
  __syncthreads();
}


struct LoadSet3 { u32x4 q, k, v; };
DI int ret_lrow(int pk) { const int pp = pk >> 1; return 64 * (pp >> 5) + (pp & 31) + 32 * (pk & 1); }
DI void scan_unit_ret(unsigned char* shm, const bf16_t* Pq, const bf16_t* Pk, const bf16_t* Pv, float lgs, const float* s0, float* sout, bf16_t* O,
                      int rowbase, int Tlen, int dir, const float* sdummy) {
  constexpr int QS = 136, NP = 4, NKT = 8, PS = 4096, BUFB = 3 * 8704;
  const int tid = opaque_i((int)threadIdx.x), wid = tid >> 6, lane = tid & 63, r16 = lane & 15, g = lane >> 4;
  const int ei = tid >> 4, c8 = (tid & 15) * 8;
  const int jcol = 16 * wid + r16;
  f32x4 accS[NKT];
#pragma unroll
  for (int kt = 0; kt < NKT; ++kt)
#pragma unroll
    for (int i = 0; i < 4; ++i) { const float sv = (s0 ? s0 : sdummy)[(size_t)ret_lrow(16 * kt + 4 * g + i) * 128 + jcol]; accS[kt][i] = s0 ? sv : 0.f; }
  f32x4 dm, d01; float cs[8];
#pragma unroll
  for (int i = 0; i < 4; ++i) { const int dd = r16 - 4 * g - i; dm[i] = dd >= 0 ? __expf((float)dd * lgs) : 0.f; d01[i] = __expf((float)(16 + dd) * lgs); }
#pragma unroll
  for (int j = 0; j < 8; ++j) cs[j] = __expf((float)(31 - (16 * (j >> 2) + 4 * g + (j & 3))) * lgs);
  const float ct0 = __expf((float)(r16 + 1) * lgs), ct1 = __expf((float)(r16 + 17) * lgs), eb = __expf(32.0f * lgs);
  const int nsteps = Tlen >> 5;
  LoadSet3 LA, LB;
  auto issue_loads = [&](int n, LoadSet3& X) {
    const int tok = dir ? Tlen - 1 - (32 * n + ei) : 32 * n + ei;
    const size_t ro = (size_t)(rowbase + tok) * PS + c8;
    X.q = *(const u32x4*)(Pq + ro); X.k = *(const u32x4*)(Pk + ro); X.v = *(const u32x4*)(Pv + ro);
  };
  auto step = [&](int n, LoadSet3& X) {
    const int tb = 32 * n;
    unsigned char* buf = shm + (n & 1) * BUFB;
    bf16_t* Qm = (bf16_t*)buf; bf16_t* Km = (bf16_t*)(buf + 8704); bf16_t* Vm = (bf16_t*)(buf + 17408);
    *(u32x4*)(Qm + ei * QS + c8) = X.q;
    *(u32x4*)(Km + ei * QS + c8) = X.k;
    *(u32x4*)(Vm + ei * QS + c8) = X.v;
    issue_loads(min(n + 2, nsteps - 1), X);
    __syncthreads();
    const int tq = r16 >> 2, tp = r16 & 3;
    const bf16x8 vfrag = ld_frag_tr(Vm + (4 * g + tq) * QS + 16 * wid + 4 * tp, 16 * QS);
    bf16x8 qf[2][NP];
#pragma unroll
    for (int tt = 0; tt < 2; ++tt)
#pragma unroll
      for (int pp = 0; pp < NP; ++pp) qf[tt][pp] = ld_frag(Qm + (16 * tt + r16) * QS + 32 * pp + 4 * g);
    f32x4 sc00 = (f32x4){0.f, 0.f, 0.f, 0.f}, sc01 = sc00, sc11 = sc00;
#pragma unroll
    for (int pp = 0; pp < NP; ++pp) {
      const bf16x8 kf0 = ld_frag(Km + r16 * QS + 32 * pp + 4 * g), kf1 = ld_frag(Km + (16 + r16) * QS + 32 * pp + 4 * g);
      sc00 = MFMA16(kf0, qf[0][pp], sc00); sc01 = MFMA16(kf0, qf[1][pp], sc01); sc11 = MFMA16(kf1, qf[1][pp], sc11);
    }
    const f32x4 z4 = (f32x4){0.f, 0.f, 0.f, 0.f};
    const bf16x8 pf0 = pack_frag(sc00 * dm, z4), pf1 = pack_frag(sc01 * d01, sc11 * dm);
    f32x4 o0 = MFMA16(vfrag, pf0, z4), o1 = MFMA16(vfrag, pf1, z4);
    f32x4 oi0 = z4, oi1 = z4;
#pragma unroll
    for (int pp = 0; pp < NP; ++pp) {
      const bf16x8 sf = pack_frag(accS[2 * pp], accS[2 * pp + 1]);
      oi0 = MFMA16(sf, qf[0][pp], oi0); oi1 = MFMA16(sf, qf[1][pp], oi1);
    }
    o0 += oi0 * ct0; o1 += oi1 * ct1;
    bf16x8 vsf;
    {
      float vv[8];
      unpack8(__builtin_bit_cast(u32x4, vfrag), vv);
#pragma unroll
      for (int j = 0; j < 8; ++j) vv[j] *= cs[j];
      vsf = __builtin_bit_cast(bf16x8, pack8(vv));
    }
#pragma unroll
    for (int kt = 0; kt < NKT; ++kt) {
      const bf16x8 kdf = ld_frag_tr(Km + (4 * g + tq) * QS + 16 * kt + 4 * tp, 16 * QS);
      accS[kt] = MFMA16(kdf, vsf, accS[kt] * eb);
    }
    {
      const int t0 = tb + r16, t1 = tb + 16 + r16;
      const int tok0 = dir ? Tlen - 1 - t0 : t0, tok1 = dir ? Tlen - 1 - t1 : t1;
      u32x2 w0, w1; w0.x = cvt_pk_bf16(o0[0], o0[1]); w0.y = cvt_pk_bf16(o0[2], o0[3]); w1.x = cvt_pk_bf16(o1[0], o1[1]); w1.y = cvt_pk_bf16(o1[2], o1[3]);
      *(u32x2*)(O + (size_t)(rowbase + tok0) * 1024 + 16 * wid + 4 * g) = w0;
      *(u32x2*)(O + (size_t)(rowbase + tok1) * 1024 + 16 * wid + 4 * g) = w1;
    }
  };
  issue_loads(0, LA);
  issue_loads(1, LB);
  for (int n = 0; n < nsteps; n += 2) { step(n, LA); step(n + 1, LB); }
  if (sout) {
#pragma unroll
    for (int kt = 0; kt < NKT; ++kt)
#pragma unroll
      for (int i = 0; i < 4; ++i) __builtin_nontemporal_store(accS[kt][i], sout + (size_t)ret_lrow(16 * kt + 4 * g + i) * 128 + jcol);
  }
  __syncthreads();
}

DI int scan_unit_id(int k, int bid, int nb) {
  if (nb == 256) {
    if (bid < 64) return k == 0 ? bid : -1;
    const int j = bid - 64;
    if (k == 0) return 64 + j;
    if (k == 1) return 64 + 192 + j;
    if (k == 2 && j < 128) return 64 + 384 + j;
    return -1;
  }
  const int u = bid + k * nb;
  return u < 576 ? u : -1;
}

DI void phase_scan(const Params& p, int layer, unsigned char* shm) {
  const int bid = blockIdx.x, nb = gridDim.x;
  bf16_t* OF = (bf16_t*)(p.ws + OFF_OF); bf16_t* OB = (bf16_t*)(p.ws + OFF_OB);
  const bf16_t* P = (const bf16_t*)(p.ws + OFF_P);
  for (int k = 0;; ++k) {
    const int u = scan_unit_id(k, bid, nb);
    if (u < 0) break;
    const bool lat = u < 64;
    const int v = lat ? u : u - 64;
    if (layer == 0) {
      const int half = lat ? 32 : 256;
      const bool gla = v >= half;
      const int idx = gla ? v - half : v;
      const int b = idx >> 3, h = (idx >> 1) & 3, d = idx & 1;
      const int rowbase = lat ? TCTX + b * 1024 : b * 256, Tlen = lat ? 1024 : 256;
      bf16_t* O = (d ? OB : OF);
      if (!gla) {
        const float* s0 = lat ? p.state_hgrn + (size_t)((b * 2 + d) * 4 + h) * 16384 : nullptr;
        float* so = lat ? nullptr : p.out + OUT_HGRN + (size_t)((b * 2 + d) * 4 + h) * 16384;
        scan_unit<128, T_HGRN>(shm, P + h * 128, nullptr, P + 512 + h * 128, 3072, (const _Float16*)(p.ws + OFF_LG) + d * 512 + h * 128, 1024, 0.f, s0, so,
                               O + h * 128, rowbase, Tlen, d, p.state_hgrn, false);
      } else {
        const float* s0 = lat ? p.state_gla + (size_t)((b * 2 + d) * 4 + h) * 8192 : nullptr;
        float* so = lat ? nullptr : p.out + OUT_GLA + (size_t)((b * 2 + d) * 4 + h) * 8192;
        scan_unit<64, T_GLA>(shm, P + 1536 + h * 64, P + 1792 + h * 64, P + 2048 + h * 128, 3072, (const _Float16*)(p.ws + OFF_GG) + d * 256 + h * 64, 512, 0.f,
                             s0, so, O + 512 + h * 128, rowbase, Tlen, d, p.state_hgrn, false);
      }
    } else {
      const int b = v >> 4, h = (v >> 1) & 7, d = v & 1;
      const int rowbase = lat ? TCTX + b * 1024 : b * 256, Tlen = lat ? 1024 : 256;
      const float* s0 = lat ? p.state_ret + (size_t)((b * 2 + d) * 8 + h) * 16384 : nullptr;
      float* so = lat ? nullptr : p.out + OUT_RET + (size_t)((b * 2 + d) * 8 + h) * 16384;
      const float lgs = logsigmoid_f(p.ret_decay[d * 8 + h]);
      scan_unit_ret(shm, P + h * 128, P + 1024 + h * 128, P + 2048 + h * 128, lgs, s0, so, (d ? OB : OF) + h * 128, rowbase, Tlen, d, p.state_ret);
    }
  }
  if (layer == 0) {
    const bool sp = (nb == 256);
    const int slot = sp ? bid - 64 : bid, nsl = sp ? 192 : nb;
    if (slot >= 0) {
      prep_layer1(p, shm, slot, nsl);
      mod_partials(p, 1, slot * 8 + ((int)threadIdx.x >> 6), nsl * 8);
    }
  }
}

DI void phase_combine(const Params& p, int layer) {
  const int tid = opaque_i((int)threadIdx.x), nb = gridDim.x, bid = blockIdx.x, wid = tid >> 6, lane = tid & 63, gw = bid * 8 + wid, nw = nb * 8;
  const bf16_t* OF = (const bf16_t*)(p.ws + OFF_OF); const bf16_t* OB = (const bf16_t*)(p.ws + OFF_OB);
  const bf16_t* P = (const bf16_t*)(p.ws + OFF_P);
  bf16_t* A = (bf16_t*)(p.ws + OFF_A);
  const float* gn = layer == 0 ? p.gn_even : p.gn_odd;
  const int c0 = lane * 16;
  float gnv[16];
#pragma unroll
  for (int i = 0; i < 16; ++i) gnv[i] = gn[c0 + i];
  for (int rb = gw; rb < TALL; rb += 6 * nw) {
    u32x4 rf[6][2], rbk[6][2], rg[6][2];
#pragma unroll
    for (int j = 0; j < 6; ++j) {
      const int r = min(rb + j * nw, TALL - 1);
      const bf16_t* gp = layer == 0 ? P + (size_t)r * 3072 + (c0 < 512 ? 1024 + c0 : 2048 + c0) : P + (size_t)r * 4096 + 3072 + c0;
      rf[j][0] = *(const u32x4*)(OF + (size_t)r * 1024 + c0); rf[j][1] = *(const u32x4*)(OF + (size_t)r * 1024 + c0 + 8);
      rbk[j][0] = *(const u32x4*)(OB + (size_t)r * 1024 + c0); rbk[j][1] = *(const u32x4*)(OB + (size_t)r * 1024 + c0 + 8);
      rg[j][0] = *(const u32x4*)gp; rg[j][1] = *(const u32x4*)(gp + 8);
    }
#pragma unroll
    for (int j = 0; j < 6; ++j) {
      const int r = rb + j * nw;
      if (r < TALL) {
        float o[16], t[16], sg[16];
        unpack8(rf[j][0], o); unpack8(rf[j][1], o + 8); unpack8(rbk[j][0], t); unpack8(rbk[j][1], t + 8); unpack8(rg[j][0], sg); unpack8(rg[j][1], sg + 8);
        float ss = 0.f;
#pragma unroll
        for (int i = 0; i < 16; ++i) { o[i] += t[i]; ss += o[i] * o[i]; }
        ss += __shfl_xor(ss, 1); ss += __shfl_xor(ss, 2); ss += __shfl_xor(ss, 4);
        const float rstd = rsqrtf(ss * (1.0f / 128.0f) + 1e-6f);
#pragma unroll
        for (int i = 0; i < 16; ++i) o[i] = o[i] * rstd * gnv[i] * silu_f(sg[i]);
        *(u32x4*)(A + (size_t)r * 1024 + c0) = pack8(o);
        *(u32x4*)(A + (size_t)r * 1024 + c0 + 8) = pack8(o + 8);
      }
    }
  }
}

DI void phase_final_norm(const Params& p) {
  const int tid = opaque_i((int)threadIdx.x), nb = gridDim.x, bid = blockIdx.x, wid = tid >> 6, lane = tid & 63, gw = bid * 8 + wid, nw = nb * 8;
  f32x4 fw[4];
#pragma unroll
  for (int i = 0; i < 4; ++i) fw[i] = *(const f32x4*)(p.final_norm_w + lane * 4 + 256 * i);
  for (int rb = gw; rb < TALL; rb += 6 * nw) {
    f32x4 x[6][4];
#pragma unroll
    for (int j = 0; j < 6; ++j) {
      const int rr = min(rb + j * nw, TALL - 1);
      const float* row = rr < TCTX ? p.x_prompt + (size_t)rr * 1024 : p.x_sample + (size_t)(rr - TCTX) * 1024;
      const bf16_t* dp = (const bf16_t*)(p.ws + OFF_OF) + (size_t)rr * 1024 + lane * 4;
      const bf16_t* d0 = (const bf16_t*)(p.ws + OFF_D0) + (size_t)rr * 1024 + lane * 4;
#pragma unroll
      for (int i = 0; i < 4; ++i) {
        const u32x2 dv = *(const u32x2*)(dp + 256 * i), ev = *(const u32x2*)(d0 + 256 * i);
        x[j][i] = (__builtin_nontemporal_load((const f32x4*)(row + lane * 4 + 256 * i)) + (f32x4){bf_lo(ev.x), bf_hi(ev.x), bf_lo(ev.y), bf_hi(ev.y)}) + (f32x4){bf_lo(dv.x), bf_hi(dv.x), bf_lo(dv.y), bf_hi(dv.y)};
      }
    }
#pragma unroll
    for (int j = 0; j < 6; ++j) {
      const int r = rb + j * nw;
      if (r < TALL) {
        float* row = p.out + (size_t)r * 1024;
        float ss = 0.f;
#pragma unroll
        for (int i = 0; i < 4; ++i) ss += x[j][i][0] * x[j][i][0] + x[j][i][1] * x[j][i][1] + x[j][i][2] * x[j][i][2] + x[j][i][3] * x[j][i][3];
        ss = wave_sum(ss);
        const float rstd = rsqrtf(ss * (1.0f / 1024.0f) + 1e-6f);
#pragma unroll
        for (int i = 0; i < 4; ++i) __builtin_nontemporal_store(x[j][i] * rstd * fw[i], (f32x4*)(row + lane * 4 + 256 * i));
      }
    }
  }
}

#ifndef REP_P0
#define REP_P0 1
#endif
#ifndef REP_EW
#define REP_EW 1
#endif
#ifndef REP_IN
#define REP_IN 1
#endif
#ifndef REP_SCAN
#define REP_SCAN 1
#endif
#ifndef REP_OUT
#define REP_OUT 1
#endif
__global__ void __launch_bounds__(512, 2) fwd_megakernel(Params p) {
  extern __shared__ __attribute__((aligned(16))) unsigned char shm[];
  cg::grid_group grid = cg::this_grid();
  LAS unsigned char* lds = (LAS unsigned char*)shm;
  const bf16_t* A = (const bf16_t*)(p.ws + OFF_A);
  pg8::StaticOrder S;
  volatile LAS unsigned* xst = (volatile LAS unsigned*)(lds + 131072);
  if (threadIdx.x == 0) { xst[0] = 0u; xst[1] = 0u; }
  __syncthreads();
  const XcdBarrier xb = xcd_barrier_post((unsigned*)(p.ws + OFF_BAR), xst);
  if (p.ws == nullptr) grid.sync();

  for (int rep = 0; rep < REP_P0; ++rep) phase0(p, shm);
  phase0b_transposes(p, shm);
  xcd_barrier(xb);
  for (int rep = 0; rep < REP_EW; ++rep) phase_norm_mod(p, 0, false);
  xcd_barrier(xb);
  for (int rep = 0; rep < REP_IN; ++rep) {
  phase_tail(p, shm);
    pg8::Gemm g{A, (const bf16_t*)(p.ws + OFF_BTIN0), TALL, 4096, 1024};
    EpiIn0 E{(bf16_t*)(p.ws + OFF_P), (_Float16*)(p.ws + OFF_LG), p.hgrn_lb};
    S.init(TALL, 4096, (int)gridDim.x, (int)blockIdx.x);
    pg8::gemm_phase(lds, g, S, E);
  }
  xcd_barrier(xb);
  for (int rep = 0; rep < REP_SCAN; ++rep) phase_scan(p, 0, shm);
  xcd_barrier(xb);
  for (int rep = 0; rep < REP_EW; ++rep) phase_combine(p, 0);
  xcd_barrier(xb);
  for (int rep = 0; rep < REP_OUT; ++rep) {
    pg8::Gemm g{A, (const bf16_t*)(p.ws + OFF_BTOUT0), TALL, 1024, 1024};
    EpiOut E{(const float*)(p.ws + OFF_MOD), (bf16_t*)(p.ws + OFF_D0)};
    S.init(TALL, 1024, (int)gridDim.x, (int)blockIdx.x);
    pg8::gemm_phase(lds, g, S, E);
  }
  xcd_barrier(xb);
  phase_norm_mod(p, 1, true);
  xcd_barrier(xb);
  for (int rep = 0; rep < REP_IN; ++rep) {
    pg8::Gemm g{A, (const bf16_t*)(p.ws + OFF_BTIN1), TALL, 4096, 1024};
    EpiIn1 E{(bf16_t*)(p.ws + OFF_P), (const float*)(p.ws + OFF_ROPE)};
    S.init(TALL, 4096, (int)gridDim.x, (int)blockIdx.x);
    pg8::gemm_phase(lds, g, S, E);
  }
  xcd_barrier(xb);
  for (int rep = 0; rep < REP_SCAN; ++rep) phase_scan(p, 1, shm);
  xcd_barrier(xb);
  for (int rep = 0; rep < REP_EW; ++rep) phase_combine(p, 1);
  xcd_barrier(xb);
  {
    pg8::Gemm g{A, (const bf16_t*)(p.ws + OFF_BTOUT1), TALL, 1024, 1024};
    EpiOut E{(const float*)(p.ws + OFF_MOD) + 15360, (bf16_t*)(p.ws + OFF_OF)};
    S.init(TALL, 1024, (int)gridDim.x, (int)blockIdx.x);
    pg8::gemm_phase(lds, g, S, E);
  }
  xcd_barrier(xb);
  phase_final_norm(p);
}

extern "C" void kernel_launch(void* const* d_in, const int* in_sizes, int n_in, void* d_out, int out_size, void* d_ws, size_t ws_size,
                              hipStream_t stream) {
  constexpr size_t kDynLds = 131072 + 16;
  static int grid_blocks = 0;
  if (!grid_blocks) {
    int dev = 0, cus = 0, per_cu = 0;
    (void)hipGetDevice(&dev);
    (void)hipDeviceGetAttribute(&cus, hipDeviceAttributeMultiprocessorCount, dev);
    (void)hipFuncSetAttribute((const void*)fwd_megakernel, hipFuncAttributeMaxDynamicSharedMemorySize, (int)kDynLds);
    (void)hipOccupancyMaxActiveBlocksPerMultiprocessor(&per_cu, fwd_megakernel, 512, kDynLds);
    if (per_cu < 1) per_cu = 1;
    grid_blocks = cus * per_cu;
  }
  if (ws_size < WS_NEED) fprintf(stderr, "workspace too small: %zu < %zu\n", ws_size, (size_t)WS_NEED);
  Params p{};
  const float** pp = (const float**)&p;
  for (int i = 0; i < 21; ++i) pp[i] = (const float*)d_in[i];
  p.out = (float*)d_out;
  p.ws = (unsigned char*)d_ws;
  (void)hipMemsetAsync((unsigned char*)d_ws + OFF_BAR, 0, XCD_BAR_WORDS * 4, stream);
  void* args[] = {&p};
  hipError_t e = hipLaunchCooperativeKernel((void*)fwd_megakernel, dim3(grid_blocks), dim3(512), args, kDynLds, stream);
  if (e != hipSuccess) fprintf(stderr, "cooperative launch failed: %s (grid %d)\n", hipGetErrorString(e), grid_blocks);
}
```

```cpp
#include <hip/hip_runtime.h>
#include <hip/hip_cooperative_groups.h>
#include <cstdio>
namespace cg = cooperative_groups;

#define DI __device__ __forceinline__
#define LAS __attribute__((address_space(3)))
typedef unsigned short bf16_t;
typedef short bf16x8 __attribute__((ext_vector_type(8)));
typedef short s16x4 __attribute__((ext_vector_type(4)));
typedef float f32x4 __attribute__((ext_vector_type(4)));
typedef unsigned u32x4 __attribute__((ext_vector_type(4)));
typedef unsigned u32x2 __attribute__((ext_vector_type(2)));
typedef _Float16 f16x8 __attribute__((ext_vector_type(8)));

constexpr int TCTX = 8192, TALL = 12288;
constexpr size_t OFF_BTIN0 = 0, OFF_BTOUT0 = 8454144, OFF_BTIN1 = 10551296, OFF_BTOUT1 = 18939904, OFF_MODP = 21037056,
                 OFF_MOD = 22020096, OFF_ROPE = 22142976, OFF_A = 22159360, OFF_P = 47325184, OFF_GG = OFF_P + 75497472,
                 OFF_LG = 147988480, OFF_OF = 198320128, OFF_OB = 223485952, OFF_D0 = OFF_LG + 25165824, OFF_BAR = 248651776, WS_NEED = 248651776 + 16384;
constexpr size_t OUT_HGRN = 12582912, OUT_GLA = 16777216, OUT_RET = 18874368;

struct Params {
  const float *x_prompt, *x_sample, *state_hgrn, *state_gla, *state_ret, *c, *c_ctx, *norm_w, *ada_w, *ada_b, *w_in_even, *hgrn_lb,
      *gla_gk_w, *gla_gk_b, *gn_even, *w_out_even, *w_in_odd, *ret_decay, *gn_odd, *w_out_odd, *final_norm_w;
  float* out;
  unsigned char* ws;
};

typedef float f32x2 __attribute__((ext_vector_type(2)));
typedef __bf16 bf16v2 __attribute__((ext_vector_type(2)));
DI unsigned cvt_pk_bf16(float lo, float hi) { const f32x2 v = {lo, hi}; const bf16v2 b = __builtin_convertvector(v, bf16v2); return __builtin_bit_cast(unsigned, b); }
DI int opaque_i(int x) { asm volatile("" : "+v"(x)); return x; }
DI float bf_lo(unsigned u) { return __uint_as_float(u << 16); }
DI float bf_hi(unsigned u) { return __uint_as_float(u & 0xffff0000u); }
DI float silu_f(float x) { return x * __builtin_amdgcn_rcpf(1.0f + __expf(-x)); }
DI float logsigmoid_f(float x) { return fminf(x, 0.f) - __logf(1.0f + __expf(-fabsf(x))); }
DI void unpack8(const u32x4& u, float* f) {
  f[0] = bf_lo(u.x); f[1] = bf_hi(u.x); f[2] = bf_lo(u.y); f[3] = bf_hi(u.y); f[4] = bf_lo(u.z); f[5] = bf_hi(u.z); f[6] = bf_lo(u.w); f[7] = bf_hi(u.w);
}
DI u32x4 pack8(const float* f) { u32x4 w; w.x = cvt_pk_bf16(f[0], f[1]); w.y = cvt_pk_bf16(f[2], f[3]); w.z = cvt_pk_bf16(f[4], f[5]); w.w = cvt_pk_bf16(f[6], f[7]); return w; }
DI float wave_sum(float v) {
#pragma unroll
  for (int o = 32; o >= 1; o >>= 1) v += __shfl_xor(v, o);
  return v;
}

#define XB_TMO      128
#define XB_XCNT(j)  (256  + 64 * (j))
#define XB_XSUB(j)  (1280 + 64 * (j))
#define XB_XGEN(j)  (2304 + 64 * (j))
#define XB_TOP      3328
#define XB_TOPGEN   3392
#define XCD_BAR_WORDS 3456
#define XB_SPIN_CAP (1u << 18)
DI unsigned xb_ld(unsigned* p) { return __hip_atomic_load(p, __ATOMIC_RELAXED, __HIP_MEMORY_SCOPE_AGENT); }
DI unsigned xb_add(unsigned* p, unsigned v) { return __hip_atomic_fetch_add(p, v, __ATOMIC_RELAXED, __HIP_MEMORY_SCOPE_AGENT); }
DI unsigned xb_xcc_id() { return (unsigned)__builtin_amdgcn_s_getreg((3 << 11) | 20) & 0xFu; }
#define XB_SPIN(cond, bar) do { unsigned _sp = 0; while (cond) { __builtin_amdgcn_s_sleep(1); \
    if ((++_sp & 255u) == 0u) { if (xb_ld(&(bar)[XB_TMO])) break; if (_sp > XB_SPIN_CAP) { atomicAdd(&(bar)[XB_TMO], 1u); break; } } } } while (0)
struct XcdBarrier { unsigned* bar; unsigned x; volatile LAS unsigned* st; };
DI XcdBarrier xcd_barrier_post(unsigned* bar, volatile LAS unsigned* st) {
  XcdBarrier b; b.bar = bar; b.x = xb_xcc_id(); b.st = st;
  if (threadIdx.x == 0) (void)xb_add(&bar[XB_XCNT(b.x)], 1u);
  return b;
}
DI void xcd_barrier_complete(unsigned* bar, unsigned x, unsigned& nloc, unsigned& nx) {
  const unsigned G = gridDim.x * gridDim.y * gridDim.z;
  unsigned sum, cnt, mine, sp = 0u;
  for (;;) {
    sum = 0u; cnt = 0u; mine = 0u;
#pragma unroll
    for (unsigned j = 0; j < 16; ++j) { const unsigned c = xb_ld(&bar[XB_XCNT(j)]); sum += c; cnt += (c > 0u) ? 1u : 0u; mine = (j == x) ? c : mine; }
    if (sum == G) break;
    __builtin_amdgcn_s_sleep(1);
    if ((++sp & 255u) == 0u) { if (xb_ld(&bar[XB_TMO])) break; if (sp > XB_SPIN_CAP) { atomicAdd(&bar[XB_TMO], 1u); break; } }
  }
  nloc = mine > 0u ? mine : 1u; nx = cnt > 0u ? cnt : 1u;
}
DI void xcd_barrier(const XcdBarrier& b) {
  asm volatile("s_waitcnt vmcnt(0)" ::: "memory");
  __syncthreads();
  if (threadIdx.x == 0) {
    unsigned* bar = b.bar;
    __builtin_amdgcn_s_waitcnt(0);
    unsigned nloc = b.st[0], nx = b.st[1];
    if (nloc == 0u) { xcd_barrier_complete(bar, b.x, nloc, nx); b.st[0] = nloc; b.st[1] = nx; }
    const unsigned old = xb_add(&bar[XB_XSUB(b.x)], 1u);
    const unsigned gen = old / nloc;
    if (old + 1u == (gen + 1u) * nloc) {
      __builtin_amdgcn_fence(__ATOMIC_RELEASE, "agent");
      asm volatile("s_waitcnt vmcnt(0)" ::: "memory");
      const unsigned og = xb_add(&bar[XB_TOP], 1u);
      const unsigned tg = og / nx;
      if (og + 1u == (tg + 1u) * nx) xb_add(&bar[XB_TOPGEN], 1u);
      else XB_SPIN(xb_ld(&bar[XB_TOPGEN]) == tg, bar);
      __builtin_amdgcn_fence(__ATOMIC_ACQUIRE, "agent");
      xb_add(&bar[XB_XGEN(b.x)], 1u);
      asm volatile("s_waitcnt vmcnt(0)" ::: "memory");
    } else {
      XB_SPIN(xb_ld(&bar[XB_XGEN(b.x)]) == gen, bar);
      __builtin_amdgcn_fence(__ATOMIC_ACQUIRE, "agent");
      asm volatile("s_waitcnt vmcnt(0)" ::: "memory");
    }
  }
  __syncthreads();
}

namespace pg8 {
constexpr int BM = 256, BK = 64, HALF = 128, HTB = HALF * BK * 2, STAGE_BYTES = 8 * HTB, NXCD = 8, WGM = 8;
DI int lds_byte(int r, int c) { const int st = (r >> 4) * 2 + (c >> 5), rr = r & 15, cc = c & 31, ob = rr * 64 + cc * 2; return st * 1024 + (ob ^ (((ob >> 9) & 1) << 5)); }
DI void stage_rc(int b, int& R, int& C) { const int st = b / 1024, sb = b % 1024, swz = sb ^ (((sb >> 9) & 1) << 5); R = (st >> 1) * 16 + swz / 64; C = (st & 1) * 32 + (swz % 64) / 2; }
DI int perm32(int rho) { const int n = rho >> 4, i = rho & 15; return 8 * (i >> 2) + 4 * n + (i & 3); }
struct Unit { int pm, pn; };
struct Gemm { const bf16_t* A; const bf16_t* Bt; int M, N, K; };
struct StaticOrder {
  int nM, nN, nwg, G, c;
  DI void init(int M, int N, int G_, int c_) { nM = M / BM; nN = N / BM; nwg = nM * nN; G = G_; c = c_; }
  DI bool next(int i, Unit& u) const {
    const long L = (long)i * G + c; if (L >= nwg) return false;
    int wgid = (int)L; { const int q = nwg / NXCD, r = nwg % NXCD, xcd = wgid % NXCD, off = wgid / NXCD; wgid = (xcd < r ? xcd * (q + 1) : r * (q + 1) + (xcd - r) * q) + off; }
    const int nig = WGM * nN, gid = wgid / nig, fm = gid * WGM, gsz = (nM - fm) < WGM ? (nM - fm) : WGM;
    u.pm = fm + ((wgid % nig) % gsz); u.pn = (wgid % nig) / gsz; return true;
  }
};

template <class Epi>
DI void gemm_phase(LAS unsigned char* lds, const Gemm g, const StaticOrder& S, const Epi& E) {
  const int tid = opaque_i((int)threadIdx.x), wid = __builtin_amdgcn_readfirstlane(tid >> 6), lane = tid & 63, wr = wid >> 2, wc = wid & 3, fr = lane & 15, fq = lane >> 4;
  const int K = g.K, nt = K / BK;
  unsigned voffA[2], voffB[2];
#pragma unroll
  for (int i = 0; i < 2; ++i) { int R, C; stage_rc(tid * 16 + i * 8192, R, C); const int Rb = Epi::PERM ? ((R & ~31) + perm32(R & 31)) : R;
    voffA[i] = (unsigned)(R * K + C) * 2u; voffB[i] = (unsigned)(Rb * K + C) * 2u; }
  const size_t kstep = (size_t)(BK * 2);
  const size_t hstep = (size_t)HALF * K * 2;
  const size_t tstep = 2 * hstep;
  const unsigned ldsw = (unsigned)wid * 1024u;
  const int aoff = lds_byte(wr * 64 + fr, fq * 8), boff = lds_byte(wc * 32 + fr, fq * 8);
#define PG8_SA(b, h) (((b) * 2 + (h)) * HTB)
#define PG8_SB(b, h) ((4 + (b) * 2 + (h)) * HTB)
#define PG8_STAGE(bufoff, gbase, voff) do { _Pragma("unroll") for (int _i = 0; _i < 2; ++_i) \
        __builtin_amdgcn_global_load_lds((const unsigned*)((const char*)(gbase) + (voff)[_i]), (LAS unsigned*)(lds + (bufoff) + ldsw + _i * 8192), 16, 0, 0); } while (0)
#define PG8_LDA(dst, b, h) do { _Pragma("unroll") for (int m = 0; m < 4; ++m) _Pragma("unroll") for (int k = 0; k < 2; ++k) dst[m][k] = *(const LAS bf16x8*)(lds + PG8_SA(b, h) + aoff + m * 2048 + k * 1024); } while (0)
#define PG8_LDB(dst, b, h) do { _Pragma("unroll") for (int n = 0; n < 2; ++n) _Pragma("unroll") for (int k = 0; k < 2; ++k) dst[n][k] = *(const LAS bf16x8*)(lds + PG8_SB(b, h) + boff + n * 2048 + k * 1024); } while (0)
#define PG8_MMA(ai, bj, At, Bt) do { __builtin_amdgcn_s_setprio(1); _Pragma("unroll") for (int m = 0; m < 4; ++m) _Pragma("unroll") for (int n = 0; n < 2; ++n) _Pragma("unroll") for (int k = 0; k < 2; ++k) \
        acc[ai][bj][m][n] = __builtin_amdgcn_mfma_f32_16x16x32_bf16(Bt[n][k], At[m][k], acc[ai][bj][m][n], 0, 0, 0); __builtin_amdgcn_s_setprio(0); } while (0)
#define PG8_WAIT_V(n) asm volatile("s_waitcnt vmcnt(" #n ")" ::: "memory")
#define PG8_WAIT_L(n) asm volatile("s_waitcnt lgkmcnt(" #n ")" ::: "memory")
#define PG8_BAR __builtin_amdgcn_s_barrier()
#define PG8_SCHED __builtin_amdgcn_sched_barrier(0)
  Unit cur, nxt; int ui = 0;
  if (!S.next(0, cur)) return;
  f32x4 acc[2][2][4][2];
#pragma unroll
  for (int a = 0; a < 2; ++a)
#pragma unroll
    for (int b = 0; b < 2; ++b)
#pragma unroll
      for (int m = 0; m < 4; ++m)
#pragma unroll
        for (int n = 0; n < 2; ++n) acc[a][b][m][n] = (f32x4){0.f, 0.f, 0.f, 0.f};
  bf16x8 At[4][2], B0[2][2], B1[2][2];
  const char* cA = (const char*)g.A + (size_t)cur.pm * tstep; const char* cB = (const char*)g.Bt + (size_t)cur.pn * tstep;
  PG8_STAGE(PG8_SB(0, 0), cB, voffB); PG8_STAGE(PG8_SA(0, 0), cA, voffA); PG8_STAGE(PG8_SB(0, 1), cB + hstep, voffB); PG8_STAGE(PG8_SA(0, 1), cA + hstep, voffA);
  if (wr == 1) PG8_BAR;
  PG8_WAIT_V(4); PG8_BAR;
  PG8_STAGE(PG8_SB(1, 0), cB + kstep, voffB); PG8_STAGE(PG8_SA(1, 0), cA + kstep, voffA); PG8_STAGE(PG8_SB(1, 1), cB + hstep + kstep, voffB);
  PG8_WAIT_V(6); PG8_BAR;
  for (;;) {
    const bool has_next = S.next(ui + 1, nxt);
    const char* nA = has_next ? (const char*)g.A + (size_t)nxt.pm * tstep : cA; const char* nB = has_next ? (const char*)g.Bt + (size_t)nxt.pn * tstep : cB;
    for (int t = 0; t < nt; t += 2) {
      const bool last = (t == nt - 2);
      const char* a1 = cA + (size_t)(t + 1) * kstep;
      const char* a2 = last ? nA : cA + (size_t)(t + 2) * kstep; const char* b2 = last ? nB : cB + (size_t)(t + 2) * kstep;
      const char* a3 = a2 + kstep; const char* b3 = b2 + kstep;
      PG8_LDB(B0, 0, 0); PG8_SCHED; PG8_LDA(At, 0, 0); PG8_STAGE(PG8_SA(1, 1), a1 + hstep, voffA);
      PG8_WAIT_L(8); PG8_BAR; PG8_WAIT_L(0); PG8_MMA(0, 0, At, B0); PG8_BAR; PG8_SCHED;
      PG8_LDB(B1, 0, 1); PG8_STAGE(PG8_SB(0, 0), b2, voffB);
      PG8_BAR; PG8_WAIT_L(0); PG8_MMA(0, 1, At, B1); PG8_BAR;
      PG8_LDA(At, 0, 1); PG8_STAGE(PG8_SA(0, 0), a2, voffA);
      PG8_BAR; PG8_WAIT_L(0); PG8_MMA(1, 0, At, B0); PG8_BAR; PG8_SCHED;
      PG8_STAGE(PG8_SB(0, 1), b2 + hstep, voffB);
      PG8_WAIT_V(6); PG8_BAR; PG8_MMA(1, 1, At, B1); PG8_BAR;
      PG8_LDB(B0, 1, 0); PG8_SCHED; PG8_LDA(At, 1, 0); PG8_STAGE(PG8_SA(0, 1), a2 + hstep, voffA);
      PG8_WAIT_L(8); PG8_BAR; PG8_WAIT_L(0); PG8_MMA(0, 0, At, B0); PG8_BAR; PG8_SCHED;
      PG8_LDB(B1, 1, 1); PG8_STAGE(PG8_SB(1, 0), b3, voffB);
      PG8_BAR; PG8_WAIT_L(0); PG8_MMA(0, 1, At, B1); PG8_BAR;
      PG8_LDA(At, 1, 1); PG8_STAGE(PG8_SA(1, 0), a3, voffA);
      PG8_BAR; PG8_WAIT_L(0); PG8_MMA(1, 0, At, B0); PG8_BAR; PG8_SCHED;
      PG8_STAGE(PG8_SB(1, 1), b3 + hstep, voffB);
      PG8_WAIT_V(6); PG8_BAR; PG8_MMA(1, 1, At, B1); PG8_BAR;
    }
    E(acc, cur, wr, wc, fr, fq);
    if (!has_next) break;
#pragma unroll
    for (int a = 0; a < 2; ++a)
#pragma unroll
      for (int b = 0; b < 2; ++b)
#pragma unroll
        for (int m = 0; m < 4; ++m)
#pragma unroll
          for (int n = 0; n < 2; ++n) acc[a][b][m][n] = (f32x4){0.f, 0.f, 0.f, 0.f};
    cur = nxt; cA = nA; cB = nB; ++ui;
  }
  PG8_WAIT_V(0);
  if (wr == 0) PG8_BAR;
  PG8_BAR;
#undef PG8_SA
#undef PG8_SB
#undef PG8_STAGE
#undef PG8_LDA
#undef PG8_LDB
#undef PG8_MMA
#undef PG8_WAIT_V
#undef PG8_WAIT_L
#undef PG8_BAR
#undef PG8_SCHED
}
}

struct EpiIn0 {
  static constexpr bool PERM = true;
  bf16_t* P0; _Float16* LG; const float* hlb;
  DI void operator()(const f32x4 (&acc)[2][2][4][2], const pg8::Unit& u, int wr, int wc, int fr, int fq) const {
    const int row0 = u.pm * 256 + wr * 64 + fr, pn = u.pn;
    if (pn >= 4 && pn < 8) {
#pragma unroll
      for (int bj = 0; bj < 2; ++bj) {
        const int c0 = pn * 256 + bj * 128 + wc * 32 + 8 * fq, ch = (c0 - 1024) & 511;
        float lb[8];
#pragma unroll
        for (int e = 0; e < 8; ++e) lb[e] = __builtin_amdgcn_rcpf(1.0f + __expf(hlb[512 + ch + e] - hlb[ch + e]));
#pragma unroll
        for (int ai = 0; ai < 2; ++ai)
#pragma unroll
          for (int m = 0; m < 4; ++m) {
            _Float16* dst = LG + (size_t)(row0 + ai * 128 + m * 16) * 1024 + (c0 - 1024);
            f16x8 hv;
#pragma unroll
            for (int n = 0; n < 2; ++n) {
#pragma unroll
              for (int j = 0; j < 4; ++j) { const float a = acc[ai][bj][m][n][j]; const float sg = __builtin_amdgcn_rcpf(1.0f + __expf(-a)); const float l = lb[4 * n + j]; hv[4 * n + j] = (_Float16)__logf(l + (1.0f - l) * sg); }
            }
            *(f16x8*)dst = hv;
          }
      }
    } else {
      const bool act = (pn < 2);
      const float scl = (pn == 10) ? 0.125f : 1.0f;
#pragma unroll
      for (int bj = 0; bj < 2; ++bj) {
        const int c0 = pn * 256 + bj * 128 + wc * 32 + 8 * fq, pc = c0 < 1024 ? c0 : c0 - 1024;
#pragma unroll
        for (int ai = 0; ai < 2; ++ai)
#pragma unroll
          for (int m = 0; m < 4; ++m) {
            float v[8];
#pragma unroll
            for (int j = 0; j < 4; ++j) { v[j] = acc[ai][bj][m][0][j]; v[4 + j] = acc[ai][bj][m][1][j]; }
#pragma unroll
            for (int j = 0; j < 8; ++j) v[j] = act ? silu_f(v[j]) : v[j] * scl;
            *(u32x4*)(P0 + (size_t)(row0 + ai * 128 + m * 16) * 3072 + pc) = pack8(v);
          }
      }
    }
  }
};
struct EpiIn1 {
  static constexpr bool PERM = true;
  bf16_t* P1; const float* ropeT;
  DI void operator()(const f32x4 (&acc)[2][2][4][2], const pg8::Unit& u, int wr, int wc, int fr, int fq) const {
    const int row0 = u.pm * 256 + wr * 64 + fr, pn = u.pn;
    const bool act = false, rope = (pn < 8) && (u.pm >= 32);
    const float scl = (pn >= 4 && pn < 8) ? 0.08838834764831845f : 1.0f;
    const int i0 = 16 * (wc & 1) + 4 * fq, hf = wc >> 1;
#pragma unroll
    for (int bj = 0; bj < 2; ++bj) {
      const int c0 = pn * 256 + bj * 128 + wc * 32 + 8 * fq;
#pragma unroll
      for (int ai = 0; ai < 2; ++ai)
#pragma unroll
        for (int m = 0; m < 4; ++m) {
          const int row = row0 + ai * 128 + m * 16;
          float v[8];
#pragma unroll
          for (int j = 0; j < 4; ++j) { v[j] = acc[ai][bj][m][0][j]; v[4 + j] = acc[ai][bj][m][1][j]; }
          if (rope) {
            const int t = row & 1023, pos = hf ? (t & 63) : (t >> 6);
            const f32x4 cs = *(const f32x4*)(ropeT + pos * 32 + i0), sn = *(const f32x4*)(ropeT + 2048 + pos * 32 + i0);
#pragma unroll
            for (int q = 0; q < 4; ++q) { const float a = v[2 * q], b = v[2 * q + 1]; v[2 * q] = a * cs[q] - b * sn[q]; v[2 * q + 1] = b * cs[q] + a * sn[q]; }
          }
#pragma unroll
          for (int j = 0; j < 8; ++j) v[j] = act ? silu_f(v[j]) : v[j] * scl;
          *(u32x4*)(P1 + (size_t)row * 4096 + c0) = pack8(v);
        }
    }
  }
};
struct EpiOut {
  static constexpr bool PERM = true;
  const float* gate;
  bf16_t* delta;
  DI void operator()(const f32x4 (&acc)[2][2][4][2], const pg8::Unit& u, int wr, int wc, int fr, int fq) const {
    const int pm = u.pm, row0 = pm * 256 + wr * 64 + fr, col0 = u.pn * 256 + wc * 32 + 8 * fq;
    const int cond = pm < 32 ? 0 : 1 + ((pm - 32) >> 2);
    const float* gp = gate + cond * 3072 + 2048 + col0;
    f32x4 gv[2][2];
#pragma unroll
    for (int bj = 0; bj < 2; ++bj)
#pragma unroll
      for (int n = 0; n < 2; ++n) gv[bj][n] = *(const f32x4*)(gp + bj * 128 + n * 4);
#pragma unroll
    for (int ai = 0; ai < 2; ++ai)
#pragma unroll
      for (int m = 0; m < 4; ++m) {
        bf16_t* dst = delta + (size_t)(row0 + ai * 128 + m * 16) * 1024 + col0;
#pragma unroll
        for (int bj = 0; bj < 2; ++bj) {
          const f32x4 a = gv[bj][0] * acc[ai][bj][m][0], b = gv[bj][1] * acc[ai][bj][m][1];
          u32x4 w; w.x = cvt_pk_bf16(a[0], a[1]); w.y = cvt_pk_bf16(a[2], a[3]); w.z = cvt_pk_bf16(b[0], b[1]); w.w = cvt_pk_bf16(b[2], b[3]);
          *(u32x4*)(dst + bj * 128) = w;
        }
      }
  }
};

template <bool PERMQK>
DI void tr_tile2(const float* __restrict__ W, const int N, bf16_t* __restrict__ Bt, const int nTn, const int t0, const int ntiles, float* tile) {
  const int tid = opaque_i((int)threadIdx.x);
  const int r = tid >> 4, c4 = (tid & 15) * 4;
  f32x4 v[2][2];
#pragma unroll
  for (int h = 0; h < 2; ++h) {
    const int t = min(t0 + h, ntiles - 1), k0 = (t / nTn) * 64, n0 = (t % nTn) * 64;
#pragma unroll
    for (int rr = 0; rr < 2; ++rr) {
      v[h][rr] = (f32x4){0.f, 0.f, 0.f, 0.f};
      if (n0 + c4 < N) v[h][rr] = __builtin_nontemporal_load((const f32x4*)(W + (size_t)(k0 + r + 32 * rr) * N + n0 + c4));
    }
  }
#pragma unroll
  for (int h = 0; h < 2; ++h)
#pragma unroll
    for (int rr = 0; rr < 2; ++rr) { float* d = tile + h * 4160 + (r + 32 * rr) * 65 + c4; d[0] = v[h][rr][0]; d[1] = v[h][rr][1]; d[2] = v[h][rr][2]; d[3] = v[h][rr][3]; }
  __syncthreads();
  const int n = tid >> 3, k8 = (tid & 7) * 8;
#pragma unroll
  for (int h = 0; h < 2; ++h) {
    const int t = t0 + h;
    if (t < ntiles) {
      const int k0 = (t / nTn) * 64, n0 = (t % nTn) * 64;
      if (n0 + n < N) {
        float o[8];
#pragma unroll
        for (int j = 0; j < 8; ++j) o[j] = tile[h * 4160 + (k8 + j) * 65 + n];
        int nr = n0 + n;
        if (PERMQK && nr < 2048) { const int d = nr & 127; nr = (nr & ~127) + 64 * (d >> 6) + 2 * (d & 31) + ((d >> 5) & 1); }
        *(u32x4*)(Bt + (size_t)nr * 1024 + k0 + k8) = pack8(o);
      }
    }
  }
  __syncthreads();
}
DI void phase0b_transposes(const Params& p, unsigned char* shm) {
  const int nb = gridDim.x, bid = blockIdx.x;
  const bool sp = (nb == 256);
  const int slot = sp ? bid - 48 : bid, nsl = sp ? 208 : nb;
  if (slot < 0) return;
  float* tile = (float*)shm;
  for (int t = 2 * slot; t < 1040; t += 2 * nsl) tr_tile2<false>(p.w_in_even, 4128, (bf16_t*)(p.ws + OFF_BTIN0), 65, t, 1040, tile);
}
DI void prep_layer1(const Params& p, unsigned char* shm, const int slot, const int nsl) {
  float* tile = (float*)shm;
  for (int t = 2 * slot; t < 1024; t += 2 * nsl) tr_tile2<true>(p.w_in_odd, 4096, (bf16_t*)(p.ws + OFF_BTIN1), 64, t, 1024, tile);
  for (int t = 2 * (nsl - 1 - slot); t < 256; t += 2 * nsl) tr_tile2<false>(p.w_out_odd, 1024, (bf16_t*)(p.ws + OFF_BTOUT1), 16, t, 256, tile);
  for (int t = 2 * (nsl - 1 - slot); t < 256; t += 2 * nsl) tr_tile2<false>(p.w_out_even, 1024, (bf16_t*)(p.ws + OFF_BTOUT0), 16, t, 256, tile);
}
DI void mod_partials(const Params& p, const int l, const int gw, const int nw) {
  const int lane = opaque_i((int)threadIdx.x) & 63;
  float* modp = (float*)(p.ws + OFF_MODP);
  for (int it = gw; it < 384; it += nw) {
    const int ks = it & 7, cgp = it >> 3;
    float a0 = 0.f, a1 = 0.f, a2 = 0.f, a3 = 0.f, a4 = 0.f;
    const float* wp = p.ada_w + (size_t)l * 1024 * 3072 + (size_t)(ks * 128) * 3072 + cgp * 64 + lane;
#pragma unroll 1
    for (int hh = 0; hh < 2; ++hh) {
      const int k = ks * 128 + hh * 64 + lane;
      const float s0 = silu_f(p.c_ctx[k]), s1 = silu_f(p.c[k]), s2 = silu_f(p.c[1024 + k]), s3 = silu_f(p.c[2048 + k]), s4 = silu_f(p.c[3072 + k]);
#pragma unroll 16
      for (int kk = 0; kk < 64; ++kk) {
        const float w = __builtin_nontemporal_load(wp + (size_t)(hh * 64 + kk) * 3072);
        a0 += __shfl(s0, kk) * w; a1 += __shfl(s1, kk) * w; a2 += __shfl(s2, kk) * w; a3 += __shfl(s3, kk) * w; a4 += __shfl(s4, kk) * w;
      }
    }
    float* mo = modp + ((size_t)(ks * 2 + l) * 5) * 3072 + cgp * 64 + lane;
    mo[0] = a0; mo[3072] = a1; mo[6144] = a2; mo[9216] = a3; mo[12288] = a4;
  }
}
DI void phase0(const Params& p, unsigned char* shm) {
  const int tid = opaque_i((int)threadIdx.x), nb = gridDim.x, bid = blockIdx.x;
  mod_partials(p, 0, bid * 8 + (tid >> 6), nb * 8);
  float* rope = (float*)(p.ws + OFF_ROPE);
  for (int i = bid * 512 + tid; i < 2048; i += nb * 512) {
    const int pos = i >> 5, fi = i & 31;
    const float inv = exp2f(-(float)(2 * fi) * (13.287712379549449f / 64.0f));
    const float ang = (float)pos * inv;
    const double kq = rint((double)ang * 0.15915494309189535);
    const float rr = (float)((double)ang - kq * 6.283185307179586);
    rope[i] = __cosf(rr);
    rope[2048 + i] = __sinf(rr);
  }
}

DI void phase_norm_mod(const Params& p, int l, bool with_delta) {
  const int tid = opaque_i((int)threadIdx.x), nb = gridDim.x, bid = blockIdx.x, wid = tid >> 6, lane = tid & 63, gw = bid * 8 + wid, nw = nb * 8;
  const float* modp = (const float*)(p.ws + OFF_MODP);
  bf16_t* A = (bf16_t*)(p.ws + OFF_A);
  {
    float* mod = (float*)(p.ws + OFF_MOD);
    for (int i = l * 15360 + bid * 512 + tid; i < (l + 1) * 15360; i += nb * 512) {
      float s = p.ada_b[(i / 15360) * 3072 + (i % 3072)];
#pragma unroll
      for (int ks = 0; ks < 8; ++ks) s += modp[ks * 30720 + i];
      mod[i] = s;
    }
  }
  const int rpw = (TALL + nw - 1) / nw;
  int cur = -1;
  f32x4 sc[4], sh[4], nwv[4];
#pragma unroll
  for (int i = 0; i < 4; ++i) { nwv[i] = *(const f32x4*)(p.norm_w + l * 1024 + lane * 4 + 256 * i); sc[i] = (f32x4){0.f, 0.f, 0.f, 0.f}; sh[i] = sc[i]; }
  const int rend = min(TALL, (gw + 1) * rpw);
  for (int rb = gw * rpw; rb < rend; rb += 6) {
    f32x4 x[6][4];
#pragma unroll
    for (int j = 0; j < 6; ++j) {
      const int r = min(rb + j, rend - 1);
      const float* src = r < TCTX ? p.x_prompt + (size_t)r * 1024 : p.x_sample + (size_t)(r - TCTX) * 1024;
#pragma unroll
      for (int i = 0; i < 4; ++i) x[j][i] = __builtin_nontemporal_load((const f32x4*)(src + lane * 4 + 256 * i));
      if (with_delta) {
        const bf16_t* dp = (const bf16_t*)(p.ws + OFF_D0) + (size_t)r * 1024 + lane * 4;
#pragma unroll
        for (int i = 0; i < 4; ++i) { const u32x2 dv = *(const u32x2*)(dp + 256 * i); x[j][i] += (f32x4){bf_lo(dv.x), bf_hi(dv.x), bf_lo(dv.y), bf_hi(dv.y)}; }
      }
    }
#pragma unroll
    for (int j = 0; j < 6; ++j) {
      const int r = rb + j;
      if (r < rend) {
        const int cond = r < TCTX ? 0 : 1 + ((r - TCTX) >> 10);
        if (cond != cur) {
          cur = cond;
#pragma unroll
          for (int i = 0; i < 4; ++i) {
            const int col = lane * 4 + 256 * i;
            f32x4 a = *(const f32x4*)(p.ada_b + l * 3072 + col), b = *(const f32x4*)(p.ada_b + l * 3072 + 1024 + col);
#pragma unroll 2
            for (int ks = 0; ks < 8; ++ks) {
              const float* mp = modp + ((size_t)(ks * 2 + l) * 5 + cond) * 3072 + col;
              a += *(const f32x4*)mp; b += *(const f32x4*)(mp + 1024);
            }
            sh[i] = a; sc[i] = b;
          }
        }
        float ss = 0.f;
#pragma unroll
        for (int i = 0; i < 4; ++i) ss += x[j][i][0] * x[j][i][0] + x[j][i][1] * x[j][i][1] + x[j][i][2] * x[j][i][2] + x[j][i][3] * x[j][i][3];
        ss = wave_sum(ss);
        const float rstd = rsqrtf(ss * (1.0f / 1024.0f) + 1e-6f);
#pragma unroll
        for (int i = 0; i < 4; ++i) {
          f32x4 h = x[j][i] * rstd * nwv[i] * (sc[i] + 1.0f) + sh[i];
          u32x2 w; w.x = cvt_pk_bf16(h[0], h[1]); w.y = cvt_pk_bf16(h[2], h[3]);
          *(u32x2*)(A + (size_t)r * 1024 + lane * 4 + 256 * i) = w;
        }
      }
    }
  }
}

DI void phase_tail(const Params& p, unsigned char* shm) {
  const int tid = opaque_i((int)threadIdx.x), nb = gridDim.x, bid = blockIdx.x, wid = tid >> 6, lane = tid & 63;
  const int r16 = lane & 15, g = lane >> 4;
  float* part = (float*)shm;
  float* lowS = (float*)(shm + 50688);
  const bf16_t* A = (const bf16_t*)(p.ws + OFF_A);
  const bf16_t* Bt = (const bf16_t*)(p.ws + OFF_BTIN0) + (size_t)4096 * 1024;
  _Float16* GG = (_Float16*)(p.ws + OFF_GG);
  const int gd = tid >> 8, gc = tid & 255;
  f32x2 w2[8];
#pragma unroll
  for (int r = 0; r < 8; ++r) { w2[r][0] = p.gla_gk_w[(gd * 16 + 2 * r) * 256 + gc]; w2[r][1] = p.gla_gk_w[(gd * 16 + 2 * r + 1) * 256 + gc]; }
  const float gb = p.gla_gk_b[gd * 256 + gc];
  for (int grp = bid; grp < TALL / 48; grp += nb) {
    const int row0 = grp * 48;
    {
      f32x4 acc[3][2];
#pragma unroll
      for (int j = 0; j < 3; ++j) { acc[j][0] = (f32x4){0.f, 0.f, 0.f, 0.f}; acc[j][1] = acc[j][0]; }
      const bf16_t* ap = A + (size_t)(row0 + r16) * 1024 + wid * 128 + 8 * g;
      const bf16_t* bp = Bt + (size_t)r16 * 1024 + wid * 128 + 8 * g;
#pragma unroll
      for (int ks = 0; ks < 4; ++ks) {
        const bf16x8 x0 = *(const bf16x8*)(bp + ks * 32), x1 = *(const bf16x8*)(bp + 16 * 1024 + ks * 32);
#pragma unroll
        for (int j = 0; j < 3; ++j) {
          const bf16x8 a = *(const bf16x8*)(ap + (size_t)j * 16 * 1024 + ks * 32);
          acc[j][0] = __builtin_amdgcn_mfma_f32_16x16x32_bf16(a, x0, acc[j][0], 0, 0, 0);
          acc[j][1] = __builtin_amdgcn_mfma_f32_16x16x32_bf16(a, x1, acc[j][1], 0, 0, 0);
        }
      }
#pragma unroll
      for (int j = 0; j < 3; ++j)
#pragma unroll
        for (int i = 0; i < 4; ++i) {
          float* d = part + ((wid * 3 + j) * 16 + 4 * g + i) * 33;
          d[r16] = acc[j][0][i]; d[16 + r16] = acc[j][1][i];
        }
    }
    __syncthreads();
    for (int e = tid; e < 1536; e += 512) {
      const int rr = e >> 5, c = e & 31, j = rr >> 4, r = rr & 15;
      float sum = 0.f;
#pragma unroll
      for (int w = 0; w < 8; ++w) sum += part[((w * 3 + j) * 16 + r) * 33 + c];
      lowS[rr * 36 + c] = sum;
    }
    __syncthreads();
    {
#pragma unroll 4
      for (int t = 0; t < 48; ++t) {
        const f32x4 l0 = *(const f32x4*)(lowS + t * 36 + 16 * gd), l1 = *(const f32x4*)(lowS + t * 36 + 16 * gd + 4),
                    l2 = *(const f32x4*)(lowS + t * 36 + 16 * gd + 8), l3 = *(const f32x4*)(lowS + t * 36 + 16 * gd + 12);
        f32x2 a0 = __builtin_shufflevector(l0, l0, 0, 1) * w2[0], a1 = __builtin_shufflevector(l1, l1, 0, 1) * w2[2];
        a0 += __builtin_shufflevector(l0, l0, 2, 3) * w2[1]; a1 += __builtin_shufflevector(l1, l1, 2, 3) * w2[3];
        a0 += __builtin_shufflevector(l2, l2, 0, 1) * w2[4]; a1 += __builtin_shufflevector(l3, l3, 0, 1) * w2[6];
        a0 += __builtin_shufflevector(l2, l2, 2, 3) * w2[5]; a1 += __builtin_shufflevector(l3, l3, 2, 3) * w2[7];
        const f32x2 as = a0 + a1;
        GG[(size_t)(row0 + t) * 512 + tid] = (_Float16)(logsigmoid_f(gb + (as[0] + as[1])) * 0.0625f);
      }
    }
    __syncthreads();
  }
}

enum { T_HGRN = 0, T_GLA = 1, T_RET = 2 };
#define MFMA16(a, b, c) __builtin_amdgcn_mfma_f32_16x16x32_bf16((a), (b), (c), 0, 0, 0)
DI bf16x8 ld_frag(const bf16_t* base) {
  const s16x4 lo = *(const s16x4*)base, hi = *(const s16x4*)(base + 16);
  return __builtin_shufflevector(lo, hi, 0, 1, 2, 3, 4, 5, 6, 7);
}
DI bf16x8 ld_frag_tr(const bf16_t* base, int hi_off) {
  const s16x4 lo = __builtin_amdgcn_ds_read_tr16_b64_v4i16((LAS s16x4*)base), hi = __builtin_amdgcn_ds_read_tr16_b64_v4i16((LAS s16x4*)(base + hi_off));
  return __builtin_shufflevector(lo, hi, 0, 1, 2, 3, 4, 5, 6, 7);
}
DI bf16x8 pack_frag(const f32x4& a, const f32x4& b) {
  u32x4 w; w.x = cvt_pk_bf16(a[0], a[1]); w.y = cvt_pk_bf16(a[2], a[3]); w.z = cvt_pk_bf16(b[0], b[1]); w.w = cvt_pk_bf16(b[2], b[3]);
  return __builtin_bit_cast(bf16x8, w);
}

struct LoadSet { u32x4 q, k, v, qp, kp, lg; f32x4 c0, c1, s0, s1; };
template <int KD, int TYPE>
DI void scan_unit(unsigned char* shm, const bf16_t* Pq, const bf16_t* Pk, const bf16_t* Pv, int PS, const _Float16* lgp, int LS, float lgs,
                  const float* s0, float* sout, bf16_t* O, int rowbase, int Tlen, int dir, const float* sdummy, bool rope) {
  const float* ropeT = sdummy;
  constexpr int QS = KD + 8, NP = KD / 32, NKT = KD / 16;
  constexpr int BUFB = 35840, VS = 136;
  const int tid = opaque_i((int)threadIdx.x), wid = tid >> 6, lane = tid & 63, r16 = lane & 15, g = lane >> 4;
  const bool active = wid < KD / 16;
  const int ei = lane & 31, c8 = (16 * wid + 8 * (lane >> 5)) & (KD - 1);
  const int vi = tid >> 4, j8 = (tid & 15) * 8;
  const int jcol = 16 * wid + r16;

  f32x4 accS[NKT];
#pragma unroll
  for (int kt = 0; kt < NKT; ++kt)
#pragma unroll
    for (int i = 0; i < 4; ++i) { const float sv = (s0 ? s0 : sdummy)[(size_t)(16 * kt + 4 * g + i) * 128 + jcol]; accS[kt][i] = s0 ? sv : 0.f; }

  const int nsteps = Tlen >> 5;
  LoadSet LA, LB;
  LA.q = (u32x4){0u, 0u, 0u, 0u}; LA.k = LA.q; LA.v = LA.q; LA.qp = LA.q; LA.kp = LA.q; LA.lg = LA.q;
  LA.c0 = (f32x4){0.f, 0.f, 0.f, 0.f}; LA.c1 = LA.c0; LA.s0 = LA.c0; LA.s1 = LA.c0;
  LB = LA;
  const int eiL = ei;
  auto issue_loads = [&](int n, LoadSet& X) {
    const int tb = 32 * n;
    const int tokE = dir ? Tlen - 1 - (tb + eiL) : tb + eiL;
    const int tokV = dir ? Tlen - 1 - (tb + vi) : tb + vi;
    const size_t ro = (size_t)(rowbase + tokE) * PS;
    X.q = *(const u32x4*)(Pq + ro + c8);
    if (TYPE != T_RET) X.lg = *(const u32x4*)(lgp + (size_t)(rowbase + tokE) * LS + c8);
    if (TYPE != T_HGRN) X.k = *(const u32x4*)(Pk + ro + c8);
    if (TYPE == T_RET) {
      X.qp = *(const u32x4*)(Pq + ro + (c8 ^ 32)); X.kp = *(const u32x4*)(Pk + ro + (c8 ^ 32));
      const int pos = (c8 < 64) ? (tokE >> 6) : (tokE & 63);
      const float* rp = ropeT + pos * 32 + (c8 & 31);
      X.c0 = *(const f32x4*)rp; X.c1 = *(const f32x4*)(rp + 4); X.s0 = *(const f32x4*)(rp + 2048); X.s1 = *(const f32x4*)(rp + 2052);
    }
    X.v = *(const u32x4*)(Pv + (size_t)(rowbase + tokV) * PS + j8);
  };
  auto step = [&](int n, LoadSet& X) {
    const int tb = 32 * n;
    unsigned char* buf = shm + (n & 1) * BUFB;
    bf16_t* QR = (bf16_t*)buf;
    bf16_t* KI = (bf16_t*)(buf + 8704);
    bf16_t* KDm = (bf16_t*)(buf + 17408);
    bf16_t* Vm = (bf16_t*)(buf + 26112);
    float* EV = (float*)(buf + 34816);
    if (active) {
      float pre[8];
      const f16x8 hl = __builtin_bit_cast(f16x8, X.lg);
#pragma unroll
      for (int e = 0; e < 8; ++e) pre[e] = (float)hl[e];
#define DPP_ADD(ctrl, rmask, bc) _Pragma("unroll") for (int e = 0; e < 8; ++e) pre[e] += __builtin_bit_cast(float, __builtin_amdgcn_update_dpp(0, __builtin_bit_cast(int, pre[e]), ctrl, rmask, 0xf, bc))
      DPP_ADD(0x111, 0xf, true);
      DPP_ADD(0x112, 0xf, true);
      DPP_ADD(0x114, 0xf, true);
      DPP_ADD(0x118, 0xf, true);
      DPP_ADD(0x142, 0xa, false);
#undef DPP_ADD
      float q[8], kk[8];
      unpack8(X.q, q);
      if (TYPE == T_HGRN) {
#pragma unroll
        for (int e = 0; e < 8; ++e) kk[e] = 1.0f - __expf((float)hl[e]);
      } else unpack8(X.k, kk);
      float qr[8], ki[8], kd[8];
      const int lR = ((lane & 32) | 15) << 2, lL = (lane | 31) << 2;
#pragma unroll
      for (int e = 0; e < 8; ++e) {
        const float rr = __builtin_bit_cast(float, __builtin_amdgcn_ds_bpermute(lR, __builtin_bit_cast(int, pre[e])));
        const float x = __builtin_amdgcn_fmed3f(pre[e] - rr, -80.f, 80.f);
        const float er = __expf(x), ek = __builtin_amdgcn_rcpf(er);
        const float er31 = __builtin_bit_cast(float, __builtin_amdgcn_ds_bpermute(lL, __builtin_bit_cast(int, er)));
        qr[e] = q[e] * er; ki[e] = kk[e] * ek; kd[e] = ki[e] * er31;
      }
      if ((lane & 15) == 15) {
        float* evp = EV + ((lane & 16) ? 0 : 128) + c8;
#pragma unroll
        for (int e = 0; e < 8; ++e) evp[e] = __expf(pre[e]);
      }
      *(u32x4*)(QR + ei * QS + c8) = pack8(qr);
      *(u32x4*)(KI + ei * QS + c8) = pack8(ki);
      *(u32x4*)(KDm + ei * QS + c8) = pack8(kd);
    }
    *(u32x4*)(Vm + vi * VS + j8) = X.v;
    issue_loads(min(n + 2, nsteps - 1), X);
    __syncthreads();
    {
      const int tq = r16 >> 2, tp = r16 & 3;
      const bf16x8 vfrag = ld_frag_tr(Vm + (4 * g + tq) * VS + 16 * wid + 4 * tp, 16 * VS);
      bf16x8 qf[2][NP];
#pragma unroll
      for (int tt = 0; tt < 2; ++tt)
#pragma unroll
        for (int pp = 0; pp < NP; ++pp) qf[tt][pp] = ld_frag(QR + (16 * tt + r16) * QS + 32 * pp + 4 * g);
      f32x4 sc00 = (f32x4){0.f, 0.f, 0.f, 0.f}, sc01 = sc00, sc11 = sc00;
#pragma unroll
      for (int pp = 0; pp < NP; ++pp) {
        const bf16x8 kf0 = ld_frag(KI + r16 * QS + 32 * pp + 4 * g), kf1 = ld_frag(KI + (16 + r16) * QS + 32 * pp + 4 * g);
        sc00 = MFMA16(kf0, qf[0][pp], sc00); sc01 = MFMA16(kf0, qf[1][pp], sc01); sc11 = MFMA16(kf1, qf[1][pp], sc11);
      }
#pragma unroll
      for (int i = 0; i < 4; ++i) if (4 * g + i > r16) { sc00[i] = 0.f; sc11[i] = 0.f; }
      const f32x4 z4 = (f32x4){0.f, 0.f, 0.f, 0.f};
      const bf16x8 pf0 = pack_frag(sc00, z4), pf1 = pack_frag(sc01, sc11);
      f32x4 o0 = MFMA16(vfrag, pf0, z4), o1 = MFMA16(vfrag, pf1, z4);
#pragma unroll
      for (int pp = 0; pp < NP; ++pp) {
        f32x4 e0, e1;
        e0 = *(const f32x4*)(EV + 128 + 32 * pp + 4 * g); e1 = *(const f32x4*)(EV + 128 + 32 * pp + 16 + 4 * g);
        const bf16x8 sf = pack_frag(accS[2 * pp] * e0, accS[2 * pp + 1] * e1);
        o0 = MFMA16(sf, qf[0][pp], o0); o1 = MFMA16(sf, qf[1][pp], o1);
      }
#pragma unroll
      for (int kt = 0; kt < NKT; ++kt) {
        f32x4 eb;
        eb = *(const f32x4*)(EV + 16 * kt + 4 * g);
        const bf16x8 kdf = ld_frag_tr(KDm + (4 * g + tq) * QS + 16 * kt + 4 * tp, 16 * QS);
        accS[kt] = MFMA16(kdf, vfrag, accS[kt] * eb);
      }
      {
        const int t0 = tb + r16, t1 = tb + 16 + r16;
        const int tok0 = dir ? Tlen - 1 - t0 : t0, tok1 = dir ? Tlen - 1 - t1 : t1;
        u32x2 w0, w1; w0.x = cvt_pk_bf16(o0[0], o0[1]); w0.y = cvt_pk_bf16(o0[2], o0[3]); w1.x = cvt_pk_bf16(o1[0], o1[1]); w1.y = cvt_pk_bf16(o1[2], o1[3]);
        *(u32x2*)(O + (size_t)(rowbase + tok0) * 1024 + 16 * wid + 4 * g) = w0;
        *(u32x2*)(O + (size_t)(rowbase + tok1) * 1024 + 16 * wid + 4 * g) = w1;
      }
    }
  };
  issue_loads(0, LA);
  issue_loads(1, LB);
  for (int n = 0; n < nsteps; n += 2) { step(n, LA); step(n + 1, LB); }
  if (sout) {
#pragma unroll
    for (int kt = 0; kt < NKT; ++kt)
#pragma unroll
      for (int i = 0; i < 4; ++i) __builtin_nontemporal_store(accS[kt][i], sout + (size_t)(16 * kt + 4 * g + i) * 128 + jcol);
  }
  __syncthreads();
}


struct LoadSet3 { u32x4 q, k, v; };
DI int ret_lrow(int pk) { const int pp = pk >> 1; return 64 * (pp >> 5) + (pp & 31) + 32 * (pk & 1); }
DI void scan_unit_ret(unsigned char* shm, const bf16_t* Pq, const bf16_t* Pk, const bf16_t* Pv, float lgs, const float* s0, float* sout, bf16_t* O,
                      int rowbase, int Tlen, int dir, const float* sdummy) {
  constexpr int QS = 136, NP = 4, NKT = 8, PS = 4096, BUFB = 3 * 8704;
  const int tid = opaque_i((int)threadIdx.x), wid = tid >> 6, lane = tid & 63, r16 = lane & 15, g = lane >> 4;
  const int ei = tid >> 4, c8 = (tid & 15) * 8;
  const int jcol = 16 * wid + r16;
  f32x4 accS[NKT];
#pragma unroll
  for (int kt = 0; kt < NKT; ++kt)
#pragma unroll
    for (int i = 0; i < 4; ++i) { const float sv = (s0 ? s0 : sdummy)[(size_t)ret_lrow(16 * kt + 4 * g + i) * 128 + jcol]; accS[kt][i] = s0 ? sv : 0.f; }
  f32x4 dm, d01; float cs[8];
#pragma unroll
  for (int i = 0; i < 4; ++i) { const int dd = r16 - 4 * g - i; dm[i] = dd >= 0 ? __expf((float)dd * lgs) : 0.f; d01[i] = __expf((float)(16 + dd) * lgs); }
#pragma unroll
  for (int j = 0; j < 8; ++j) cs[j] = __expf((float)(31 - (16 * (j >> 2) + 4 * g + (j & 3))) * lgs);
  const float ct0 = __expf((float)(r16 + 1) * lgs), ct1 = __expf((float)(r16 + 17) * lgs), eb = __expf(32.0f * lgs);
  const int nsteps = Tlen >> 5;
  LoadSet3 LA, LB;
  auto issue_loads = [&](int n, LoadSet3& X) {
    const int tok = dir ? Tlen - 1 - (32 * n + ei) : 32 * n + ei;
    const size_t ro = (size_t)(rowbase + tok) * PS + c8;
    X.q = *(const u32x4*)(Pq + ro); X.k = *(const u32x4*)(Pk + ro); X.v = *(const u32x4*)(Pv + ro);
  };
  auto step = [&](int n, LoadSet3& X) {
    const int tb = 32 * n;
    unsigned char* buf = shm + (n & 1) * BUFB;
    bf16_t* Qm = (bf16_t*)buf; bf16_t* Km = (bf16_t*)(buf + 8704); bf16_t* Vm = (bf16_t*)(buf + 17408);
    *(u32x4*)(Qm + ei * QS + c8) = X.q;
    *(u32x4*)(Km + ei * QS + c8) = X.k;
    *(u32x4*)(Vm + ei * QS + c8) = X.v;
    issue_loads(min(n + 2, nsteps - 1), X);
    __syncthreads();
    const int tq = r16 >> 2, tp = r16 & 3;
    const bf16x8 vfrag = ld_frag_tr(Vm + (4 * g + tq) * QS + 16 * wid + 4 * tp, 16 * QS);
    bf16x8 qf[2][NP];
#pragma unroll
    for (int tt = 0; tt < 2; ++tt)
#pragma unroll
      for (int pp = 0; pp < NP; ++pp) qf[tt][pp] = ld_frag(Qm + (16 * tt + r16) * QS + 32 * pp + 4 * g);
    f32x4 sc00 = (f32x4){0.f, 0.f, 0.f, 0.f}, sc01 = sc00, sc11 = sc00;
#pragma unroll
    for (int pp = 0; pp < NP; ++pp) {
      const bf16x8 kf0 = ld_frag(Km + r16 * QS + 32 * pp + 4 * g), kf1 = ld_frag(Km + (16 + r16) * QS + 32 * pp + 4 * g);
      sc00 = MFMA16(kf0, qf[0][pp], sc00); sc01 = MFMA16(kf0, qf[1][pp], sc01); sc11 = MFMA16(kf1, qf[1][pp], sc11);
    }
    const f32x4 z4 = (f32x4){0.f, 0.f, 0.f, 0.f};
    const bf16x8 pf0 = pack_frag(sc00 * dm, z4), pf1 = pack_frag(sc01 * d01, sc11 * dm);
    f32x4 o0 = MFMA16(vfrag, pf0, z4), o1 = MFMA16(vfrag, pf1, z4);
    f32x4 oi0 = z4, oi1 = z4;
#pragma unroll
    for (int pp = 0; pp < NP; ++pp) {
      const bf16x8 sf = pack_frag(accS[2 * pp], accS[2 * pp + 1]);
      oi0 = MFMA16(sf, qf[0][pp], oi0); oi1 = MFMA16(sf, qf[1][pp], oi1);
    }
    o0 += oi0 * ct0; o1 += oi1 * ct1;
    bf16x8 vsf;
    {
      float vv[8];
      unpack8(__builtin_bit_cast(u32x4, vfrag), vv);
#pragma unroll
      for (int j = 0; j < 8; ++j) vv[j] *= cs[j];
      vsf = __builtin_bit_cast(bf16x8, pack8(vv));
    }
#pragma unroll
    for (int kt = 0; kt < NKT; ++kt) {
      const bf16x8 kdf = ld_frag_tr(Km + (4 * g + tq) * QS + 16 * kt + 4 * tp, 16 * QS);
      accS[kt] = MFMA16(kdf, vsf, accS[kt] * eb);
    }
    {
      const int t0 = tb + r16, t1 = tb + 16 + r16;
      const int tok0 = dir ? Tlen - 1 - t0 : t0, tok1 = dir ? Tlen - 1 - t1 : t1;
      u32x2 w0, w1; w0.x = cvt_pk_bf16(o0[0], o0[1]); w0.y = cvt_pk_bf16(o0[2], o0[3]); w1.x = cvt_pk_bf16(o1[0], o1[1]); w1.y = cvt_pk_bf16(o1[2], o1[3]);
      *(u32x2*)(O + (size_t)(rowbase + tok0) * 1024 + 16 * wid + 4 * g) = w0;
      *(u32x2*)(O + (size_t)(rowbase + tok1) * 1024 + 16 * wid + 4 * g) = w1;
    }
  };
  issue_loads(0, LA);
  issue_loads(1, LB);
  for (int n = 0; n < nsteps; n += 2) { step(n, LA); step(n + 1, LB); }
  if (sout) {
#pragma unroll
    for (int kt = 0; kt < NKT; ++kt)
#pragma unroll
      for (int i = 0; i < 4; ++i) __builtin_nontemporal_store(accS[kt][i], sout + (size_t)ret_lrow(16 * kt + 4 * g + i) * 128 + jcol);
  }
  __syncthreads();
}

DI int scan_unit_id(int k, int bid, int nb) {
  if (nb == 256) {
    if (bid < 64) return k == 0 ? bid : -1;
    const int j = bid - 64;
    if (k == 0) return 64 + j;
    if (k == 1) return 64 + 192 + j;
    if (k == 2 && j < 128) return 64 + 384 + j;
    return -1;
  }
  const int u = bid + k * nb;
  return u < 576 ? u : -1;
}

DI void phase_scan(const Params& p, int layer, unsigned char* shm) {
  const int bid = blockIdx.x, nb = gridDim.x;
  bf16_t* OF = (bf16_t*)(p.ws + OFF_OF); bf16_t* OB = (bf16_t*)(p.ws + OFF_OB);
  const bf16_t* P = (const bf16_t*)(p.ws + OFF_P);
  for (int k = 0;; ++k) {
    const int u = scan_unit_id(k, bid, nb);
    if (u < 0) break;
    const bool lat = u < 64;
    const int v = lat ? u : u - 64;
    if (layer == 0) {
      const int half = lat ? 32 : 256;
      const bool gla = v >= half;
      const int idx = gla ? v - half : v;
      const int b = idx >> 3, h = (idx >> 1) & 3, d = idx & 1;
      const int rowbase = lat ? TCTX + b * 1024 : b * 256, Tlen = lat ? 1024 : 256;
      bf16_t* O = (d ? OB : OF);
      if (!gla) {
        const float* s0 = lat ? p.state_hgrn + (size_t)((b * 2 + d) * 4 + h) * 16384 : nullptr;
        float* so = lat ? nullptr : p.out + OUT_HGRN + (size_t)((b * 2 + d) * 4 + h) * 16384;
        scan_unit<128, T_HGRN>(shm, P + h * 128, nullptr, P + 512 + h * 128, 3072, (const _Float16*)(p.ws + OFF_LG) + d * 512 + h * 128, 1024, 0.f, s0, so,
                               O + h * 128, rowbase, Tlen, d, p.state_hgrn, false);
      } else {
        const float* s0 = lat ? p.state_gla + (size_t)((b * 2 + d) * 4 + h) * 8192 : nullptr;
        float* so = lat ? nullptr : p.out + OUT_GLA + (size_t)((b * 2 + d) * 4 + h) * 8192;
        scan_unit<64, T_GLA>(shm, P + 1536 + h * 64, P + 1792 + h * 64, P + 2048 + h * 128, 3072, (const _Float16*)(p.ws + OFF_GG) + d * 256 + h * 64, 512, 0.f,
                             s0, so, O + 512 + h * 128, rowbase, Tlen, d, p.state_hgrn, false);
      }
    } else {
      const int b = v >> 4, h = (v >> 1) & 7, d = v & 1;
      const int rowbase = lat ? TCTX + b * 1024 : b * 256, Tlen = lat ? 1024 : 256;
      const float* s0 = lat ? p.state_ret + (size_t)((b * 2 + d) * 8 + h) * 16384 : nullptr;
      float* so = lat ? nullptr : p.out + OUT_RET + (size_t)((b * 2 + d) * 8 + h) * 16384;
      const float lgs = logsigmoid_f(p.ret_decay[d * 8 + h]);
      scan_unit_ret(shm, P + h * 128, P + 1024 + h * 128, P + 2048 + h * 128, lgs, s0, so, (d ? OB : OF) + h * 128, rowbase, Tlen, d, p.state_ret);
    }
  }
  if (layer == 0) {
    const bool sp = (nb == 256);
    const int slot = sp ? bid - 64 : bid, nsl = sp ? 192 : nb;
    if (slot >= 0) {
      prep_layer1(p, shm, slot, nsl);
      mod_partials(p, 1, slot * 8 + ((int)threadIdx.x >> 6), nsl * 8);
    }
  }
}

DI void phase_combine(const Params& p, int layer) {
  const int tid = opaque_i((int)threadIdx.x), nb = gridDim.x, bid = blockIdx.x, wid = tid >> 6, lane = tid & 63, gw = bid * 8 + wid, nw = nb * 8;
  const bf16_t* OF = (const bf16_t*)(p.ws + OFF_OF); const bf16_t* OB = (const bf16_t*)(p.ws + OFF_OB);
  const bf16_t* P = (const bf16_t*)(p.ws + OFF_P);
  bf16_t* A = (bf16_t*)(p.ws + OFF_A);
  const float* gn = layer == 0 ? p.gn_even : p.gn_odd;
  const int c0 = lane * 16;
  float gnv[16];
#pragma unroll
  for (int i = 0; i < 16; ++i) gnv[i] = gn[c0 + i];
  for (int rb = gw; rb < TALL; rb += 6 * nw) {
    u32x4 rf[6][2], rbk[6][2], rg[6][2];
#pragma unroll
    for (int j = 0; j < 6; ++j) {
      const int r = min(rb + j * nw, TALL - 1);
      const bf16_t* gp = layer == 0 ? P + (size_t)r * 3072 + (c0 < 512 ? 1024 + c0 : 2048 + c0) : P + (size_t)r * 4096 + 3072 + c0;
      rf[j][0] = *(const u32x4*)(OF + (size_t)r * 1024 + c0); rf[j][1] = *(const u32x4*)(OF + (size_t)r * 1024 + c0 + 8);
      rbk[j][0] = *(const u32x4*)(OB + (size_t)r * 1024 + c0); rbk[j][1] = *(const u32x4*)(OB + (size_t)r * 1024 + c0 + 8);
      rg[j][0] = *(const u32x4*)gp; rg[j][1] = *(const u32x4*)(gp + 8);
    }
#pragma unroll
    for (int j = 0; j < 6; ++j) {
      const int r = rb + j * nw;
      if (r < TALL) {
        float o[16], t[16], sg[16];
        unpack8(rf[j][0], o); unpack8(rf[j][1], o + 8); unpack8(rbk[j][0], t); unpack8(rbk[j][1], t + 8); unpack8(rg[j][0], sg); unpack8(rg[j][1], sg + 8);
        float ss = 0.f;
#pragma unroll
        for (int i = 0; i < 16; ++i) { o[i] += t[i]; ss += o[i] * o[i]; }
        ss += __shfl_xor(ss, 1); ss += __shfl_xor(ss, 2); ss += __shfl_xor(ss, 4);
        const float rstd = rsqrtf(ss * (1.0f / 128.0f) + 1e-6f);
#pragma unroll
        for (int i = 0; i < 16; ++i) o[i] = o[i] * rstd * gnv[i] * silu_f(sg[i]);
        *(u32x4*)(A + (size_t)r * 1024 + c0) = pack8(o);
        *(u32x4*)(A + (size_t)r * 1024 + c0 + 8) = pack8(o + 8);
      }
    }
  }
}

DI void phase_final_norm(const Params& p) {
  const int tid = opaque_i((int)threadIdx.x), nb = gridDim.x, bid = blockIdx.x, wid = tid >> 6, lane = tid & 63, gw = bid * 8 + wid, nw = nb * 8;
  f32x4 fw[4];
#pragma unroll
  for (int i = 0; i < 4; ++i) fw[i] = *(const f32x4*)(p.final_norm_w + lane * 4 + 256 * i);
  for (int rb = gw; rb < TALL; rb += 6 * nw) {
    f32x4 x[6][4];
#pragma unroll
    for (int j = 0; j < 6; ++j) {
      const int rr = min(rb + j * nw, TALL - 1);
      const float* row = rr < TCTX ? p.x_prompt + (size_t)rr * 1024 : p.x_sample + (size_t)(rr - TCTX) * 1024;
      const bf16_t* dp = (const bf16_t*)(p.ws + OFF_OF) + (size_t)rr * 1024 + lane * 4;
      const bf16_t* d0 = (const bf16_t*)(p.ws + OFF_D0) + (size_t)rr * 1024 + lane * 4;
#pragma unroll
      for (int i = 0; i < 4; ++i) {
        const u32x2 dv = *(const u32x2*)(dp + 256 * i), ev = *(const u32x2*)(d0 + 256 * i);
        x[j][i] = (__builtin_nontemporal_load((const f32x4*)(row + lane * 4 + 256 * i)) + (f32x4){bf_lo(ev.x), bf_hi(ev.x), bf_lo(ev.y), bf_hi(ev.y)}) + (f32x4){bf_lo(dv.x), bf_hi(dv.x), bf_lo(dv.y), bf_hi(dv.y)};
      }
    }
#pragma unroll
    for (int j = 0; j < 6; ++j) {
      const int r = rb + j * nw;
      if (r < TALL) {
        float* row = p.out + (size_t)r * 1024;
        float ss = 0.f;
#pragma unroll
        for (int i = 0; i < 4; ++i) ss += x[j][i][0] * x[j][i][0] + x[j][i][1] * x[j][i][1] + x[j][i][2] * x[j][i][2] + x[j][i][3] * x[j][i][3];
        ss = wave_sum(ss);
        const float rstd = rsqrtf(ss * (1.0f / 1024.0f) + 1e-6f);
#pragma unroll
        for (int i = 0; i < 4; ++i) __builtin_nontemporal_store(x[j][i] * rstd * fw[i], (f32x4*)(row + lane * 4 + 256 * i));
      }
    }
  }
}

#ifndef REP_P0
#define REP_P0 1
#endif
#ifndef REP_EW
#define REP_EW 1
#endif
#ifndef REP_IN
#define REP_IN 1
#endif
#ifndef REP_SCAN
#define REP_SCAN 1
#endif
#ifndef REP_OUT
#define REP_OUT 1
#endif
__global__ void __launch_bounds__(512, 2) fwd_megakernel(Params p) {
  extern __shared__ __attribute__((aligned(16))) unsigned char shm[];
  cg::grid_group grid = cg::this_grid();
  LAS unsigned char* lds = (LAS unsigned char*)shm;
  const bf16_t* A = (const bf16_t*)(p.ws + OFF_A);
  pg8::StaticOrder S;
  volatile LAS unsigned* xst = (volatile LAS unsigned*)(lds + 131072);
  if (threadIdx.x == 0) { xst[0] = 0u; xst[1] = 0u; }
  __syncthreads();
  const XcdBarrier xb = xcd_barrier_post((unsigned*)(p.ws + OFF_BAR), xst);
  if (p.ws == nullptr) grid.sync();

  for (int rep = 0; rep < REP_P0; ++rep) phase0(p, shm);
  phase0b_transposes(p, shm);
  xcd_barrier(xb);
  for (int rep = 0; rep < REP_EW; ++rep) phase_norm_mod(p, 0, false);
  xcd_barrier(xb);
  for (int rep = 0; rep < REP_IN; ++rep) {
  phase_tail(p, shm);
    pg8::Gemm g{A, (const bf16_t*)(p.ws + OFF_BTIN0), TALL, 4096, 1024};
    EpiIn0 E{(bf16_t*)(p.ws + OFF_P), (_Float16*)(p.ws + OFF_LG), p.hgrn_lb};
    S.init(TALL, 4096, (int)gridDim.x, (int)blockIdx.x);
    pg8::gemm_phase(lds, g, S, E);
  }
  xcd_barrier(xb);
  for (int rep = 0; rep < REP_SCAN; ++rep) phase_scan(p, 0, shm);
  xcd_barrier(xb);
  for (int rep = 0; rep < REP_EW; ++rep) phase_combine(p, 0);
  xcd_barrier(xb);
  for (int rep = 0; rep < REP_OUT; ++rep) {
    pg8::Gemm g{A, (const bf16_t*)(p.ws + OFF_BTOUT0), TALL, 1024, 1024};
    EpiOut E{(const float*)(p.ws + OFF_MOD), (bf16_t*)(p.ws + OFF_D0)};
    S.init(TALL, 1024, (int)gridDim.x, (int)blockIdx.x);
    pg8::gemm_phase(lds, g, S, E);
  }
  xcd_barrier(xb);
  phase_norm_mod(p, 1, true);
  xcd_barrier(xb);
  for (int rep = 0; rep < REP_IN; ++rep) {
    pg8::Gemm g{A, (const bf16_t*)(p.ws + OFF_BTIN1), TALL, 4096, 1024};
    EpiIn1 E{(bf16_t*)(p.ws + OFF_P), (const float*)(p.ws + OFF_ROPE)};
    S.init(TALL, 4096, (int)gridDim.x, (int)blockIdx.x);
    pg8::gemm_phase(lds, g, S, E);
  }
  xcd_barrier(xb);
  for (int rep = 0; rep < REP_SCAN; ++rep) phase_scan(p, 1, shm);
  xcd_barrier(xb);
  for (int rep = 0; rep < REP_EW; ++rep) phase_combine(p, 1);
  xcd_barrier(xb);
  {
    pg8::Gemm g{A, (const bf16_t*)(p.ws + OFF_BTOUT1), TALL, 1024, 1024};
    EpiOut E{(const float*)(p.ws + OFF_MOD) + 15360, (bf16_t*)(p.ws + OFF_OF)};
    S.init(TALL, 1024, (int)gridDim.x, (int)blockIdx.x);
    pg8::gemm_phase(lds, g, S, E);
  }
  xcd_barrier(xb);
  phase_final_norm(p);
}

extern "C" void kernel_launch(void* const* d_in, const int* in_sizes, int n_in, void* d_out, int out_size, void* d_ws, size_t ws_size,
                              hipStream_t stream) {
  constexpr size_t kDynLds = 131072 + 16;
  static int grid_blocks = 0;
  if (!grid_blocks) {
    int dev = 0, cus = 0, per_cu = 0;
    (void)hipGetDevice(&dev);
    (void)hipDeviceGetAttribute(&cus, hipDeviceAttributeMultiprocessorCount, dev);
    (void)hipFuncSetAttribute((const void*)fwd_megakernel, hipFuncAttributeMaxDynamicSharedMemorySize, (int)kDynLds);
    (void)hipOccupancyMaxActiveBlocksPerMultiprocessor(&per_cu, fwd_megakernel, 512, kDynLds);
    if (per_cu < 1) per_cu = 1;
    grid_blocks = cus * per_cu;
  }
  if (ws_size < WS_NEED) fprintf(stderr, "workspace too small: %zu < %zu\n", ws_size, (size_t)WS_NEED);
  Params p{};
  const float** pp = (const float**)&p;
  for (int i = 0; i < 21; ++i) pp[i] = (const float*)d_in[i];
  p.out = (float*)d_out;
  p.ws = (unsigned char*)d_ws;
  (void)hipMemsetAsync((unsigned char*)d_ws + OFF_BAR, 0, XCD_BAR_WORDS * 4, stream);
  void* args[] = {&p};
  hipError_t e = hipLaunchCooperativeKernel((void*)fwd_megakernel, dim3(grid_blocks), dim3(512), args, kDynLds, stream);
  if (e != hipSuccess) fprintf(stderr, "cooperative launch failed: %s (grid %d)\n", hipGetErrorString(e), grid_blocks);
}
```

```cpp
#include <hip/hip_runtime.h>
#include <hip/hip_cooperative_groups.h>
#include <cstdio>
namespace cg = cooperative_groups;

#define DI __device__ __forceinline__
#define LAS __attribute__((address_space(3)))
typedef unsigned short bf16_t;
typedef short bf16x8 __attribute__((ext_vector_type(8)));
typedef short s16x4 __attribute__((ext_vector_type(4)));
typedef float f32x4 __attribute__((ext_vector_type(4)));
typedef unsigned u32x4 __attribute__((ext_vector_type(4)));
typedef unsigned u32x2 __attribute__((ext_vector_type(2)));
typedef _Float16 f16x8 __attribute__((ext_vector_type(8)));

constexpr int TCTX = 8192, TALL = 12288;
constexpr size_t OFF_BTIN0 = 0, OFF_BTOUT0 = 8454144, OFF_BTIN1 = 10551296, OFF_BTOUT1 = 18939904, OFF_MODP = 21037056,
                 OFF_MOD = 22020096, OFF_ROPE = 22142976, OFF_A = 22159360, OFF_P = 47325184, OFF_GG = OFF_P + 75497472,
                 OFF_LG = 147988480, OFF_OF = 198320128, OFF_OB = 223485952, OFF_D0 = OFF_LG + 25165824, OFF_BAR = 248651776, OFF_O2F = 248651776 + 65536, OFF_O2B = OFF_O2F + 8388608, WS_NEED = OFF_O2B + 8388608;
constexpr size_t OUT_HGRN = 12582912, OUT_GLA = 16777216, OUT_RET = 18874368;

struct Params {
  const float *x_prompt, *x_sample, *state_hgrn, *state_gla, *state_ret, *c, *c_ctx, *norm_w, *ada_w, *ada_b, *w_in_even, *hgrn_lb,
      *gla_gk_w, *gla_gk_b, *gn_even, *w_out_even, *w_in_odd, *ret_decay, *gn_odd, *w_out_odd, *final_norm_w;
  float* out;
  unsigned char* ws;
};

typedef float f32x2 __attribute__((ext_vector_type(2)));
typedef __bf16 bf16v2 __attribute__((ext_vector_type(2)));
DI unsigned cvt_pk_bf16(float lo, float hi) { const f32x2 v = {lo, hi}; const bf16v2 b = __builtin_convertvector(v, bf16v2); return __builtin_bit_cast(unsigned, b); }
DI int opaque_i(int x) { asm volatile("" : "+v"(x)); return x; }
DI float bf_lo(unsigned u) { return __uint_as_float(u << 16); }
DI float bf_hi(unsigned u) { return __uint_as_float(u & 0xffff0000u); }
DI float silu_f(float x) { return x * __builtin_amdgcn_rcpf(1.0f + __expf(-x)); }
DI float logsigmoid_f(float x) { return fminf(x, 0.f) - __logf(1.0f + __expf(-fabsf(x))); }
DI void unpack8(const u32x4& u, float* f) {
  f[0] = bf_lo(u.x); f[1] = bf_hi(u.x); f[2] = bf_lo(u.y); f[3] = bf_hi(u.y); f[4] = bf_lo(u.z); f[5] = bf_hi(u.z); f[6] = bf_lo(u.w); f[7] = bf_hi(u.w);
}
DI u32x4 pack8(const float* f) { u32x4 w; w.x = cvt_pk_bf16(f[0], f[1]); w.y = cvt_pk_bf16(f[2], f[3]); w.z = cvt_pk_bf16(f[4], f[5]); w.w = cvt_pk_bf16(f[6], f[7]); return w; }
DI float wave_sum(float v) {
#pragma unroll
  for (int o = 32; o >= 1; o >>= 1) v += __shfl_xor(v, o);
  return v;
}

#define XB_TMO      128
#define XB_XCNT(j)  (256  + 64 * (j))
#define XB_XSUB(j)  (1280 + 64 * (j))
#define XB_XGEN(j)  (2304 + 64 * (j))
#define XB_TOP      3328
#define XB_TOPGEN   3392
#define XCD_BAR_WORDS 3456
#define XB_SPIN_CAP (1u << 18)
DI unsigned xb_ld(unsigned* p) { return __hip_atomic_load(p, __ATOMIC_RELAXED, __HIP_MEMORY_SCOPE_AGENT); }
DI unsigned xb_add(unsigned* p, unsigned v) { return __hip_atomic_fetch_add(p, v, __ATOMIC_RELAXED, __HIP_MEMORY_SCOPE_AGENT); }
DI unsigned xb_xcc_id() { return (unsigned)__builtin_amdgcn_s_getreg((3 << 11) | 20) & 0xFu; }
#define XB_SPIN(cond, bar) do { unsigned _sp = 0; while (cond) { __builtin_amdgcn_s_sleep(1); \
    if ((++_sp & 255u) == 0u) { if (xb_ld(&(bar)[XB_TMO])) break; if (_sp > XB_SPIN_CAP) { atomicAdd(&(bar)[XB_TMO], 1u); break; } } } } while (0)
struct XcdBarrier { unsigned* bar; unsigned x; volatile LAS unsigned* st; };
DI XcdBarrier xcd_barrier_post(unsigned* bar, volatile LAS unsigned* st) {
  XcdBarrier b; b.bar = bar; b.x = xb_xcc_id(); b.st = st;
  if (threadIdx.x == 0) (void)xb_add(&bar[XB_XCNT(b.x)], 1u);
  return b;
}
DI void xcd_barrier_complete(unsigned* bar, unsigned x, unsigned& nloc, unsigned& nx) {
  const unsigned G = gridDim.x * gridDim.y * gridDim.z;
  unsigned sum, cnt, mine, sp = 0u;
  for (;;) {
    sum = 0u; cnt = 0u; mine = 0u;
#pragma unroll
    for (unsigned j = 0; j < 16; ++j) { const unsigned c = xb_ld(&bar[XB_XCNT(j)]); sum += c; cnt += (c > 0u) ? 1u : 0u; mine = (j == x) ? c : mine; }
    if (sum == G) break;
    __builtin_amdgcn_s_sleep(1);
    if ((++sp & 255u) == 0u) { if (xb_ld(&bar[XB_TMO])) break; if (sp > XB_SPIN_CAP) { atomicAdd(&bar[XB_TMO], 1u); break; } }
  }
  nloc = mine > 0u ? mine : 1u; nx = cnt > 0u ? cnt : 1u;
}
DI void xcd_barrier(const XcdBarrier& b) {
  asm volatile("s_waitcnt vmcnt(0)" ::: "memory");
  __syncthreads();
  if (threadIdx.x == 0) {
    unsigned* bar = b.bar;
    __builtin_amdgcn_s_waitcnt(0);
    unsigned nloc = b.st[0], nx = b.st[1];
    if (nloc == 0u) { xcd_barrier_complete(bar, b.x, nloc, nx); b.st[0] = nloc; b.st[1] = nx; }
    const unsigned old = xb_add(&bar[XB_XSUB(b.x)], 1u);
    const unsigned gen = old / nloc;
    if (old + 1u == (gen + 1u) * nloc) {
      __builtin_amdgcn_fence(__ATOMIC_RELEASE, "agent");
      asm volatile("s_waitcnt vmcnt(0)" ::: "memory");
      const unsigned og = xb_add(&bar[XB_TOP], 1u);
      const unsigned tg = og / nx;
      if (og + 1u == (tg + 1u) * nx) xb_add(&bar[XB_TOPGEN], 1u);
      else XB_SPIN(xb_ld(&bar[XB_TOPGEN]) == tg, bar);
      __builtin_amdgcn_fence(__ATOMIC_ACQUIRE, "agent");
      xb_add(&bar[XB_XGEN(b.x)], 1u);
      asm volatile("s_waitcnt vmcnt(0)" ::: "memory");
    } else {
      XB_SPIN(xb_ld(&bar[XB_XGEN(b.x)]) == gen, bar);
      __builtin_amdgcn_fence(__ATOMIC_ACQUIRE, "agent");
      asm volatile("s_waitcnt vmcnt(0)" ::: "memory");
    }
  }
  __syncthreads();
}

namespace pg8 {
constexpr int BM = 256, BK = 64, HALF = 128, HTB = HALF * BK * 2, STAGE_BYTES = 8 * HTB, NXCD = 8, WGM = 8;
DI int lds_byte(int r, int c) { const int st = (r >> 4) * 2 + (c >> 5), rr = r & 15, cc = c & 31, ob = rr * 64 + cc * 2; return st * 1024 + (ob ^ (((ob >> 9) & 1) << 5)); }
DI void stage_rc(int b, int& R, int& C) { const int st = b / 1024, sb = b % 1024, swz = sb ^ (((sb >> 9) & 1) << 5); R = (st >> 1) * 16 + swz / 64; C = (st & 1) * 32 + (swz % 64) / 2; }
DI int perm32(int rho) { const int n = rho >> 4, i = rho & 15; return 8 * (i >> 2) + 4 * n + (i & 3); }
struct Unit { int pm, pn; };
struct Gemm { const bf16_t* A; const bf16_t* Bt; int M, N, K; };
struct StaticOrder {
  int nM, nN, nwg, G, c;
  DI void init(int M, int N, int G_, int c_) { nM = M / BM; nN = N / BM; nwg = nM * nN; G = G_; c = c_; }
  DI bool next(int i, Unit& u) const {
    const long L = (long)i * G + c; if (L >= nwg) return false;
    int wgid = (int)L; { const int q = nwg / NXCD, r = nwg % NXCD, xcd = wgid % NXCD, off = wgid / NXCD; wgid = (xcd < r ? xcd * (q + 1) : r * (q + 1) + (xcd - r) * q) + off; }
    const int nig = WGM * nN, gid = wgid / nig, fm = gid * WGM, gsz = (nM - fm) < WGM ? (nM - fm) : WGM;
    u.pm = fm + ((wgid % nig) % gsz); u.pn = (wgid % nig) / gsz; return true;
  }
};

template <class Epi>
DI void gemm_phase(LAS unsigned char* lds, const Gemm g, const StaticOrder& S, const Epi& E) {
  const int tid = opaque_i((int)threadIdx.x), wid = __builtin_amdgcn_readfirstlane(tid >> 6), lane = tid & 63, wr = wid >> 2, wc = wid & 3, fr = lane & 15, fq = lane >> 4;
  const int K = g.K, nt = K / BK;
  unsigned voffA[2], voffB[2];
#pragma unroll
  for (int i = 0; i < 2; ++i) { int R, C; stage_rc(tid * 16 + i * 8192, R, C); const int Rb = Epi::PERM ? ((R & ~31) + perm32(R & 31)) : R;
    voffA[i] = (unsigned)(R * K + C) * 2u; voffB[i] = (unsigned)(Rb * K + C) * 2u; }
  const size_t kstep = (size_t)(BK * 2);
  const size_t hstep = (size_t)HALF * K * 2;
  const size_t tstep = 2 * hstep;
  const unsigned ldsw = (unsigned)wid * 1024u;
  const int aoff = lds_byte(wr * 64 + fr, fq * 8), boff = lds_byte(wc * 32 + fr, fq * 8);
#define PG8_SA(b, h) (((b) * 2 + (h)) * HTB)
#define PG8_SB(b, h) ((4 + (b) * 2 + (h)) * HTB)
#define PG8_STAGE(bufoff, gbase, voff) do { _Pragma("unroll") for (int _i = 0; _i < 2; ++_i) \
        __builtin_amdgcn_global_load_lds((const unsigned*)((const char*)(gbase) + (voff)[_i]), (LAS unsigned*)(lds + (bufoff) + ldsw + _i * 8192), 16, 0, 0); } while (0)
#define PG8_LDA(dst, b, h) do { _Pragma("unroll") for (int m = 0; m < 4; ++m) _Pragma("unroll") for (int k = 0; k < 2; ++k) dst[m][k] = *(const LAS bf16x8*)(lds + PG8_SA(b, h) + aoff + m * 2048 + k * 1024); } while (0)
#define PG8_LDB(dst, b, h) do { _Pragma("unroll") for (int n = 0; n < 2; ++n) _Pragma("unroll") for (int k = 0; k < 2; ++k) dst[n][k] = *(const LAS bf16x8*)(lds + PG8_SB(b, h) + boff + n * 2048 + k * 1024); } while (0)
#define PG8_MMA(ai, bj, At, Bt) do { __builtin_amdgcn_s_setprio(1); _Pragma("unroll") for (int m = 0; m < 4; ++m) _Pragma("unroll") for (int n = 0; n < 2; ++n) _Pragma("unroll") for (int k = 0; k < 2; ++k) \
        acc[ai][bj][m][n] = __builtin_amdgcn_mfma_f32_16x16x32_bf16(Bt[n][k], At[m][k], acc[ai][bj][m][n], 0, 0, 0); __builtin_amdgcn_s_setprio(0); } while (0)
#define PG8_WAIT_V(n) asm volatile("s_waitcnt vmcnt(" #n ")" ::: "memory")
#define PG8_WAIT_L(n) asm volatile("s_waitcnt lgkmcnt(" #n ")" ::: "memory")
#define PG8_BAR __builtin_amdgcn_s_barrier()
#define PG8_SCHED __builtin_amdgcn_sched_barrier(0)
  Unit cur, nxt; int ui = 0;
  if (!S.next(0, cur)) return;
  f32x4 acc[2][2][4][2];
#pragma unroll
  for (int a = 0; a < 2; ++a)
#pragma unroll
    for (int b = 0; b < 2; ++b)
#pragma unroll
      for (int m = 0; m < 4; ++m)
#pragma unroll
        for (int n = 0; n < 2; ++n) acc[a][b][m][n] = (f32x4){0.f, 0.f, 0.f, 0.f};
  bf16x8 At[4][2], B0[2][2], B1[2][2];
  const char* cA = (const char*)g.A + (size_t)cur.pm * tstep; const char* cB = (const char*)g.Bt + (size_t)cur.pn * tstep;
  PG8_STAGE(PG8_SB(0, 0), cB, voffB); PG8_STAGE(PG8_SA(0, 0), cA, voffA); PG8_STAGE(PG8_SB(0, 1), cB + hstep, voffB); PG8_STAGE(PG8_SA(0, 1), cA + hstep, voffA);
  if (wr == 1) PG8_BAR;
  PG8_WAIT_V(4); PG8_BAR;
  PG8_STAGE(PG8_SB(1, 0), cB + kstep, voffB); PG8_STAGE(PG8_SA(1, 0), cA + kstep, voffA); PG8_STAGE(PG8_SB(1, 1), cB + hstep + kstep, voffB);
  PG8_WAIT_V(6); PG8_BAR;
  for (;;) {
    const bool has_next = S.next(ui + 1, nxt);
    const char* nA = has_next ? (const char*)g.A + (size_t)nxt.pm * tstep : cA; const char* nB = has_next ? (const char*)g.Bt + (size_t)nxt.pn * tstep : cB;
    for (int t = 0; t < nt; t += 2) {
      const bool last = (t == nt - 2);
      const char* a1 = cA + (size_t)(t + 1) * kstep;
      const char* a2 = last ? nA : cA + (size_t)(t + 2) * kstep; const char* b2 = last ? nB : cB + (size_t)(t + 2) * kstep;
      const char* a3 = a2 + kstep; const char* b3 = b2 + kstep;
      PG8_LDB(B0, 0, 0); PG8_SCHED; PG8_LDA(At, 0, 0); PG8_STAGE(PG8_SA(1, 1), a1 + hstep, voffA);
      PG8_WAIT_L(8); PG8_BAR; PG8_WAIT_L(0); PG8_MMA(0, 0, At, B0); PG8_BAR; PG8_SCHED;
      PG8_LDB(B1, 0, 1); PG8_STAGE(PG8_SB(0, 0), b2, voffB);
      PG8_BAR; PG8_WAIT_L(0); PG8_MMA(0, 1, At, B1); PG8_BAR;
      PG8_LDA(At, 0, 1); PG8_STAGE(PG8_SA(0, 0), a2, voffA);
      PG8_BAR; PG8_WAIT_L(0); PG8_MMA(1, 0, At, B0); PG8_BAR; PG8_SCHED;
      PG8_STAGE(PG8_SB(0, 1), b2 + hstep, voffB);
      PG8_WAIT_V(6); PG8_BAR; PG8_MMA(1, 1, At, B1); PG8_BAR;
      PG8_LDB(B0, 1, 0); PG8_SCHED; PG8_LDA(At, 1, 0); PG8_STAGE(PG8_SA(0, 1), a2 + hstep, voffA);
      PG8_WAIT_L(8); PG8_BAR; PG8_WAIT_L(0); PG8_MMA(0, 0, At, B0); PG8_BAR; PG8_SCHED;
      PG8_LDB(B1, 1, 1); PG8_STAGE(PG8_SB(1, 0), b3, voffB);
      PG8_BAR; PG8_WAIT_L(0); PG8_MMA(0, 1, At, B1); PG8_BAR;
      PG8_LDA(At, 1, 1); PG8_STAGE(PG8_SA(1, 0), a3, voffA);
      PG8_BAR; PG8_WAIT_L(0); PG8_MMA(1, 0, At, B0); PG8_BAR; PG8_SCHED;
      PG8_STAGE(PG8_SB(1, 1), b3 + hstep, voffB);
      PG8_WAIT_V(6); PG8_BAR; PG8_MMA(1, 1, At, B1); PG8_BAR;
    }
    E(acc, cur, wr, wc, fr, fq);
    if (!has_next) break;
#pragma unroll
    for (int a = 0; a < 2; ++a)
#pragma unroll
      for (int b = 0; b < 2; ++b)
#pragma unroll
        for (int m = 0; m < 4; ++m)
#pragma unroll
          for (int n = 0; n < 2; ++n) acc[a][b][m][n] = (f32x4){0.f, 0.f, 0.f, 0.f};
    cur = nxt; cA = nA; cB = nB; ++ui;
  }
  PG8_WAIT_V(0);
  if (wr == 0) PG8_BAR;
  PG8_BAR;
#undef PG8_SA
#undef PG8_SB
#undef PG8_STAGE
#undef PG8_LDA
#undef PG8_LDB
#undef PG8_MMA
#undef PG8_WAIT_V
#undef PG8_WAIT_L
#undef PG8_BAR
#undef PG8_SCHED
}
}

struct EpiIn0 {
  static constexpr bool PERM = true;
  bf16_t* P0; _Float16* LG; const float* hlb;
  DI void operator()(const f32x4 (&acc)[2][2][4][2], const pg8::Unit& u, int wr, int wc, int fr, int fq) const {
    const int row0 = u.pm * 256 + wr * 64 + fr, pn = u.pn;
    if (pn >= 4 && pn < 8) {
#pragma unroll
      for (int bj = 0; bj < 2; ++bj) {
        const int c0 = pn * 256 + bj * 128 + wc * 32 + 8 * fq, ch = (c0 - 1024) & 511;
        float lb[8];
#pragma unroll
        for (int e = 0; e < 8; ++e) lb[e] = __builtin_amdgcn_rcpf(1.0f + __expf(hlb[512 + ch + e] - hlb[ch + e]));
#pragma unroll
        for (int ai = 0; ai < 2; ++ai)
#pragma unroll
          for (int m = 0; m < 4; ++m) {
            _Float16* dst = LG + (size_t)(row0 + ai * 128 + m * 16) * 1024 + (c0 - 1024);
            f16x8 hv;
#pragma unroll
            for (int n = 0; n < 2; ++n) {
#pragma unroll
              for (int j = 0; j < 4; ++j) { const float a = acc[ai][bj][m][n][j]; const float sg = __builtin_amdgcn_rcpf(1.0f + __expf(-a)); const float l = lb[4 * n + j]; hv[4 * n + j] = (_Float16)__logf(l + (1.0f - l) * sg); }
            }
            *(f16x8*)dst = hv;
          }
      }
    } else {
      const bool act = (pn < 2);
      const float scl = (pn == 10) ? 0.125f : 1.0f;
#pragma unroll
      for (int bj = 0; bj < 2; ++bj) {
        const int c0 = pn * 256 + bj * 128 + wc * 32 + 8 * fq, pc = c0 < 1024 ? c0 : c0 - 1024;
#pragma unroll
        for (int ai = 0; ai < 2; ++ai)
#pragma unroll
          for (int m = 0; m < 4; ++m) {
            float v[8];
#pragma unroll
            for (int j = 0; j < 4; ++j) { v[j] = acc[ai][bj][m][0][j]; v[4 + j] = acc[ai][bj][m][1][j]; }
#pragma unroll
            for (int j = 0; j < 8; ++j) v[j] = act ? silu_f(v[j]) : v[j] * scl;
            *(u32x4*)(P0 + (size_t)(row0 + ai * 128 + m * 16) * 3072 + pc) = pack8(v);
          }
      }
    }
  }
};
struct EpiIn1 {
  static constexpr bool PERM = true;
  bf16_t* P1; const float* ropeT;
  DI void operator()(const f32x4 (&acc)[2][2][4][2], const pg8::Unit& u, int wr, int wc, int fr, int fq) const {
    const int row0 = u.pm * 256 + wr * 64 + fr, pn = u.pn;
    const bool act = false, rope = (pn < 8) && (u.pm >= 32);
    const float scl = (pn >= 4 && pn < 8) ? 0.08838834764831845f : 1.0f;
    const int i0 = 16 * (wc & 1) + 4 * fq, hf = wc >> 1;
#pragma unroll
    for (int bj = 0; bj < 2; ++bj) {
      const int c0 = pn * 256 + bj * 128 + wc * 32 + 8 * fq;
#pragma unroll
      for (int ai = 0; ai < 2; ++ai)
#pragma unroll
        for (int m = 0; m < 4; ++m) {
          const int row = row0 + ai * 128 + m * 16;
          float v[8];
#pragma unroll
          for (int j = 0; j < 4; ++j) { v[j] = acc[ai][bj][m][0][j]; v[4 + j] = acc[ai][bj][m][1][j]; }
          if (rope) {
            const int t = row & 1023, pos = hf ? (t & 63) : (t >> 6);
            const f32x4 cs = *(const f32x4*)(ropeT + pos * 32 + i0), sn = *(const f32x4*)(ropeT + 2048 + pos * 32 + i0);
#pragma unroll
            for (int q = 0; q < 4; ++q) { const float a = v[2 * q], b = v[2 * q + 1]; v[2 * q] = a * cs[q] - b * sn[q]; v[2 * q + 1] = b * cs[q] + a * sn[q]; }
          }
#pragma unroll
          for (int j = 0; j < 8; ++j) v[j] = act ? silu_f(v[j]) : v[j] * scl;
          *(u32x4*)(P1 + (size_t)row * 4096 + c0) = pack8(v);
        }
    }
  }
};
struct EpiOut {
  static constexpr bool PERM = true;
  const float* gate;
  bf16_t* delta;
  DI void operator()(const f32x4 (&acc)[2][2][4][2], const pg8::Unit& u, int wr, int wc, int fr, int fq) const {
    const int pm = u.pm, row0 = pm * 256 + wr * 64 + fr, col0 = u.pn * 256 + wc * 32 + 8 * fq;
    const int cond = pm < 32 ? 0 : 1 + ((pm - 32) >> 2);
    const float* gp = gate + cond * 3072 + 2048 + col0;
    f32x4 gv[2][2];
#pragma unroll
    for (int bj = 0; bj < 2; ++bj)
#pragma unroll
      for (int n = 0; n < 2; ++n) gv[bj][n] = *(const f32x4*)(gp + bj * 128 + n * 4);
#pragma unroll
    for (int ai = 0; ai < 2; ++ai)
#pragma unroll
      for (int m = 0; m < 4; ++m) {
        bf16_t* dst = delta + (size_t)(row0 + ai * 128 + m * 16) * 1024 + col0;
#pragma unroll
        for (int bj = 0; bj < 2; ++bj) {
          const f32x4 a = gv[bj][0] * acc[ai][bj][m][0], b = gv[bj][1] * acc[ai][bj][m][1];
          u32x4 w; w.x = cvt_pk_bf16(a[0], a[1]); w.y = cvt_pk_bf16(a[2], a[3]); w.z = cvt_pk_bf16(b[0], b[1]); w.w = cvt_pk_bf16(b[2], b[3]);
          *(u32x4*)(dst + bj * 128) = w;
        }
      }
  }
};

template <bool PERMQK>
DI void tr_tile2(const float* __restrict__ W, const int N, bf16_t* __restrict__ Bt, const int nTn, const int t0, const int ntiles, float* tile) {
  const int tid = opaque_i((int)threadIdx.x);
  const int r = tid >> 4, c4 = (tid & 15) * 4;
  f32x4 v[2][2];
#pragma unroll
  for (int h = 0; h < 2; ++h) {
    const int t = min(t0 + h, ntiles - 1), k0 = (t / nTn) * 64, n0 = (t % nTn) * 64;
#pragma unroll
    for (int rr = 0; rr < 2; ++rr) {
      v[h][rr] = (f32x4){0.f, 0.f, 0.f, 0.f};
      if (n0 + c4 < N) v[h][rr] = __builtin_nontemporal_load((const f32x4*)(W + (size_t)(k0 + r + 32 * rr) * N + n0 + c4));
    }
  }
#pragma unroll
  for (int h = 0; h < 2; ++h)
#pragma unroll
    for (int rr = 0; rr < 2; ++rr) { float* d = tile + h * 4160 + (r + 32 * rr) * 65 + c4; d[0] = v[h][rr][0]; d[1] = v[h][rr][1]; d[2] = v[h][rr][2]; d[3] = v[h][rr][3]; }
  __syncthreads();
  const int n = tid >> 3, k8 = (tid & 7) * 8;
#pragma unroll
  for (int h = 0; h < 2; ++h) {
    const int t = t0 + h;
    if (t < ntiles) {
      const int k0 = (t / nTn) * 64, n0 = (t % nTn) * 64;
      if (n0 + n < N) {
        float o[8];
#pragma unroll
        for (int j = 0; j < 8; ++j) o[j] = tile[h * 4160 + (k8 + j) * 65 + n];
        int nr = n0 + n;
        if (PERMQK && nr < 2048) { const int d = nr & 127; nr = (nr & ~127) + 64 * (d >> 6) + 2 * (d & 31) + ((d >> 5) & 1); }
        *(u32x4*)(Bt + (size_t)nr * 1024 + k0 + k8) = pack8(o);
      }
    }
  }
  __syncthreads();
}
DI void phase0b_transposes(const Params& p, unsigned char* shm) {
  const int nb = gridDim.x, bid = blockIdx.x;
  const bool sp = (nb == 256);
  const int slot = sp ? bid - 48 : bid, nsl = sp ? 208 : nb;
  if (slot < 0) return;
  float* tile = (float*)shm;
  for (int t = 2 * slot; t < 1040; t += 2 * nsl) tr_tile2<false>(p.w_in_even, 4128, (bf16_t*)(p.ws + OFF_BTIN0), 65, t, 1040, tile);
}
DI void prep_layer1(const Params& p, unsigned char* shm, const int slot, const int nsl) {
  float* tile = (float*)shm;
  for (int t = 2 * slot; t < 1024; t += 2 * nsl) tr_tile2<true>(p.w_in_odd, 4096, (bf16_t*)(p.ws + OFF_BTIN1), 64, t, 1024, tile);
  for (int t = 2 * (nsl - 1 - slot); t < 256; t += 2 * nsl) tr_tile2<false>(p.w_out_odd, 1024, (bf16_t*)(p.ws + OFF_BTOUT1), 16, t, 256, tile);
  for (int t = 2 * (nsl - 1 - slot); t < 256; t += 2 * nsl) tr_tile2<false>(p.w_out_even, 1024, (bf16_t*)(p.ws + OFF_BTOUT0), 16, t, 256, tile);
}
DI void mod_partials(const Params& p, const int l, const int gw, const int nw) {
  const int lane = opaque_i((int)threadIdx.x) & 63;
  float* modp = (float*)(p.ws + OFF_MODP);
  for (int it = gw; it < 384; it += nw) {
    const int ks = it & 7, cgp = it >> 3;
    float a0 = 0.f, a1 = 0.f, a2 = 0.f, a3 = 0.f, a4 = 0.f;
    const float* wp = p.ada_w + (size_t)l * 1024 * 3072 + (size_t)(ks * 128) * 3072 + cgp * 64 + lane;
#pragma unroll 1
    for (int hh = 0; hh < 2; ++hh) {
      const int k = ks * 128 + hh * 64 + lane;
      const float s0 = silu_f(p.c_ctx[k]), s1 = silu_f(p.c[k]), s2 = silu_f(p.c[1024 + k]), s3 = silu_f(p.c[2048 + k]), s4 = silu_f(p.c[3072 + k]);
#pragma unroll 16
      for (int kk = 0; kk < 64; ++kk) {
        const float w = __builtin_nontemporal_load(wp + (size_t)(hh * 64 + kk) * 3072);
        a0 += __shfl(s0, kk) * w; a1 += __shfl(s1, kk) * w; a2 += __shfl(s2, kk) * w; a3 += __shfl(s3, kk) * w; a4 += __shfl(s4, kk) * w;
      }
    }
    float* mo = modp + ((size_t)(ks * 2 + l) * 5) * 3072 + cgp * 64 + lane;
    mo[0] = a0; mo[3072] = a1; mo[6144] = a2; mo[9216] = a3; mo[12288] = a4;
  }
}
DI void phase0(const Params& p, unsigned char* shm) {
  const int tid = opaque_i((int)threadIdx.x), nb = gridDim.x, bid = blockIdx.x;
  mod_partials(p, 0, bid * 8 + (tid >> 6), nb * 8);
  float* rope = (float*)(p.ws + OFF_ROPE);
  for (int i = bid * 512 + tid; i < 2048; i += nb * 512) {
    const int pos = i >> 5, fi = i & 31;
    const float inv = exp2f(-(float)(2 * fi) * (13.287712379549449f / 64.0f));
    const float ang = (float)pos * inv;
    const double kq = rint((double)ang * 0.15915494309189535);
    const float rr = (float)((double)ang - kq * 6.283185307179586);
    rope[i] = __cosf(rr);
    rope[2048 + i] = __sinf(rr);
  }
}

DI void phase_norm_mod(const Params& p, int l, bool with_delta) {
  const int tid = opaque_i((int)threadIdx.x), nb = gridDim.x, bid = blockIdx.x, wid = tid >> 6, lane = tid & 63, gw = bid * 8 + wid, nw = nb * 8;
  const float* modp = (const float*)(p.ws + OFF_MODP);
  bf16_t* A = (bf16_t*)(p.ws + OFF_A);
  {
    float* mod = (float*)(p.ws + OFF_MOD);
    for (int i = l * 15360 + bid * 512 + tid; i < (l + 1) * 15360; i += nb * 512) {
      float s = p.ada_b[(i / 15360) * 3072 + (i % 3072)];
#pragma unroll
      for (int ks = 0; ks < 8; ++ks) s += modp[ks * 30720 + i];
      mod[i] = s;
    }
  }
  const int rpw = (TALL + nw - 1) / nw;
  int cur = -1;
  f32x4 sc[4], sh[4], nwv[4];
#pragma unroll
  for (int i = 0; i < 4; ++i) { nwv[i] = *(const f32x4*)(p.norm_w + l * 1024 + lane * 4 + 256 * i); sc[i] = (f32x4){0.f, 0.f, 0.f, 0.f}; sh[i] = sc[i]; }
  const int rend = min(TALL, (gw + 1) * rpw);
  for (int rb = gw * rpw; rb < rend; rb += 6) {
    f32x4 x[6][4];
#pragma unroll
    for (int j = 0; j < 6; ++j) {
      const int r = min(rb + j, rend - 1);
      const float* src = r < TCTX ? p.x_prompt + (size_t)r * 1024 : p.x_sample + (size_t)(r - TCTX) * 1024;
#pragma unroll
      for (int i = 0; i < 4; ++i) x[j][i] = __builtin_nontemporal_load((const f32x4*)(src + lane * 4 + 256 * i));
      if (with_delta) {
        const bf16_t* dp = (const bf16_t*)(p.ws + OFF_D0) + (size_t)r * 1024 + lane * 4;
#pragma unroll
        for (int i = 0; i < 4; ++i) { const u32x2 dv = *(const u32x2*)(dp + 256 * i); x[j][i] += (f32x4){bf_lo(dv.x), bf_hi(dv.x), bf_lo(dv.y), bf_hi(dv.y)}; }
      }
    }
#pragma unroll
    for (int j = 0; j < 6; ++j) {
      const int r = rb + j;
      if (r < rend) {
        const int cond = r < TCTX ? 0 : 1 + ((r - TCTX) >> 10);
        if (cond != cur) {
          cur = cond;
#pragma unroll
          for (int i = 0; i < 4; ++i) {
            const int col = lane * 4 + 256 * i;
            f32x4 a = *(const f32x4*)(p.ada_b + l * 3072 + col), b = *(const f32x4*)(p.ada_b + l * 3072 + 1024 + col);
#pragma unroll 2
            for (int ks = 0; ks < 8; ++ks) {
              const float* mp = modp + ((size_t)(ks * 2 + l) * 5 + cond) * 3072 + col;
              a += *(const f32x4*)mp; b += *(const f32x4*)(mp + 1024);
            }
            sh[i] = a; sc[i] = b;
          }
        }
        float ss = 0.f;
#pragma unroll
        for (int i = 0; i < 4; ++i) ss += x[j][i][0] * x[j][i][0] + x[j][i][1] * x[j][i][1] + x[j][i][2] * x[j][i][2] + x[j][i][3] * x[j][i][3];
        ss = wave_sum(ss);
        const float rstd = rsqrtf(ss * (1.0f / 1024.0f) + 1e-6f);
#pragma unroll
        for (int i = 0; i < 4; ++i) {
          f32x4 h = x[j][i] * rstd * nwv[i] * (sc[i] + 1.0f) + sh[i];
          u32x2 w; w.x = cvt_pk_bf16(h[0], h[1]); w.y = cvt_pk_bf16(h[2], h[3]);
          *(u32x2*)(A + (size_t)r * 1024 + lane * 4 + 256 * i) = w;
        }
      }
    }
  }
}

DI void phase_tail(const Params& p, unsigned char* shm) {
  const int tid = opaque_i((int)threadIdx.x), nb = gridDim.x, bid = blockIdx.x, wid = tid >> 6, lane = tid & 63;
  const int r16 = lane & 15, g = lane >> 4;
  float* part = (float*)shm;
  float* lowS = (float*)(shm + 50688);
  const bf16_t* A = (const bf16_t*)(p.ws + OFF_A);
  const bf16_t* Bt = (const bf16_t*)(p.ws + OFF_BTIN0) + (size_t)4096 * 1024;
  _Float16* GG = (_Float16*)(p.ws + OFF_GG);
  const int gd = tid >> 8, gc = tid & 255;
  f32x2 w2[8];
#pragma unroll
  for (int r = 0; r < 8; ++r) { w2[r][0] = p.gla_gk_w[(gd * 16 + 2 * r) * 256 + gc]; w2[r][1] = p.gla_gk_w[(gd * 16 + 2 * r + 1) * 256 + gc]; }
  const float gb = p.gla_gk_b[gd * 256 + gc];
  for (int grp = bid; grp < TALL / 48; grp += nb) {
    const int row0 = grp * 48;
    {
      f32x4 acc[3][2];
#pragma unroll
      for (int j = 0; j < 3; ++j) { acc[j][0] = (f32x4){0.f, 0.f, 0.f, 0.f}; acc[j][1] = acc[j][0]; }
      const bf16_t* ap = A + (size_t)(row0 + r16) * 1024 + wid * 128 + 8 * g;
      const bf16_t* bp = Bt + (size_t)r16 * 1024 + wid * 128 + 8 * g;
#pragma unroll
      for (int ks = 0; ks < 4; ++ks) {
        const bf16x8 x0 = *(const bf16x8*)(bp + ks * 32), x1 = *(const bf16x8*)(bp + 16 * 1024 + ks * 32);
#pragma unroll
        for (int j = 0; j < 3; ++j) {
          const bf16x8 a = *(const bf16x8*)(ap + (size_t)j * 16 * 1024 + ks * 32);
          acc[j][0] = __builtin_amdgcn_mfma_f32_16x16x32_bf16(a, x0, acc[j][0], 0, 0, 0);
          acc[j][1] = __builtin_amdgcn_mfma_f32_16x16x32_bf16(a, x1, acc[j][1], 0, 0, 0);
        }
      }
#pragma unroll
      for (int j = 0; j < 3; ++j)
#pragma unroll
        for (int i = 0; i < 4; ++i) {
          float* d = part + ((wid * 3 + j) * 16 + 4 * g + i) * 33;
          d[r16] = acc[j][0][i]; d[16 + r16] = acc[j][1][i];
        }
    }
    __syncthreads();
    for (int e = tid; e < 1536; e += 512) {
      const int rr = e >> 5, c = e & 31, j = rr >> 4, r = rr & 15;
      float sum = 0.f;
#pragma unroll
      for (int w = 0; w < 8; ++w) sum += part[((w * 3 + j) * 16 + r) * 33 + c];
      lowS[rr * 36 + c] = sum;
    }
    __syncthreads();
    {
#pragma unroll 4
      for (int t = 0; t < 48; ++t) {
        const f32x4 l0 = *(const f32x4*)(lowS + t * 36 + 16 * gd), l1 = *(const f32x4*)(lowS + t * 36 + 16 * gd + 4),
                    l2 = *(const f32x4*)(lowS + t * 36 + 16 * gd + 8), l3 = *(const f32x4*)(lowS + t * 36 + 16 * gd + 12);
        f32x2 a0 = __builtin_shufflevector(l0, l0, 0, 1) * w2[0], a1 = __builtin_shufflevector(l1, l1, 0, 1) * w2[2];
        a0 += __builtin_shufflevector(l0, l0, 2, 3) * w2[1]; a1 += __builtin_shufflevector(l1, l1, 2, 3) * w2[3];
        a0 += __builtin_shufflevector(l2, l2, 0, 1) * w2[4]; a1 += __builtin_shufflevector(l3, l3, 0, 1) * w2[6];
        a0 += __builtin_shufflevector(l2, l2, 2, 3) * w2[5]; a1 += __builtin_shufflevector(l3, l3, 2, 3) * w2[7];
        const f32x2 as = a0 + a1;
        GG[(size_t)(row0 + t) * 512 + tid] = (_Float16)(logsigmoid_f(gb + (as[0] + as[1])) * 0.0625f);
      }
    }
    __syncthreads();
  }
}

enum { T_HGRN = 0, T_GLA = 1, T_RET = 2 };
#define MFMA16(a, b, c) __builtin_amdgcn_mfma_f32_16x16x32_bf16((a), (b), (c), 0, 0, 0)
DI bf16x8 ld_frag(const bf16_t* base) {
  const s16x4 lo = *(const s16x4*)base, hi = *(const s16x4*)(base + 16);
  return __builtin_shufflevector(lo, hi, 0, 1, 2, 3, 4, 5, 6, 7);
}
DI bf16x8 ld_frag_tr(const bf16_t* base, int hi_off) {
  const s16x4 lo = __builtin_amdgcn_ds_read_tr16_b64_v4i16((LAS s16x4*)base), hi = __builtin_amdgcn_ds_read_tr16_b64_v4i16((LAS s16x4*)(base + hi_off));
  return __builtin_shufflevector(lo, hi, 0, 1, 2, 3, 4, 5, 6, 7);
}
DI bf16x8 pack_frag(const f32x4& a, const f32x4& b) {
  u32x4 w; w.x = cvt_pk_bf16(a[0], a[1]); w.y = cvt_pk_bf16(a[2], a[3]); w.z = cvt_pk_bf16(b[0], b[1]); w.w = cvt_pk_bf16(b[2], b[3]);
  return __builtin_bit_cast(bf16x8, w);
}

struct LoadSet { u32x4 q, k, v, qp, kp, lg; f32x4 c0, c1, s0, s1; };
template <int KD, int TYPE>
DI void scan_unit(unsigned char* shm, const bf16_t* Pq, const bf16_t* Pk, const bf16_t* Pv, int PS, const _Float16* lgp, int LS, float lgs,
                  const float* s0, float* sout, bf16_t* O, int rowbase, int Tlen, int dir, const float* sdummy, bool rope) {
  const float* ropeT = sdummy;
  constexpr int QS = KD + 8, NP = KD / 32, NKT = KD / 16;
  constexpr int BUFB = 35840, VS = 136;
  const int tid = opaque_i((int)threadIdx.x), wid = tid >> 6, lane = tid & 63, r16 = lane & 15, g = lane >> 4;
  const bool active = wid < KD / 16;
  const int ei = lane & 31, c8 = (16 * wid + 8 * (lane >> 5)) & (KD - 1);
  const int vi = tid >> 4, j8 = (tid & 15) * 8;
  const int jcol = 16 * wid + r16;

  f32x4 accS[NKT];
#pragma unroll
  for (int kt = 0; kt < NKT; ++kt)
#pragma unroll
    for (int i = 0; i < 4; ++i) { const float sv = (s0 ? s0 : sdummy)[(size_t)(16 * kt + 4 * g + i) * 128 + jcol]; accS[kt][i] = s0 ? sv : 0.f; }

  const int nsteps = Tlen >> 5;
  LoadSet LA, LB;
  LA.q = (u32x4){0u, 0u, 0u, 0u}; LA.k = LA.q; LA.v = LA.q; LA.qp = LA.q; LA.kp = LA.q; LA.lg = LA.q;
  LA.c0 = (f32x4){0.f, 0.f, 0.f, 0.f}; LA.c1 = LA.c0; LA.s0 = LA.c0; LA.s1 = LA.c0;
  LB = LA;
  const int eiL = ei;
  auto issue_loads = [&](int n, LoadSet& X) {
    const int tb = 32 * n;
    const int tokE = dir ? Tlen - 1 - (tb + eiL) : tb + eiL;
    const int tokV = dir ? Tlen - 1 - (tb + vi) : tb + vi;
    const size_t ro = (size_t)(rowbase + tokE) * PS;
    X.q = *(const u32x4*)(Pq + ro + c8);
    if (TYPE != T_RET) X.lg = *(const u32x4*)(lgp + (size_t)(rowbase + tokE) * LS + c8);
    if (TYPE != T_HGRN) X.k = *(const u32x4*)(Pk + ro + c8);
    if (TYPE == T_RET) {
      X.qp = *(const u32x4*)(Pq + ro + (c8 ^ 32)); X.kp = *(const u32x4*)(Pk + ro + (c8 ^ 32));
      const int pos = (c8 < 64) ? (tokE >> 6) : (tokE & 63);
      const float* rp = ropeT + pos * 32 + (c8 & 31);
      X.c0 = *(const f32x4*)rp; X.c1 = *(const f32x4*)(rp + 4); X.s0 = *(const f32x4*)(rp + 2048); X.s1 = *(const f32x4*)(rp + 2052);
    }
    X.v = *(const u32x4*)(Pv + (size_t)(rowbase + tokV) * PS + j8);
  };
  auto step = [&](int n, LoadSet& X) {
    const int tb = 32 * n;
    unsigned char* buf = shm + (n & 1) * BUFB;
    bf16_t* QR = (bf16_t*)buf;
    bf16_t* KI = (bf16_t*)(buf + 8704);
    bf16_t* KDm = (bf16_t*)(buf + 17408);
    bf16_t* Vm = (bf16_t*)(buf + 26112);
    float* EV = (float*)(buf + 34816);
    if (active) {
      float pre[8];
      const f16x8 hl = __builtin_bit_cast(f16x8, X.lg);
#pragma unroll
      for (int e = 0; e < 8; ++e) pre[e] = (float)hl[e];
#define DPP_ADD(ctrl, rmask, bc) _Pragma("unroll") for (int e = 0; e < 8; ++e) pre[e] += __builtin_bit_cast(float, __builtin_amdgcn_update_dpp(0, __builtin_bit_cast(int, pre[e]), ctrl, rmask, 0xf, bc))
      DPP_ADD(0x111, 0xf, true);
      DPP_ADD(0x112, 0xf, true);
      DPP_ADD(0x114, 0xf, true);
      DPP_ADD(0x118, 0xf, true);
      DPP_ADD(0x142, 0xa, false);
#undef DPP_ADD
      float q[8], kk[8];
      unpack8(X.q, q);
      if (TYPE == T_HGRN) {
#pragma unroll
        for (int e = 0; e < 8; ++e) kk[e] = 1.0f - __expf((float)hl[e]);
      } else unpack8(X.k, kk);
      float qr[8], ki[8], kd[8];
      const int lR = ((lane & 32) | 15) << 2, lL = (lane | 31) << 2;
#pragma unroll
      for (int e = 0; e < 8; ++e) {
        const float rr = __builtin_bit_cast(float, __builtin_amdgcn_ds_bpermute(lR, __builtin_bit_cast(int, pre[e])));
        const float x = __builtin_amdgcn_fmed3f(pre[e] - rr, -80.f, 80.f);
        const float er = __expf(x), ek = __builtin_amdgcn_rcpf(er);
        const float er31 = __builtin_bit_cast(float, __builtin_amdgcn_ds_bpermute(lL, __builtin_bit_cast(int, er)));
        qr[e] = q[e] * er; ki[e] = kk[e] * ek; kd[e] = ki[e] * er31;
      }
      if ((lane & 15) == 15) {
        float* evp = EV + ((lane & 16) ? 0 : 128) + c8;
#pragma unroll
        for (int e = 0; e < 8; ++e) evp[e] = __expf(pre[e]);
      }
      *(u32x4*)(QR + ei * QS + c8) = pack8(qr);
      *(u32x4*)(KI + ei * QS + c8) = pack8(ki);
      *(u32x4*)(KDm + ei * QS + c8) = pack8(kd);
    }
    *(u32x4*)(Vm + vi * VS + j8) = X.v;
    issue_loads(min(n + 2, nsteps - 1), X);
    __syncthreads();
    {
      const int tq = r16 >> 2, tp = r16 & 3;
      const bf16x8 vfrag = ld_frag_tr(Vm + (4 * g + tq) * VS + 16 * wid + 4 * tp, 16 * VS);
      bf16x8 qf[2][NP];
#pragma unroll
      for (int tt = 0; tt < 2; ++tt)
#pragma unroll
        for (int pp = 0; pp < NP; ++pp) qf[tt][pp] = ld_frag(QR + (16 * tt + r16) * QS + 32 * pp + 4 * g);
      f32x4 sc00 = (f32x4){0.f, 0.f, 0.f, 0.f}, sc01 = sc00, sc11 = sc00;
#pragma unroll
      for (int pp = 0; pp < NP; ++pp) {
        const bf16x8 kf0 = ld_frag(KI + r16 * QS + 32 * pp + 4 * g), kf1 = ld_frag(KI + (16 + r16) * QS + 32 * pp + 4 * g);
        sc00 = MFMA16(kf0, qf[0][pp], sc00); sc01 = MFMA16(kf0, qf[1][pp], sc01); sc11 = MFMA16(kf1, qf[1][pp], sc11);
      }
#pragma unroll
      for (int i = 0; i < 4; ++i) if (4 * g + i > r16) { sc00[i] = 0.f; sc11[i] = 0.f; }
      const f32x4 z4 = (f32x4){0.f, 0.f, 0.f, 0.f};
      const bf16x8 pf0 = pack_frag(sc00, z4), pf1 = pack_frag(sc01, sc11);
      f32x4 o0 = MFMA16(vfrag, pf0, z4), o1 = MFMA16(vfrag, pf1, z4);
#pragma unroll
      for (int pp = 0; pp < NP; ++pp) {
        f32x4 e0, e1;
        e0 = *(const f32x4*)(EV + 128 + 32 * pp + 4 * g); e1 = *(const f32x4*)(EV + 128 + 32 * pp + 16 + 4 * g);
        const bf16x8 sf = pack_frag(accS[2 * pp] * e0, accS[2 * pp + 1] * e1);
        o0 = MFMA16(sf, qf[0][pp], o0); o1 = MFMA16(sf, qf[1][pp], o1);
      }
#pragma unroll
      for (int kt = 0; kt < NKT; ++kt) {
        f32x4 eb;
        eb = *(const f32x4*)(EV + 16 * kt + 4 * g);
        const bf16x8 kdf = ld_frag_tr(KDm + (4 * g + tq) * QS + 16 * kt + 4 * tp, 16 * QS);
        accS[kt] = MFMA16(kdf, vfrag, accS[kt] * eb);
      }
      {
        const int t0 = tb + r16, t1 = tb + 16 + r16;
        const int tok0 = dir ? Tlen - 1 - t0 : t0, tok1 = dir ? Tlen - 1 - t1 : t1;
        u32x2 w0, w1; w0.x = cvt_pk_bf16(o0[0], o0[1]); w0.y = cvt_pk_bf16(o0[2], o0[3]); w1.x = cvt_pk_bf16(o1[0], o1[1]); w1.y = cvt_pk_bf16(o1[2], o1[3]);
        *(u32x2*)(O + (size_t)(rowbase + tok0) * 1024 + 16 * wid + 4 * g) = w0;
        *(u32x2*)(O + (size_t)(rowbase + tok1) * 1024 + 16 * wid + 4 * g) = w1;
      }
    }
  };
  issue_loads(0, LA);
  issue_loads(1, LB);
  for (int n = 0; n < nsteps; n += 2) { step(n, LA); step(n + 1, LB); }
  if (sout) {
#pragma unroll
    for (int kt = 0; kt < NKT; ++kt)
#pragma unroll
      for (int i = 0; i < 4; ++i) __builtin_nontemporal_store(accS[kt][i], sout + (size_t)(16 * kt + 4 * g + i) * 128 + jcol);
  }
  __syncthreads();
}


struct LoadSet3 { u32x4 q, k, v; };
DI int ret_lrow(int pk) { const int pp = pk >> 1; return 64 * (pp >> 5) + (pp & 31) + 32 * (pk & 1); }
DI void scan_unit_ret(unsigned char* shm, const bf16_t* Pq, const bf16_t* Pk, const bf16_t* Pv, float lgs, const float* s0, float* sout, bf16_t* O,
                      int rowbase, int Tlen, int dir, const float* sdummy) {
  constexpr int QS = 136, NP = 4, NKT = 8, PS = 4096, BUFB = 3 * 8704;
  const int tid = opaque_i((int)threadIdx.x), wid = tid >> 6, lane = tid & 63, r16 = lane & 15, g = lane >> 4;
  const int ei = tid >> 4, c8 = (tid & 15) * 8;
  const int jcol = 16 * wid + r16;
  f32x4 accS[NKT];
#pragma unroll
  for (int kt = 0; kt < NKT; ++kt)
#pragma unroll
    for (int i = 0; i < 4; ++i) { const float sv = (s0 ? s0 : sdummy)[(size_t)ret_lrow(16 * kt + 4 * g + i) * 128 + jcol]; accS[kt][i] = s0 ? sv : 0.f; }
  f32x4 dm, d01; float cs[8];
#pragma unroll
  for (int i = 0; i < 4; ++i) { const int dd = r16 - 4 * g - i; dm[i] = dd >= 0 ? __expf((float)dd * lgs) : 0.f; d01[i] = __expf((float)(16 + dd) * lgs); }
#pragma unroll
  for (int j = 0; j < 8; ++j) cs[j] = __expf((float)(31 - (16 * (j >> 2) + 4 * g + (j & 3))) * lgs);
  const float ct0 = __expf((float)(r16 + 1) * lgs), ct1 = __expf((float)(r16 + 17) * lgs), eb = __expf(32.0f * lgs);
  const int nsteps = Tlen >> 5;
  LoadSet3 LA, LB;
  auto issue_loads = [&](int n, LoadSet3& X) {
    const int tok = dir ? Tlen - 1 - (32 * n + ei) : 32 * n + ei;
    const size_t ro = (size_t)(rowbase + tok) * PS + c8;
    X.q = *(const u32x4*)(Pq + ro); X.k = *(const u32x4*)(Pk + ro); X.v = *(const u32x4*)(Pv + ro);
  };
  auto step = [&](int n, LoadSet3& X) {
    const int tb = 32 * n;
    unsigned char* buf = shm + (n & 1) * BUFB;
    bf16_t* Qm = (bf16_t*)buf; bf16_t* Km = (bf16_t*)(buf + 8704); bf16_t* Vm = (bf16_t*)(buf + 17408);
    *(u32x4*)(Qm + ei * QS + c8) = X.q;
    *(u32x4*)(Km + ei * QS + c8) = X.k;
    *(u32x4*)(Vm + ei * QS + c8) = X.v;
    issue_loads(min(n + 2, nsteps - 1), X);
    __syncthreads();
    const int tq = r16 >> 2, tp = r16 & 3;
    const bf16x8 vfrag = ld_frag_tr(Vm + (4 * g + tq) * QS + 16 * wid + 4 * tp, 16 * QS);
    bf16x8 qf[2][NP];
#pragma unroll
    for (int tt = 0; tt < 2; ++tt)
#pragma unroll
      for (int pp = 0; pp < NP; ++pp) qf[tt][pp] = ld_frag(Qm + (16 * tt + r16) * QS + 32 * pp + 4 * g);
    f32x4 sc00 = (f32x4){0.f, 0.f, 0.f, 0.f}, sc01 = sc00, sc11 = sc00;
#pragma unroll
    for (int pp = 0; pp < NP; ++pp) {
      const bf16x8 kf0 = ld_frag(Km + r16 * QS + 32 * pp + 4 * g), kf1 = ld_frag(Km + (16 + r16) * QS + 32 * pp + 4 * g);
      sc00 = MFMA16(kf0, qf[0][pp], sc00); sc01 = MFMA16(kf0, qf[1][pp], sc01); sc11 = MFMA16(kf1, qf[1][pp], sc11);
    }
    const f32x4 z4 = (f32x4){0.f, 0.f, 0.f, 0.f};
    const bf16x8 pf0 = pack_frag(sc00 * dm, z4), pf1 = pack_frag(sc01 * d01, sc11 * dm);
    f32x4 o0 = MFMA16(vfrag, pf0, z4), o1 = MFMA16(vfrag, pf1, z4);
    f32x4 oi0 = z4, oi1 = z4;
#pragma unroll
    for (int pp = 0; pp < NP; ++pp) {
      const bf16x8 sf = pack_frag(accS[2 * pp], accS[2 * pp + 1]);
      oi0 = MFMA16(sf, qf[0][pp], oi0); oi1 = MFMA16(sf, qf[1][pp], oi1);
    }
    o0 += oi0 * ct0; o1 += oi1 * ct1;
    bf16x8 vsf;
    {
      float vv[8];
      unpack8(__builtin_bit_cast(u32x4, vfrag), vv);
#pragma unroll
      for (int j = 0; j < 8; ++j) vv[j] *= cs[j];
      vsf = __builtin_bit_cast(bf16x8, pack8(vv));
    }
#pragma unroll
    for (int kt = 0; kt < NKT; ++kt) {
      const bf16x8 kdf = ld_frag_tr(Km + (4 * g + tq) * QS + 16 * kt + 4 * tp, 16 * QS);
      accS[kt] = MFMA16(kdf, vsf, accS[kt] * eb);
    }
    {
      const int t0 = tb + r16, t1 = tb + 16 + r16;
      const int tok0 = dir ? Tlen - 1 - t0 : t0, tok1 = dir ? Tlen - 1 - t1 : t1;
      u32x2 w0, w1; w0.x = cvt_pk_bf16(o0[0], o0[1]); w0.y = cvt_pk_bf16(o0[2], o0[3]); w1.x = cvt_pk_bf16(o1[0], o1[1]); w1.y = cvt_pk_bf16(o1[2], o1[3]);
      *(u32x2*)(O + (size_t)(rowbase + tok0) * 1024 + 16 * wid + 4 * g) = w0;
      *(u32x2*)(O + (size_t)(rowbase + tok1) * 1024 + 16 * wid + 4 * g) = w1;
    }
  };
  issue_loads(0, LA);
  issue_loads(1, LB);
  for (int n = 0; n < nsteps; n += 2) { step(n, LA); step(n + 1, LB); }
  if (sout) {
#pragma unroll
    for (int kt = 0; kt < NKT; ++kt)
#pragma unroll
      for (int i = 0; i < 4; ++i) __builtin_nontemporal_store(accS[kt][i], sout + (size_t)ret_lrow(16 * kt + 4 * g + i) * 128 + jcol);
  }
  __syncthreads();
}

DI int scan_unit_id(int k, int bid, int nb) {
  if (nb == 256) {
    if (bid < 64) return k == 0 ? bid : -1;
    const int j = bid - 64;
    if (k == 0) return 64 + j;
    if (k == 1) return 64 + 192 + j;
    if (k == 2 && j < 128) return 64 + 384 + j;
    return -1;
  }
  const int u = bid + k * nb;
  return u < 576 ? u : -1;
}

DI void phase_scan(const Params& p, int layer, unsigned char* shm) {
  const int bid = blockIdx.x, nb = gridDim.x;
  bf16_t* OF = (bf16_t*)(p.ws + OFF_OF); bf16_t* OB = (bf16_t*)(p.ws + OFF_OB);
  const bf16_t* P = (const bf16_t*)(p.ws + OFF_P);
  const bool ksplit = (layer == 0) && (nb == 256);
  for (int k = 0;; ++k) {
    bool lat, gla; int idx, kh = -1, u = 0, v = 0;
    if (ksplit) {
      if (bid < 64) { if (k > 0) break; lat = true; gla = false; idx = bid >> 1; kh = bid & 1; }
      else if (bid < 96) { if (k > 0) break; lat = true; gla = true; idx = bid - 64; }
      else {
        const int s = bid - 96; lat = false;
        if (k == 0) { gla = false; idx = s; }
        else if (s < 96) { if (k == 1) { gla = false; idx = 160 + s; } else if (k == 2) { gla = true; idx = s; } else break; }
        else { if (k == 1) { gla = true; idx = 96 + 2 * (s - 96); } else if (k == 2) { gla = true; idx = 97 + 2 * (s - 96); } else if (k == 3 && s < 128) { gla = true; idx = 224 + (s - 96); } else break; }
      }
    } else {
      u = scan_unit_id(k, bid, nb);
      if (u < 0) break;
      lat = u < 64;
      v = lat ? u : u - 64;
      if (layer == 0) { const int half = lat ? 32 : 256; gla = v >= half; idx = gla ? v - half : v; } else { gla = false; idx = 0; }
    }
    if (layer == 0) {
      const int b = idx >> 3, h = (idx >> 1) & 3, d = idx & 1;
      const int rowbase = lat ? TCTX + b * 1024 : b * 256, Tlen = lat ? 1024 : 256;
      bf16_t* O = (d ? OB : OF);
      if (kh >= 0) {
        const float* s0 = p.state_hgrn + (size_t)((b * 2 + d) * 4 + h) * 16384 + (size_t)kh * 64 * 128;
        bf16_t* Oh = kh == 0 ? O : (bf16_t*)(p.ws + (d ? OFF_O2B : OFF_O2F)) - (size_t)TCTX * 1024;
        scan_unit<64, T_HGRN>(shm, P + h * 128 + 64 * kh, nullptr, P + 512 + h * 128, 3072, (const _Float16*)(p.ws + OFF_LG) + d * 512 + h * 128 + 64 * kh, 1024, 0.f, s0, nullptr,
                              Oh + h * 128, rowbase, Tlen, d, p.state_hgrn, false);
      } else if (!gla) {
        const float* s0 = lat ? p.state_hgrn + (size_t)((b * 2 + d) * 4 + h) * 16384 : nullptr;
        float* so = lat ? nullptr : p.out + OUT_HGRN + (size_t)((b * 2 + d) * 4 + h) * 16384;
        scan_unit<128, T_HGRN>(shm, P + h * 128, nullptr, P + 512 + h * 128, 3072, (const _Float16*)(p.ws + OFF_LG) + d * 512 + h * 128, 1024, 0.f, s0, so,
                               O + h * 128, rowbase, Tlen, d, p.state_hgrn, false);
      } else {
        const float* s0 = lat ? p.state_gla + (size_t)((b * 2 + d) * 4 + h) * 8192 : nullptr;
        float* so = lat ? nullptr : p.out + OUT_GLA + (size_t)((b * 2 + d) * 4 + h) * 8192;
        scan_unit<64, T_GLA>(shm, P + 1536 + h * 64, P + 1792 + h * 64, P + 2048 + h * 128, 3072, (const _Float16*)(p.ws + OFF_GG) + d * 256 + h * 64, 512, 0.f,
                             s0, so, O + 512 + h * 128, rowbase, Tlen, d, p.state_hgrn, false);
      }
    } else {
      const int b = v >> 4, h = (v >> 1) & 7, d = v & 1;
      const int rowbase = lat ? TCTX + b * 1024 : b * 256, Tlen = lat ? 1024 : 256;
      const float* s0 = lat ? p.state_ret + (size_t)((b * 2 + d) * 8 + h) * 16384 : nullptr;
      float* so = lat ? nullptr : p.out + OUT_RET + (size_t)((b * 2 + d) * 8 + h) * 16384;
      const float lgs = logsigmoid_f(p.ret_decay[d * 8 + h]);
      scan_unit_ret(shm, P + h * 128, P + 1024 + h * 128, P + 2048 + h * 128, lgs, s0, so, (d ? OB : OF) + h * 128, rowbase, Tlen, d, p.state_ret);
    }
  }
  if (layer == 0) {
    const bool sp = (nb == 256);
    int slot = bid; const int nsl = sp ? 192 : nb;
    if (sp) { const int s = bid - 96; slot = bid < 64 ? bid : (bid < 96 ? -1 : (s < 96 ? 64 + s : (s >= 128 ? 160 + (s - 128) : -1))); }
    if (slot >= 0) {
      prep_layer1(p, shm, slot, nsl);
      mod_partials(p, 1, slot * 8 + ((int)threadIdx.x >> 6), nsl * 8);
    }
  }
}

DI void phase_combine(const Params& p, int layer) {
  const int tid = opaque_i((int)threadIdx.x), nb = gridDim.x, bid = blockIdx.x, wid = tid >> 6, lane = tid & 63, gw = bid * 8 + wid, nw = nb * 8;
  const bf16_t* OF = (const bf16_t*)(p.ws + OFF_OF); const bf16_t* OB = (const bf16_t*)(p.ws + OFF_OB);
  const bf16_t* P = (const bf16_t*)(p.ws + OFF_P);
  bf16_t* A = (bf16_t*)(p.ws + OFF_A);
  const float* gn = layer == 0 ? p.gn_even : p.gn_odd;
  const int c0 = lane * 16;
  float gnv[16];
#pragma unroll
  for (int i = 0; i < 16; ++i) gnv[i] = gn[c0 + i];
  const bool ksplit = (layer == 0) && (gridDim.x == 256);
  const bf16_t* O2F = (const bf16_t*)(p.ws + OFF_O2F) - (size_t)TCTX * 1024; const bf16_t* O2B = (const bf16_t*)(p.ws + OFF_O2B) - (size_t)TCTX * 1024;
  for (int rb = gw; rb < TALL; rb += 6 * nw) {
    u32x4 rf[6][2], rbk[6][2], rg[6][2], x2f[2][2], x2b[2][2];
#pragma unroll
    for (int j = 0; j < 6; ++j) {
      const int r = min(rb + j * nw, TALL - 1);
      if (j >= 4) {
        x2f[j - 4][0] = (u32x4){0u, 0u, 0u, 0u}; x2f[j - 4][1] = x2f[j - 4][0]; x2b[j - 4][0] = x2f[j - 4][0]; x2b[j - 4][1] = x2f[j - 4][0];
        if (ksplit && c0 < 512) {
          x2f[j - 4][0] = *(const u32x4*)(O2F + (size_t)r * 1024 + c0); x2f[j - 4][1] = *(const u32x4*)(O2F + (size_t)r * 1024 + c0 + 8);
          x2b[j - 4][0] = *(const u32x4*)(O2B + (size_t)r * 1024 + c0); x2b[j - 4][1] = *(const u32x4*)(O2B + (size_t)r * 1024 + c0 + 8);
        }
      }
      const bf16_t* gp = layer == 0 ? P + (size_t)r * 3072 + (c0 < 512 ? 1024 + c0 : 2048 + c0) : P + (size_t)r * 4096 + 3072 + c0;
      rf[j][0] = *(const u32x4*)(OF + (size_t)r * 1024 + c0); rf[j][1] = *(const u32x4*)(OF + (size_t)r * 1024 + c0 + 8);
      rbk[j][0] = *(const u32x4*)(OB + (size_t)r * 1024 + c0); rbk[j][1] = *(const u32x4*)(OB + (size_t)r * 1024 + c0 + 8);
      rg[j][0] = *(const u32x4*)gp; rg[j][1] = *(const u32x4*)(gp + 8);
    }
#pragma unroll
    for (int j = 0; j < 6; ++j) {
      const int r = rb + j * nw;
      if (r < TALL) {
        float o[16], t[16], sg[16];
        unpack8(rf[j][0], o); unpack8(rf[j][1], o + 8); unpack8(rbk[j][0], t); unpack8(rbk[j][1], t + 8); unpack8(rg[j][0], sg); unpack8(rg[j][1], sg + 8);
        float ss = 0.f;
        if (j >= 4) {
          float e2[16];
          unpack8(x2f[j - 4][0], e2); unpack8(x2f[j - 4][1], e2 + 8);
#pragma unroll
          for (int i = 0; i < 16; ++i) o[i] += e2[i];
          unpack8(x2b[j - 4][0], e2); unpack8(x2b[j - 4][1], e2 + 8);
#pragma unroll
          for (int i = 0; i < 16; ++i) t[i] += e2[i];
        }
#pragma unroll
        for (int i = 0; i < 16; ++i) { o[i] += t[i]; ss += o[i] * o[i]; }
        ss += __shfl_xor(ss, 1); ss += __shfl_xor(ss, 2); ss += __shfl_xor(ss, 4);
        const float rstd = rsqrtf(ss * (1.0f / 128.0f) + 1e-6f);
#pragma unroll
        for (int i = 0; i < 16; ++i) o[i] = o[i] * rstd * gnv[i] * silu_f(sg[i]);
        *(u32x4*)(A + (size_t)r * 1024 + c0) = pack8(o);
        *(u32x4*)(A + (size_t)r * 1024 + c0 + 8) = pack8(o + 8);
      }
    }
  }
}

DI void phase_final_norm(const Params& p) {
  const int tid = opaque_i((int)threadIdx.x), nb = gridDim.x, bid = blockIdx.x, wid = tid >> 6, lane = tid & 63, gw = bid * 8 + wid, nw = nb * 8;
  f32x4 fw[4];
#pragma unroll
  for (int i = 0; i < 4; ++i) fw[i] = *(const f32x4*)(p.final_norm_w + lane * 4 + 256 * i);
  for (int rb = gw; rb < TALL; rb += 6 * nw) {
    f32x4 x[6][4];
#pragma unroll
    for (int j = 0; j < 6; ++j) {
      const int rr = min(rb + j * nw, TALL - 1);
      const float* row = rr < TCTX ? p.x_prompt + (size_t)rr * 1024 : p.x_sample + (size_t)(rr - TCTX) * 1024;
      const bf16_t* dp = (const bf16_t*)(p.ws + OFF_OF) + (size_t)rr * 1024 + lane * 4;
      const bf16_t* d0 = (const bf16_t*)(p.ws + OFF_D0) + (size_t)rr * 1024 + lane * 4;
#pragma unroll
      for (int i = 0; i < 4; ++i) {
        const u32x2 dv = *(const u32x2*)(dp + 256 * i), ev = *(const u32x2*)(d0 + 256 * i);
        x[j][i] = (__builtin_nontemporal_load((const f32x4*)(row + lane * 4 + 256 * i)) + (f32x4){bf_lo(ev.x), bf_hi(ev.x), bf_lo(ev.y), bf_hi(ev.y)}) + (f32x4){bf_lo(dv.x), bf_hi(dv.x), bf_lo(dv.y), bf_hi(dv.y)};
      }
    }
#pragma unroll
    for (int j = 0; j < 6; ++j) {
      const int r = rb + j * nw;
      if (r < TALL) {
        float* row = p.out + (size_t)r * 1024;
        float ss = 0.f;
#pragma unroll
        for (int i = 0; i < 4; ++i) ss += x[j][i][0] * x[j][i][0] + x[j][i][1] * x[j][i][1] + x[j][i][2] * x[j][i][2] + x[j][i][3] * x[j][i][3];
        ss = wave_sum(ss);
        const float rstd = rsqrtf(ss * (1.0f / 1024.0f) + 1e-6f);
#pragma unroll
        for (int i = 0; i < 4; ++i) __builtin_nontemporal_store(x[j][i] * rstd * fw[i], (f32x4*)(row + lane * 4 + 256 * i));
      }
    }
  }
}

#ifndef REP_P0
#define REP_P0 1
#endif
#ifndef REP_EW
#define REP_EW 1
#endif
#ifndef REP_IN
#define REP_IN 1
#endif
#ifndef REP_SCAN
#define REP_SCAN 1
#endif
#ifndef REP_OUT
#define REP_OUT 1
#endif
__global__ void __launch_bounds__(512, 2) fwd_megakernel(Params p) {
  extern __shared__ __attribute__((aligned(16))) unsigned char shm[];
  cg::grid_group grid = cg::this_grid();
  LAS unsigned char* lds = (LAS unsigned char*)shm;
  const bf16_t* A = (const bf16_t*)(p.ws + OFF_A);
  pg8::StaticOrder S;
  volatile LAS unsigned* xst = (volatile LAS unsigned*)(lds + 131072);
  if (threadIdx.x == 0) { xst[0] = 0u; xst[1] = 0u; }
  __syncthreads();
  const XcdBarrier xb = xcd_barrier_post((unsigned*)(p.ws + OFF_BAR), xst);
  if (p.ws == nullptr) grid.sync();

  for (int rep = 0; rep < REP_P0; ++rep) phase0(p, shm);
  phase0b_transposes(p, shm);
  xcd_barrier(xb);
  for (int rep = 0; rep < REP_EW; ++rep) phase_norm_mod(p, 0, false);
  xcd_barrier(xb);
  for (int rep = 0; rep < REP_IN; ++rep) {
  phase_tail(p, shm);
    pg8::Gemm g{A, (const bf16_t*)(p.ws + OFF_BTIN0), TALL, 4096, 1024};
    EpiIn0 E{(bf16_t*)(p.ws + OFF_P), (_Float16*)(p.ws + OFF_LG), p.hgrn_lb};
    S.init(TALL, 4096, (int)gridDim.x, (int)blockIdx.x);
    pg8::gemm_phase(lds, g, S, E);
  }
  xcd_barrier(xb);
  for (int rep = 0; rep < REP_SCAN; ++rep) phase_scan(p, 0, shm);
  xcd_barrier(xb);
  for (int rep = 0; rep < REP_EW; ++rep) phase_combine(p, 0);
  xcd_barrier(xb);
  for (int rep = 0; rep < REP_OUT; ++rep) {
    pg8::Gemm g{A, (const bf16_t*)(p.ws + OFF_BTOUT0), TALL, 1024, 1024};
    EpiOut E{(const float*)(p.ws + OFF_MOD), (bf16_t*)(p.ws + OFF_D0)};
    S.init(TALL, 1024, (int)gridDim.x, (int)blockIdx.x);
    pg8::gemm_phase(lds, g, S, E);
  }
  xcd_barrier(xb);
  phase_norm_mod(p, 1, true);
  xcd_barrier(xb);
  for (int rep = 0; rep < REP_IN; ++rep) {
    pg8::Gemm g{A, (const bf16_t*)(p.ws + OFF_BTIN1), TALL, 4096, 1024};
    EpiIn1 E{(bf16_t*)(p.ws + OFF_P), (const float*)(p.ws + OFF_ROPE)};
    S.init(TALL, 4096, (int)gridDim.x, (int)blockIdx.x);
    pg8::gemm_phase(lds, g, S, E);
  }
  xcd_barrier(xb);
  for (int rep = 0; rep < REP_SCAN; ++rep) phase_scan(p, 1, shm);
  xcd_barrier(xb);
  for (int rep = 0; rep < REP_EW; ++rep) phase_combine(p, 1);
  xcd_barrier(xb);
  {
    pg8::Gemm g{A, (const bf16_t*)(p.ws + OFF_BTOUT1), TALL, 1024, 1024};
    EpiOut E{(const float*)(p.ws + OFF_MOD) + 15360, (bf16_t*)(p.ws + OFF_OF)};
    S.init(TALL, 1024, (int)gridDim.x, (int)blockIdx.x);
    pg8::gemm_phase(lds, g, S, E);
  }
  xcd_barrier(xb);
  phase_final_norm(p);
}

extern "C" void kernel_launch(void* const* d_in, const int* in_sizes, int n_in, void* d_out, int out_size, void* d_ws, size_t ws_size,
                              hipStream_t stream) {
  constexpr size_t kDynLds = 131072 + 16;
  static int grid_blocks = 0;
  if (!grid_blocks) {
    int dev = 0, cus = 0, per_cu = 0;
    (void)hipGetDevice(&dev);
    (void)hipDeviceGetAttribute(&cus, hipDeviceAttributeMultiprocessorCount, dev);
    (void)hipFuncSetAttribute((const void*)fwd_megakernel, hipFuncAttributeMaxDynamicSharedMemorySize, (int)kDynLds);
    (void)hipOccupancyMaxActiveBlocksPerMultiprocessor(&per_cu, fwd_megakernel, 512, kDynLds);
    if (per_cu < 1) per_cu = 1;
    grid_blocks = cus * per_cu;
  }
  if (ws_size < WS_NEED) fprintf(stderr, "workspace too small: %zu < %zu\n", ws_size, (size_t)WS_NEED);
  Params p{};
  const float** pp = (const float**)&p;
  for (int i = 0; i < 21; ++i) pp[i] = (const float*)d_in[i];
  p.out = (float*)d_out;
  p.ws = (unsigned char*)d_ws;
  (void)hipMemsetAsync((unsigned char*)d_ws + OFF_BAR, 0, XCD_BAR_WORDS * 4, stream);
  void* args[] = {&p};
  hipError_t e = hipLaunchCooperativeKernel((void*)fwd_megakernel, dim3(grid_blocks), dim3(512), args, kDynLds, stream);
  if (e != hipSuccess) fprintf(stderr, "cooperative launch failed: %s (grid %d)\n", hipGetErrorString(e), grid_blocks);
}
```
